# Optimizing an MI355X kernel written in HIP

```python
import math
import jax, jax.numpy as jnp
from jax import lax
import numpy as np

D_MODEL = 1024
BATCH = 4
SEQ = 4096
DEPTH = 1

RWKV_HEADS = 8
RWKV_HEAD = 64
RWKV_W = RWKV_HEADS * RWKV_HEAD
DIFF_HEADS = 4
DIFF_QK = 64
DIFF_V = 2 * DIFF_QK
DIFF_W = DIFF_HEADS * DIFF_V
MIX_W = RWKV_W + DIFF_W
DECAY_LORA = 64
ICLR_LORA = 64
GATE_LORA = 160
RWKV_COLS = [RWKV_W, RWKV_W, RWKV_W, DECAY_LORA, ICLR_LORA, GATE_LORA]
SHIFT_COLS = sum(RWKV_COLS)
DIFF_COLS = [DIFF_HEADS * 2 * DIFF_QK, DIFF_HEADS * 2 * DIFF_QK, DIFF_W]
PROJ_W = SHIFT_COLS + sum(DIFF_COLS)
D_FF = 2816
FFN_RES = 0.5
Q_BLOCK = 128
NORM_EPS = 1e-6
GN_EPS = 64e-5
SUBLN_EPS = 1e-5

kernel_name = "hybrid_rwkv7_diffattn_macaron"


def _split(t, widths):
    idx = [int(v) for v in np.cumsum(widths)[:-1]]
    return jnp.split(t, idx, axis=-1)


def rmsnorm(x, g, eps=NORM_EPS):
    xf = x.astype(jnp.float32)
    y = xf * lax.rsqrt(jnp.mean(xf * xf, axis=-1, keepdims=True) + eps)
    return (y * g.astype(jnp.float32)).astype(x.dtype)


def swiglu(x, w_gate, w_up, w_down):
    return (jax.nn.silu(x @ w_gate) * (x @ w_up)) @ w_down


def token_shift(p):
    return jnp.pad(p, ((0, 0), (1, 0), (0, 0)))[:, :-1]


def rwkv7_scan(r, w, k, v, a, b):
    B, T, H, N = r.shape

    def step(S, inp):
        r_t, w_t, k_t, v_t, a_t, b_t = inp
        sa = jnp.einsum('bhij,bhj->bhi', S, a_t)
        S = (S * w_t[:, :, None, :] + sa[..., None] * b_t[:, :, None, :]
             + v_t[..., None] * k_t[:, :, None, :])
        y = jnp.einsum('bhij,bhj->bhi', S, r_t)
        return S, y

    S0 = jnp.zeros((B, H, N, N), jnp.float32)
    xs = tuple(jnp.moveaxis(t, 1, 0) for t in (r, w, k, v, a, b))
    _, ys = lax.scan(step, S0, xs)
    return jnp.moveaxis(ys, 0, 1)


def rwkv7_group(p_r, p_k, p_v, p_wd, p_ad, p_gd, w0, w_up, a0, a_up, g_up,
                k_k, k_a, r_k, gn_w, gn_b):
    B, T, _ = p_r.shape
    H, N = RWKV_HEADS, RWKV_HEAD
    f32 = jnp.float32
    logw = -jax.nn.softplus(-(w0 + jnp.tanh(p_wd) @ w_up)) - 0.5
    decay = jnp.exp(-jnp.exp(logw.astype(f32)))
    iclr = jax.nn.sigmoid(a0 + p_ad @ a_up)
    gate = jax.nn.sigmoid(p_gd) @ g_up
    kk = (p_k * k_k).reshape(B, T, H, N).astype(f32)
    kk = kk * lax.rsqrt(jnp.maximum(jnp.sum(kk * kk, -1, keepdims=True), 1e-24))
    k = p_k * (1.0 + (iclr - 1.0) * k_a)
    hs = lambda t: t.reshape(B, T, H, N).astype(f32)
    r_h, k_h, v_h, a_h = hs(p_r), hs(k), hs(p_v), hs(iclr)
    y = rwkv7_scan(r_h, hs(decay), k_h, v_h, -kk, kk * a_h)
    mu = jnp.mean(y, -1, keepdims=True)
    var = jnp.mean(jnp.square(y - mu), -1, keepdims=True)
    y = (y - mu) * lax.rsqrt(var + GN_EPS)
    y = y * gn_w.reshape(H, N).astype(f32) + gn_b.reshape(H, N).astype(f32)
    y = y + jnp.sum(r_h * k_h * r_k.astype(f32), -1, keepdims=True) * v_h
    y = y.reshape(B, T, RWKV_W)
    return (y * gate.astype(f32)).astype(p_r.dtype)


def diff_attention_group(q, k, v, lam_q1, lam_k1, lam_q2, lam_k2, subln_w, lambda_init):
    B, T, _ = q.shape
    H, D = DIFF_HEADS, DIFF_QK
    f32 = jnp.float32
    nb = T // Q_BLOCK
    qh = q.reshape(B, nb, Q_BLOCK, H, 2, D).transpose(1, 0, 2, 3, 4, 5).astype(f32)
    kh = k.reshape(B, T, H, 2, D).astype(f32)
    vh = v.reshape(B, T, H, DIFF_V).astype(f32)
    lam = (jnp.exp(jnp.sum(lam_q1.astype(f32) * lam_k1.astype(f32)))
           - jnp.exp(jnp.sum(lam_q2.astype(f32) * lam_k2.astype(f32))) + lambda_init)
    scale = D ** -0.5
    key_pos = jnp.arange(T)

    def block(args):
        qi, i = args
        s = jnp.einsum('bqhcd,bkhcd->bhcqk', qi, kh) * scale
        q_pos = i * Q_BLOCK + jnp.arange(Q_BLOCK)
        mask = key_pos[None, :] <= q_pos[:, None]
        s = jnp.where(mask, s, -jnp.inf)
        p = jax.nn.softmax(s, axis=-1)
        pd = p[:, :, 0] - lam * p[:, :, 1]
        return jnp.einsum('bhqk,bkhe->bqhe', pd, vh)

    o = lax.map(block, (qh, jnp.arange(nb)))
    o = jnp.moveaxis(o, 0, 1).reshape(B, T, H, DIFF_V)
    o = o * lax.rsqrt(jnp.mean(o * o, -1, keepdims=True) + SUBLN_EPS) * subln_w.astype(f32)
    o = o * (1.0 - lambda_init)
    return o.reshape(B, T, DIFF_W).astype(q.dtype)


def setup_inputs(seed: int = 0) -> dict:
    key = jax.random.key(seed)
    ks = iter(jax.random.split(key, 48))
    L, D, F = DEPTH, D_MODEL, D_FF
    nrm = lambda shape, s: jax.random.normal(next(ks), shape, jnp.float32) * s
    gain = lambda shape: 1.0 + nrm(shape, 0.02)
    n = jnp.arange(RWKV_W, dtype=jnp.float32) / (RWKV_W - 1)
    decay_speed = -7.0 + 5.0 * n ** 0.85 + 0.5
    return {
        "x": jax.random.normal(next(ks), (BATCH, SEQ, D), jnp.float32),
        "ffn1_pre_g": gain((L, D)),
        "ffn1_post_g": gain((L, D)),
        "ffn1_w_gate": nrm((L, D, F), D ** -0.5),
        "ffn1_w_up": nrm((L, D, F), D ** -0.5),
        "ffn1_w_down": nrm((L, F, D), F ** -0.5),
        "mix_pre_g": gain((L, D)),
        "mix_post_g": gain((L, D)),
        "w_in": nrm((L, D, PROJ_W), D ** -0.5),
        "shift_mu": jax.random.uniform(next(ks), (L, SHIFT_COLS), jnp.float32),
        "w_o": nrm((L, MIX_W, D), MIX_W ** -0.5),
        "rwkv_w0": decay_speed[None, :] + nrm((L, RWKV_W), 0.1),
        "rwkv_w_up": nrm((L, DECAY_LORA, RWKV_W), 0.5 * DECAY_LORA ** -0.5),
        "rwkv_a0": nrm((L, RWKV_W), 0.1),
        "rwkv_a_up": nrm((L, ICLR_LORA, RWKV_W), 0.5 * ICLR_LORA ** -0.5),
        "rwkv_g_up": nrm((L, GATE_LORA, RWKV_W), GATE_LORA ** -0.5),
        "rwkv_k_k": 0.85 + nrm((L, RWKV_W), 0.02),
        "rwkv_k_a": gain((L, RWKV_W)),
        "rwkv_r_k": nrm((L, RWKV_HEADS, RWKV_HEAD), 0.1),
        "rwkv_gn_w": gain((L, RWKV_W)),
        "rwkv_gn_b": nrm((L, RWKV_W), 0.02),
        "diff_lam_q1": nrm((L, DIFF_QK), 0.1),
        "diff_lam_k1": nrm((L, DIFF_QK), 0.1),
        "diff_lam_q2": nrm((L, DIFF_QK), 0.1),
        "diff_lam_k2": nrm((L, DIFF_QK), 0.1),
        "diff_subln_w": gain((L, DIFF_V)),
        "ffn2_pre_g": gain((L, D)),
        "ffn2_post_g": gain((L, D)),
        "ffn2_w_gate": nrm((L, D, F), D ** -0.5),
        "ffn2_w_up": nrm((L, D, F), D ** -0.5),
        "ffn2_w_down": nrm((L, F, D), F ** -0.5),
    }


def reference(x, ffn1_pre_g, ffn1_post_g, ffn1_w_gate, ffn1_w_up, ffn1_w_down,
              mix_pre_g, mix_post_g, w_in, shift_mu, w_o,
              rwkv_w0, rwkv_w_up, rwkv_a0, rwkv_a_up, rwkv_g_up, rwkv_k_k, rwkv_k_a,
              rwkv_r_k, rwkv_gn_w, rwkv_gn_b,
              diff_lam_q1, diff_lam_k1, diff_lam_q2, diff_lam_k2, diff_subln_w,
              ffn2_pre_g, ffn2_post_g, ffn2_w_gate, ffn2_w_up, ffn2_w_down):
    for l in range(DEPTH):
        lambda_init = 0.8 - 0.6 * math.exp(-0.3 * l)
        h = rmsnorm(x, ffn1_pre_g[l])
        x = x + FFN_RES * rmsnorm(swiglu(h, ffn1_w_gate[l], ffn1_w_up[l], ffn1_w_down[l]), ffn1_post_g[l])
        h = rmsnorm(x, mix_pre_g[l])
        p = h @ w_in[l]
        p_rw, p_diff = p[..., :SHIFT_COLS], p[..., SHIFT_COLS:]
        p_rw = p_rw + (token_shift(p_rw) - p_rw) * shift_mu[l]
        p_r, p_k, p_v, p_wd, p_ad, p_gd = _split(p_rw, RWKV_COLS)
        q_d, k_d, v_d = _split(p_diff, DIFF_COLS)
        y_rwkv = rwkv7_group(p_r, p_k, p_v, p_wd, p_ad, p_gd,
                             rwkv_w0[l], rwkv_w_up[l], rwkv_a0[l], rwkv_a_up[l], rwkv_g_up[l],
                             rwkv_k_k[l], rwkv_k_a[l], rwkv_r_k[l], rwkv_gn_w[l], rwkv_gn_b[l])
        y_diff = diff_attention_group(q_d, k_d, v_d, diff_lam_q1[l], diff_lam_k1[l],
                                      diff_lam_q2[l], diff_lam_k2[l], diff_subln_w[l], lambda_init)
        y = jnp.concatenate([y_rwkv, y_diff], axis=-1) @ w_o[l]
        x = x + rmsnorm(y, mix_post_g[l])
        h = rmsnorm(x, ffn2_pre_g[l])
        x = x + FFN_RES * rmsnorm(swiglu(h, ffn2_w_gate[l], ffn2_w_up[l], ffn2_w_down[l]), ffn2_post_g[l])
    return x
```

```cpp
#include <hip/hip_runtime.h>
#include <hip/hip_cooperative_groups.h>
#include <cstdio>
#include <cstdint>
namespace cg = cooperative_groups;
namespace pg8 {
#define PG8_LAS __attribute__((address_space(3)))
typedef unsigned short bf16_t;
typedef short bf16x8 __attribute__((ext_vector_type(8)));
typedef float f32x4 __attribute__((ext_vector_type(4)));
typedef unsigned u32x4 __attribute__((ext_vector_type(4)));
constexpr int BM = 256, BK = 64, HALF = 128, HTB = HALF * BK * 2  , STAGE_BYTES = 8 * HTB, NXCD = 8, WGM = 8;

__host__ __device__ __forceinline__ int lds_byte(int r, int c) { const int st = (r >> 4) * 2 + (c >> 5), rr = r & 15, cc = c & 31, ob = rr * 64 + cc * 2; return st * 1024 + (ob ^ (((ob >> 9) & 1) << 5)); }
__host__ __device__ __forceinline__ void stage_rc(int b, int& R, int& C) { const int st = b / 1024, sb = b % 1024, swz = sb ^ (((sb >> 9) & 1) << 5); R = (st >> 1) * 16 + swz / 64; C = (st & 1) * 32 + (swz % 64) / 2; }
__host__ __device__ __forceinline__ int perm32(int rho) { const int n = rho >> 4, i = rho & 15; return 8 * (i >> 2) + 4 * n + (i & 3); }

struct Unit { int pm, pn; };
struct Gemm { const bf16_t* A; const bf16_t* Bt; int M, N, K; };

struct StaticOrder {
    int nM, nN, nwg, G, c;
    __host__ __device__ void init(int M, int N, int G_, int c_) { nM = M / BM; nN = N / BM; nwg = nM * nN; G = G_; c = c_; }
    __host__ __device__ bool next(int i, Unit& u) const {
        const long L = (long)i * G + c; if (L >= nwg) return false;
        int wgid = (int)L; { const int q = nwg / NXCD, r = nwg % NXCD, xcd = wgid % NXCD, off = wgid / NXCD; wgid = (xcd < r ? xcd * (q + 1) : r * (q + 1) + (xcd - r) * q) + off; }
        const int nig = WGM * nN, gid = wgid / nig, fm = gid * WGM, gsz = (nM - fm) < WGM ? (nM - fm) : WGM;
        u.pm = fm + ((wgid % nig) % gsz); u.pn = (wgid % nig) / gsz; return true;
    }
    __device__ __forceinline__ void a_ready(const Unit&) const {}
    __device__ __forceinline__ void done(const Unit&) const {}
};

__device__ __forceinline__ unsigned cvt_pk_bf16(float lo, float hi) { unsigned r; asm volatile("v_cvt_pk_bf16_f32 %0, %1, %2" : "=v"(r) : "v"(lo), "v"(hi)); return r; }
__device__ __forceinline__ float silu_mul(float g, float u) { return g * __builtin_amdgcn_rcpf(1.0f + __builtin_amdgcn_exp2f(-1.4426950408889634f * g)) * u; }
struct EpiSwiGLU {
    static constexpr bool PERM = true, AFTER_DRAIN = false;
    bf16_t* O; int ldc;
    __device__ __forceinline__ void operator()(const f32x4 (&acc)[2][2][4][2], const Unit& u, int wr, int wc, int fr, int fq) const {
        const int row0 = u.pm * BM + wr * 64 + fr, col0 = u.pn * HALF + wc * 32 + 8 * fq;
#pragma unroll
        for (int ai = 0; ai < 2; ++ai)
#pragma unroll
            for (int m = 0; m < 4; ++m) { bf16_t* rowp = O + (size_t)(row0 + ai * HALF + m * 16) * ldc + col0;
                const f32x4 g0 = acc[ai][0][m][0], g1 = acc[ai][0][m][1], u0 = acc[ai][1][m][0], u1 = acc[ai][1][m][1];
                u32x4 w; w.x = cvt_pk_bf16(silu_mul(g0[0], u0[0]), silu_mul(g0[1], u0[1])); w.y = cvt_pk_bf16(silu_mul(g0[2], u0[2]), silu_mul(g0[3], u0[3]));
                w.z = cvt_pk_bf16(silu_mul(g1[0], u1[0]), silu_mul(g1[1], u1[1])); w.w = cvt_pk_bf16(silu_mul(g1[2], u1[2]), silu_mul(g1[3], u1[3]));
                *(u32x4*)rowp = w; }
    }
};
struct EpiF32 {
    static constexpr bool PERM = false, AFTER_DRAIN = false;
    float* O; int ldc;
    __device__ __forceinline__ void operator()(const f32x4 (&acc)[2][2][4][2], const Unit& u, int wr, int wc, int fr, int fq) const {
        const int row0 = u.pm * BM + wr * 64 + fr, col0 = u.pn * BM + wc * 32 + 4 * fq;
#pragma unroll
        for (int ai = 0; ai < 2; ++ai)
#pragma unroll
            for (int m = 0; m < 4; ++m) { float* rowp = O + (size_t)(row0 + ai * HALF + m * 16) * ldc + col0;
#pragma unroll
                for (int bj = 0; bj < 2; ++bj)
#pragma unroll
                    for (int n = 0; n < 2; ++n) *(f32x4*)(rowp + bj * HALF + n * 16) = acc[ai][bj][m][n]; }
    }
};
struct EpiP {
    static constexpr bool PERM = true, AFTER_DRAIN = false;
    bf16_t* O0; int ld0; bf16_t* O1; int ld1;
    __device__ __forceinline__ void operator()(const f32x4 (&acc)[2][2][4][2], const Unit& u, int wr, int wc, int fr, int fq) const {
        const int row0 = u.pm * BM + wr * 64 + fr; const bool first = u.pn < 8;
        bf16_t* base = first ? O0 : O1; const int ldc = first ? ld0 : ld1; const int col0 = (first ? u.pn : u.pn - 8) * BM + wc * 32 + 8 * fq;
#pragma unroll
        for (int ai = 0; ai < 2; ++ai)
#pragma unroll
            for (int m = 0; m < 4; ++m) { bf16_t* rowp = base + (size_t)(row0 + ai * HALF + m * 16) * ldc + col0;
#pragma unroll
                for (int bj = 0; bj < 2; ++bj) { const f32x4 v0 = acc[ai][bj][m][0], v1 = acc[ai][bj][m][1];
                    u32x4 w; w.x = cvt_pk_bf16(v0[0], v0[1]); w.y = cvt_pk_bf16(v0[2], v0[3]); w.z = cvt_pk_bf16(v1[0], v1[1]); w.w = cvt_pk_bf16(v1[2], v1[3]);
                    *(u32x4*)(rowp + bj * HALF) = w; } }
    }
};

template <class Epi, class Sched, bool ALIGN_EPI = false, bool SP2 = false>
__device__ __forceinline__ void gemm_phase(PG8_LAS unsigned char* lds, const Gemm g, const Sched& S, const Epi& E) {
    const int tid = threadIdx.x, wid = __builtin_amdgcn_readfirstlane(tid >> 6), lane = tid & 63, wr = wid >> 2, wc = wid & 3, fr = lane & 15, fq = lane >> 4;
    const int K = g.K, nt = K / BK;
    unsigned voffA[2], voffB[2];
#pragma unroll
    for (int i = 0; i < 2; ++i) { int R, C; stage_rc(tid * 16 + i * 8192, R, C); const int Rb = Epi::PERM ? ((R & ~31) + perm32(R & 31)) : R;
        voffA[i] = (unsigned)(R * K + C) * 2u; voffB[i] = (unsigned)(Rb * K + C) * 2u; }
    const size_t kstep = (size_t)(BK * 2);
    const size_t hstep = (size_t)HALF * K * 2;
    const size_t tstep = 2 * hstep;
    const unsigned ldsw = (unsigned)wid * 1024u;
    const int aoff = lds_byte(wr * 64 + fr, fq * 8), boff = lds_byte(wc * 32 + fr, fq * 8);
#define PG8_SA(b, h) (((b) * 2 + (h)) * HTB)
#define PG8_SB(b, h) ((4 + (b) * 2 + (h)) * HTB)
#define PG8_STAGE(bufoff, gbase, voff) do { _Pragma("unroll") for (int _i = 0; _i < 2; ++_i) \
        __builtin_amdgcn_global_load_lds((const unsigned*)((const char*)(gbase) + (voff)[_i]), (PG8_LAS unsigned*)(lds + (bufoff) + ldsw + _i * 8192), 16, 0, 0); } while (0)
#define PG8_LDA(dst, b, h) do { _Pragma("unroll") for (int m = 0; m < 4; ++m) _Pragma("unroll") for (int k = 0; k < 2; ++k) dst[m][k] = *(const PG8_LAS bf16x8*)(lds + PG8_SA(b, h) + aoff + m * 2048 + k * 1024); } while (0)
#define PG8_LDB(dst, b, h) do { _Pragma("unroll") for (int n = 0; n < 2; ++n) _Pragma("unroll") for (int k = 0; k < 2; ++k) dst[n][k] = *(const PG8_LAS bf16x8*)(lds + PG8_SB(b, h) + boff + n * 2048 + k * 1024); } while (0)
#define PG8_MMA(ai, bj, At, Bt) do { __builtin_amdgcn_s_setprio(1); _Pragma("unroll") for (int m = 0; m < 4; ++m) _Pragma("unroll") for (int n = 0; n < 2; ++n) _Pragma("unroll") for (int k = 0; k < 2; ++k) \
        acc[ai][bj][m][n] = __builtin_amdgcn_mfma_f32_16x16x32_bf16(Bt[n][k], At[m][k], acc[ai][bj][m][n], 0, 0, 0); __builtin_amdgcn_s_setprio(0); } while (0)
#define PG8_WAIT_V(n) asm volatile("s_waitcnt vmcnt(" #n ")" ::: "memory")
#define PG8_WAIT_L(n) asm volatile("s_waitcnt lgkmcnt(" #n ")" ::: "memory")
#define PG8_BAR __builtin_amdgcn_s_barrier()
#define PG8_SCHED __builtin_amdgcn_sched_barrier(0)
    Unit cur, nxt; int ui = 0;
    if (!S.next(0, cur)) return;
    f32x4 acc[2][2][4][2];
#pragma unroll
    for (int a = 0; a < 2; ++a)
#pragma unroll
        for (int b = 0; b < 2; ++b)
#pragma unroll
            for (int m = 0; m < 4; ++m)
#pragma unroll
                for (int n = 0; n < 2; ++n) acc[a][b][m][n] = (f32x4){0.f, 0.f, 0.f, 0.f};
    bf16x8 At[4][2], B0[2][2], B1[2][2];
    const char* cA = (const char*)g.A + (size_t)cur.pm * tstep; const char* cB = (const char*)g.Bt + (size_t)cur.pn * tstep;
    S.a_ready(cur);
    if constexpr (SP2) {
        PG8_STAGE(PG8_SB(0, 0), cB, voffB); PG8_STAGE(PG8_SB(0, 1), cB + hstep, voffB); PG8_STAGE(PG8_SA(0, 0), cA, voffA); PG8_STAGE(PG8_SA(0, 1), cA + hstep, voffA);
        if (wr == 1) PG8_BAR;
        PG8_WAIT_V(2); PG8_BAR;
        PG8_STAGE(PG8_SB(1, 0), cB + kstep, voffB); PG8_STAGE(PG8_SA(1, 0), cA + kstep, voffA); PG8_STAGE(PG8_SB(1, 1), cB + hstep + kstep, voffB);
        PG8_WAIT_V(6); PG8_BAR;
    } else {
        PG8_STAGE(PG8_SB(0, 0), cB, voffB); PG8_STAGE(PG8_SA(0, 0), cA, voffA); PG8_STAGE(PG8_SB(0, 1), cB + hstep, voffB); PG8_STAGE(PG8_SA(0, 1), cA + hstep, voffA);
        if (wr == 1) PG8_BAR;
        PG8_WAIT_V(4); PG8_BAR;
        PG8_STAGE(PG8_SB(1, 0), cB + kstep, voffB); PG8_STAGE(PG8_SA(1, 0), cA + kstep, voffA); PG8_STAGE(PG8_SB(1, 1), cB + hstep + kstep, voffB);
        PG8_WAIT_V(6); PG8_BAR;
    }
    for (;;) {
        const bool has_next = S.next(ui + 1, nxt);
        const char* nA = has_next ? (const char*)g.A + (size_t)nxt.pm * tstep : cA; const char* nB = has_next ? (const char*)g.Bt + (size_t)nxt.pn * tstep : cB;
        for (int t = 0; t < nt; t += 2) {
            const bool last = (t == nt - 2);
            const char* a1 = cA + (size_t)(t + 1) * kstep;
            const char* a2 = last ? nA : cA + (size_t)(t + 2) * kstep; const char* b2 = last ? nB : cB + (size_t)(t + 2) * kstep;
            const char* a3 = a2 + kstep; const char* b3 = b2 + kstep;
            if (last && has_next) S.a_ready(nxt);
            if constexpr (SP2) {
            PG8_LDB(B0, 0, 0); PG8_LDB(B1, 0, 1); PG8_SCHED; PG8_LDA(At, 0, 0); PG8_STAGE(PG8_SA(1, 1), a1 + hstep, voffA);
            PG8_WAIT_V(8); PG8_WAIT_L(0); PG8_BAR; PG8_MMA(0, 0, At, B0); PG8_MMA(0, 1, At, B1); PG8_BAR; PG8_SCHED;
            PG8_LDA(At, 0, 1); PG8_STAGE(PG8_SB(0, 0), b2, voffB); PG8_STAGE(PG8_SB(0, 1), b2 + hstep, voffB); PG8_STAGE(PG8_SA(0, 0), a2, voffA);
            PG8_WAIT_V(8); PG8_WAIT_L(0); PG8_BAR; PG8_MMA(1, 0, At, B0); PG8_MMA(1, 1, At, B1); PG8_BAR; PG8_SCHED;
            PG8_LDB(B0, 1, 0); PG8_LDB(B1, 1, 1); PG8_SCHED; PG8_LDA(At, 1, 0); PG8_STAGE(PG8_SA(0, 1), a2 + hstep, voffA);
            PG8_WAIT_V(8); PG8_WAIT_L(0); PG8_BAR; PG8_MMA(0, 0, At, B0); PG8_MMA(0, 1, At, B1); PG8_BAR; PG8_SCHED;
            PG8_LDA(At, 1, 1); PG8_STAGE(PG8_SB(1, 0), b3, voffB); PG8_STAGE(PG8_SB(1, 1), b3 + hstep, voffB); PG8_STAGE(PG8_SA(1, 0), a3, voffA);
            PG8_WAIT_V(8); PG8_WAIT_L(0); PG8_BAR; PG8_MMA(1, 0, At, B0); PG8_MMA(1, 1, At, B1); PG8_BAR; PG8_SCHED;
            } else {
            PG8_LDB(B0, 0, 0); PG8_SCHED; PG8_LDA(At, 0, 0); PG8_STAGE(PG8_SA(1, 1), a1 + hstep, voffA);
            PG8_WAIT_L(8); PG8_BAR; PG8_WAIT_L(0); PG8_MMA(0, 0, At, B0); PG8_BAR; PG8_SCHED;
            PG8_LDB(B1, 0, 1); PG8_STAGE(PG8_SB(0, 0), b2, voffB);
            PG8_BAR; PG8_WAIT_L(0); PG8_MMA(0, 1, At, B1); PG8_BAR;
            PG8_LDA(At, 0, 1); PG8_STAGE(PG8_SA(0, 0), a2, voffA);
            PG8_BAR; PG8_WAIT_L(0); PG8_MMA(1, 0, At, B0); PG8_BAR; PG8_SCHED;
            PG8_STAGE(PG8_SB(0, 1), b2 + hstep, voffB);
            PG8_WAIT_V(6); PG8_BAR; PG8_MMA(1, 1, At, B1); PG8_BAR;
            PG8_LDB(B0, 1, 0); PG8_SCHED; PG8_LDA(At, 1, 0); PG8_STAGE(PG8_SA(0, 1), a2 + hstep, voffA);
            PG8_WAIT_L(8); PG8_BAR; PG8_WAIT_L(0); PG8_MMA(0, 0, At, B0); PG8_BAR; PG8_SCHED;
            PG8_LDB(B1, 1, 1); PG8_STAGE(PG8_SB(1, 0), b3, voffB);
            PG8_BAR; PG8_WAIT_L(0); PG8_MMA(0, 1, At, B1); PG8_BAR;
            PG8_LDA(At, 1, 1); PG8_STAGE(PG8_SA(1, 0), a3, voffA);
            PG8_BAR; PG8_WAIT_L(0); PG8_MMA(1, 0, At, B0); PG8_BAR; PG8_SCHED;
            PG8_STAGE(PG8_SB(1, 1), b3 + hstep, voffB);
            PG8_WAIT_V(6); PG8_BAR; PG8_MMA(1, 1, At, B1); PG8_BAR;
            }
        }
        if constexpr (ALIGN_EPI) { if (wr == 0) PG8_BAR; }
        if constexpr (!Epi::AFTER_DRAIN) { E(acc, cur, wr, wc, fr, fq); S.done(cur); }
        if (!has_next) break;
#pragma unroll
        for (int a = 0; a < 2; ++a)
#pragma unroll
            for (int b = 0; b < 2; ++b)
#pragma unroll
                for (int m = 0; m < 4; ++m)
#pragma unroll
                    for (int n = 0; n < 2; ++n) acc[a][b][m][n] = (f32x4){0.f, 0.f, 0.f, 0.f};
        cur = nxt; cA = nA; cB = nB; ++ui;
        if constexpr (ALIGN_EPI) { if (wr == 1) PG8_BAR; }
    }
    PG8_WAIT_V(0);
    if constexpr (!ALIGN_EPI) { if (wr == 0) PG8_BAR; }
    PG8_BAR;
    if constexpr (Epi::AFTER_DRAIN) { E.fused(acc, cur, wr, wc, fr, fq, lds, wid, lane); S.done(cur); }
#undef PG8_SA
#undef PG8_SB
#undef PG8_STAGE
#undef PG8_LDA
#undef PG8_LDB
#undef PG8_MMA
#undef PG8_WAIT_V
#undef PG8_WAIT_L
#undef PG8_BAR
#undef PG8_SCHED
}
}
#include <hip/hip_bf16.h>
#include <cmath>
namespace attn_body {
using bf16=__hip_bfloat16;
using bf16x8=__attribute__((ext_vector_type(8)))short;
using s16x4=__attribute__((ext_vector_type(4)))short;
using f32x16=__attribute__((ext_vector_type(16)))float;
using u32x4=__attribute__((ext_vector_type(4)))unsigned;
constexpr int BATCH=4,NHEAD=16,SEQ=4096,D=64,PD=1536,PO=1024;
constexpr int NW=8,QBLK=32,QB=QBLK*NW,KVBLK=64,NQB=SEQ/QB;
constexpr int ATTN_UNIT_ROWS=QB;
__device__ __forceinline__ int crow(int r,int hi){return (r&3)+8*(r>>2)+4*hi;}
#define SBAR() __builtin_amdgcn_sched_barrier(0)
__device__ __forceinline__ void cmask(f32x16&p0,f32x16&p1,int jb,int qrel,int hi){
  const float NEG=-INFINITY; int kb=64*jb+4*hi;
  #pragma unroll
  for(int r=0;r<16;++r){int kv=kb+(r&3)+8*(r>>2); if(kv>qrel)p0[r]=NEG; if(kv+32>qrel)p1[r]=NEG;}
}

constexpr int NSLOT=3, SLOTB=8192;
constexpr int LDS_K=0, LDS_V=NSLOT*SLOTB, LDS_WS=2*NSLOT*SLOTB, LDS_OST=LDS_WS+NW*64*4, LDS_BYTES=LDS_OST+NW*4096;
constexpr float C2=0.125f*1.4426950408889634f;
__device__ __forceinline__ void glds16(const void*gsrc,unsigned lds_dst){unsigned keep;
  asm volatile("s_mov_b32 %0, m0\n\ts_mov_b32 m0, %2\n\ts_nop 0\n\tglobal_load_lds_dwordx4 %1, off\n\ts_mov_b32 m0, %0":"=&s"(keep):"v"(gsrc),"s"(lds_dst):"memory");}
__device__ __forceinline__ float max3f(float a,float b,float c){float r;asm("v_max3_f32 %0, %1, %2, %3":"=v"(r):"v"(a),"v"(b),"v"(c));return r;}
__device__ __forceinline__ float max2f(float a,float b){float r;asm("v_max_f32_e32 %0, %1, %2":"=v"(r):"v"(a),"v"(b));return r;}
__device__ __forceinline__ float fadd_s(float a,float b){float r;asm("v_add_f32_e32 %0, %1, %2":"=v"(r):"v"(a),"v"(b));return r;}
__device__ __forceinline__ float fsub_s(float a,float b){float r;asm("v_sub_f32_e32 %0, %1, %2":"=v"(r):"v"(a),"v"(b));return r;}
typedef float f32x2_t __attribute__((ext_vector_type(2))); typedef __bf16 bf16x2_t __attribute__((ext_vector_type(2)));
__device__ __forceinline__ unsigned cvtpk_s(float lo,float hi){f32x2_t v={lo,hi};bf16x2_t b=__builtin_convertvector(v,bf16x2_t);return __builtin_bit_cast(unsigned,b);}
#define WAIT_BAR(N) asm volatile("s_waitcnt vmcnt(" #N ") lgkmcnt(0)\n\ts_barrier":::"memory")

__device__ __forceinline__ void qkt(f32x16&p0,f32x16&p1,const char*Kslot,const bf16x8*qr,const f32x16&negm,int r32,int hi){
  const char*kb=Kslot+hi*1024+r32*16;
  #pragma unroll
  for(int d0=0;d0<4;++d0){
    const bf16x8 b0=*reinterpret_cast<const bf16x8*>(kb+d0*2048);
    const bf16x8 b1=*reinterpret_cast<const bf16x8*>(kb+d0*2048+512);
    if(d0==0){p0=__builtin_amdgcn_mfma_f32_32x32x16_bf16(b0,qr[0],negm,0,0,0);p1=__builtin_amdgcn_mfma_f32_32x32x16_bf16(b1,qr[0],negm,0,0,0);}
    else{p0=__builtin_amdgcn_mfma_f32_32x32x16_bf16(b0,qr[d0],p0,0,0,0);p1=__builtin_amdgcn_mfma_f32_32x32x16_bf16(b1,qr[d0],p1,0,0,0);}}
}
typedef __attribute__((address_space(3))) const char* lds_cptr;
typedef short v4i16_t __attribute__((ext_vector_type(4)));
__device__ __forceinline__ void kload8(bf16x8*kf,lds_cptr kp){
  kf[0]=*(const __attribute__((address_space(3))) bf16x8*)(kp);      kf[1]=*(const __attribute__((address_space(3))) bf16x8*)(kp+512);
  kf[2]=*(const __attribute__((address_space(3))) bf16x8*)(kp+2048); kf[3]=*(const __attribute__((address_space(3))) bf16x8*)(kp+2560);
  kf[4]=*(const __attribute__((address_space(3))) bf16x8*)(kp+4096); kf[5]=*(const __attribute__((address_space(3))) bf16x8*)(kp+4608);
  kf[6]=*(const __attribute__((address_space(3))) bf16x8*)(kp+6144); kf[7]=*(const __attribute__((address_space(3))) bf16x8*)(kp+6656);
}
__device__ __forceinline__ void kload2(bf16x8*kf,lds_cptr kp,int j){ kf[2*j]=*(const __attribute__((address_space(3))) bf16x8*)(kp+j*2048); kf[2*j+1]=*(const __attribute__((address_space(3))) bf16x8*)(kp+j*2048+512); }
__device__ __forceinline__ s16x4 vtr(lds_cptr p){ return __builtin_bit_cast(s16x4,__builtin_amdgcn_ds_read_tr16_b64_v4i16((__attribute__((address_space(3))) v4i16_t*)p)); }
__device__ __forceinline__ float rowmax(const f32x16&p0,const f32x16&p1){
  float a=max3f(p0[0],p0[1],p1[0]),b=max3f(p0[2],p0[3],p1[1]);a=max3f(a,p1[2],p1[3]);
  #pragma unroll
  for(int r=4;r<16;r+=4){a=max3f(a,p0[r],p0[r+1]);b=max3f(b,p0[r+2],p0[r+3]);a=max3f(a,p1[r],p1[r+1]);b=max3f(b,p1[r+2],p1[r+3]);}
  const float m=max2f(a,b);
  auto rr=__builtin_amdgcn_permlane32_swap(__float_as_uint(m),__float_as_uint(m),false,false);
  return max2f(__uint_as_float(rr[0]),__uint_as_float(rr[1]));
}
__device__ __forceinline__ void pv(f32x16*o,int vb,bf16x8 pa0,bf16x8 pa1,bf16x8 pa2,bf16x8 pa3){
  #pragma unroll
  for(int d0=0;d0<2;++d0){s16x4 lo[4],hi[4];
    #pragma unroll
    for(int ks=0;ks<4;++ks){
      asm volatile("ds_read_b64_tr_b16 %0,%1 offset:%c2":"=&v"(lo[ks]):"v"(vb),"i"(d0*4096+ks*1024):"memory");
      asm volatile("ds_read_b64_tr_b16 %0,%1 offset:%c2":"=&v"(hi[ks]):"v"(vb),"i"(d0*4096+ks*1024+512):"memory");}
    asm volatile("s_waitcnt lgkmcnt(0)":::"memory");SBAR();
    #define PK(k) (bf16x8){lo[k][0],lo[k][1],lo[k][2],lo[k][3],hi[k][0],hi[k][1],hi[k][2],hi[k][3]}
    o[d0]=__builtin_amdgcn_mfma_f32_32x32x16_bf16(pa0,PK(0),o[d0],0,0,0);
    o[d0]=__builtin_amdgcn_mfma_f32_32x32x16_bf16(pa1,PK(1),o[d0],0,0,0);
    o[d0]=__builtin_amdgcn_mfma_f32_32x32x16_bf16(pa2,PK(2),o[d0],0,0,0);
    o[d0]=__builtin_amdgcn_mfma_f32_32x32x16_bf16(pa3,PK(3),o[d0],0,0,0);
    #undef PK
  }
}

#ifndef ATTN_STORE16
#define ATTN_STORE16(p,v) (*(u32x4*)(p)=(v))
#endif
template<int THRL> __device__ __forceinline__ void attn_unit(int b,int h,int qb,const bf16*Q,const bf16*__restrict__ K,const bf16*__restrict__ V,bf16*O,char*shm){
  const int tid=threadIdx.x,lane=tid&63,r32=lane&31,hi=lane>>5; const int wid=__builtin_amdgcn_readfirstlane(tid>>6);
  const long rowbase=(long)b*SEQ; const int q0=qb*QB;
  const int qcol=(h>>1)*64, kcol=512+(h>>1)*64, vcol=1024+(h>>2)*128+(h&1)*64, ocol=h*64;
  const bf16*Qw=Q+(rowbase+q0+wid*QBLK)*PD+qcol;
  const bf16*Kh=K+rowbase*PD+kcol,*Vh=V+rowbase*PD+vcol;
  const unsigned lds0=(unsigned)(uintptr_t)shm;
  float*wsf=(float*)(shm+LDS_WS)+wid*64;
  const bf16*ksrc=Kh+(long)lane*PD+wid*8;
  const bf16*vsrc=Vh+(long)(16*(wid&3)+(lane>>2))*PD+(wid>>2)*32+(lane&3)*8;
  const unsigned kdst=lds0+LDS_K+wid*1024, vdst=lds0+LDS_V+wid*1024;
  #define DMA_K(t,slot) glds16(ksrc+(long)(t)*KVBLK*PD,(unsigned)__builtin_amdgcn_readfirstlane(kdst+(slot)))
  #define DMA_V(t,slot) glds16(vsrc+(long)(t)*KVBLK*PD,(unsigned)__builtin_amdgcn_readfirstlane(vdst+(slot)))
  const int vb0=(int)(lds0+LDS_V)+((lane>>4)&1)*32+(lane&3)*8+(4*hi+((lane&15)>>2))*64;
  const char*Kbase=shm+LDS_K; bf16x8 kf[8];
  const lds_cptr shm3=(lds_cptr)shm; const lds_cptr kp0=shm3+LDS_K+hi*1024+r32*16; const lds_cptr vp0=shm3+LDS_V+((lane>>4)&1)*32+(lane&3)*8+(4*hi+((lane&15)>>2))*64;
  const int NT=(q0+QB)/KVBLK;
  DMA_K(0,0);DMA_V(0,0);DMA_K(1,SLOTB);
  bf16x8 qr[4];
  #pragma unroll
  for(int d0=0;d0<4;++d0)qr[d0]=*reinterpret_cast<const bf16x8*>(&Qw[(long)r32*PD+d0*16+hi*8]);
  float mhat=0.f,l_reg=0.f;f32x16 o[2];o[0]=f32x16{};o[1]=f32x16{};f32x16 negm=f32x16{};asm volatile("":"+v"(negm));
  const int qrel=wid*QBLK+r32;
  #define CMASK(P0,P1,t) do{int jb_=(t)-(NT-4); if(jb_>=0)cmask(P0,P1,jb_,qrel,hi);}while(0)
  bool resc=false;
  #define START(P0,P1) do{ const float rm=rowmax(P0,P1); resc=false; \
    { const float dl=rm; mhat=fadd_s(mhat,dl); \
      _Pragma("unroll") for(int r=0;r<16;++r){P0[r]=fsub_s(P0[r],dl);P1[r]=fsub_s(P1[r],dl);} \
      _Pragma("unroll") for(int r=0;r<16;++r)negm[r]=-mhat; asm volatile("":"+v"(negm)); } \
    _Pragma("unroll") for(int r=0;r<16;++r)P0[r]=__builtin_amdgcn_exp2f(P0[r]); }while(0)
  #define RESC() do{ if(resc){ asm volatile("s_waitcnt lgkmcnt(0)":::"memory"); \
      _Pragma("unroll") for(int d_=0;d_<2;++d_) _Pragma("unroll") for(int r=0;r<16;++r)o[d_][r]*=wsf[crow(r,hi)]; } }while(0)
  f32x16 pA0,pA1,pB0,pB1;
  int sl_prev=0,sl_cur=0,sl_next=SLOTB;
  #define ROT() do{sl_prev=sl_cur;sl_cur=sl_next;sl_next=(sl_next==(NSLOT-1)*SLOTB)?0:sl_next+SLOTB;}while(0)
  DMA_K(2,2*SLOTB);
  WAIT_BAR(3);
  qkt(pA0,pA1,Kbase,qr,negm,r32,hi);asm volatile("s_nop 15\n\ts_nop 7":"+v"(pA0),"+v"(pA1));CMASK(pA0,pA1,0);
  START(pA0,pA1);
  _Pragma("unroll") for(int r=0;r<16;++r)pA1[r]=__builtin_amdgcn_exp2f(pA1[r]);
  WAIT_BAR(0);
  DMA_K(3,0);DMA_V(1,SLOTB);
  ROT();
  kload8(kf,kp0+sl_cur);
  WAIT_BAR(2);
  s16x4 vlo[8],vhi[8]; u32x4 pw0,pw1,pw2,pw3;
  #define PKW(P,B) cvtpk_s(P[B],P[B+1])
  #define PAF(k) __builtin_bit_cast(bf16x8,pw##k)
  #define VFR(i) (bf16x8){vlo[i][0],vlo[i][1],vlo[i][2],vlo[i][3],vhi[i][0],vhi[i][1],vhi[i][2],vhi[i][3]}
  #define PIN(x) asm volatile("":"+v"(x))
  #define MX3(a,b,c) __builtin_fmaxf(__builtin_fmaxf((a),(b)),(c))
  #define GAPA(MF,A0,A1,A2,A3,W0,W1,PW) do{ MF; sacc+=A0; sacc+=A1; sacc+=A2; sacc+=A3; PIN(sacc); W0; W1; PIN(PW); SBAR(); }while(0)
  #define EX(v) __builtin_amdgcn_exp2f(v)
  #define GAPB(MF,X,B) do{ MF; X[B]=EX(X[B]); X[B+1]=EX(X[B+1]); X[B+2]=EX(X[B+2]); X[B+3]=EX(X[B+3]); PIN(X); SBAR(); }while(0)
  #define VRD(i) do{ vlo[i]=vtr(vp_+(((i)>>2)*4096+((i)&3)*1024)); vhi[i]=vtr(vp_+(((i)>>2)*4096+((i)&3)*1024+512)); }while(0)
  #define KRD(G,j) do{ if(G){ kload2(kf,kp0+sl_next,j); SBAR(); } }while(0)
  #define STEP(C0,C1,P0,P1,t,GK,GV,GL) do{ SBAR(); \
    const lds_cptr vp_=vp0+sl_prev; \
    VRD(0); SBAR(); float sacc=(P0[0]+P0[1]); \
    GAPA(C0=__builtin_amdgcn_mfma_f32_32x32x16_bf16(kf[0],qr[0],negm,0,0,0), P0[2],P0[3],P0[4],P0[5],     pw0[0]=PKW(P0,0), pw0[1]=PKW(P0,2), pw0); \
    VRD(4); SBAR(); GAPA(C1=__builtin_amdgcn_mfma_f32_32x32x16_bf16(kf[1],qr[0],negm,0,0,0), P0[6],P0[7],P0[8],P0[9],     pw0[2]=PKW(P0,4), pw0[3]=PKW(P0,6), pw0); \
    VRD(1); SBAR(); GAPA(C0=__builtin_amdgcn_mfma_f32_32x32x16_bf16(kf[2],qr[1],C0,0,0,0),   P0[10],P0[11],P0[12],P0[13], pw1[0]=PKW(P0,8), pw1[1]=PKW(P0,10), pw1); \
    VRD(5); SBAR(); GAPA(C1=__builtin_amdgcn_mfma_f32_32x32x16_bf16(kf[3],qr[1],C1,0,0,0),   P0[14],P0[15],P1[0],P1[1],   pw1[2]=PKW(P0,12),pw1[3]=PKW(P0,14), pw1); \
    VRD(2); SBAR(); GAPA(C0=__builtin_amdgcn_mfma_f32_32x32x16_bf16(kf[4],qr[2],C0,0,0,0),   P1[2],P1[3],P1[4],P1[5],     pw2[0]=PKW(P1,0), pw2[1]=PKW(P1,2), pw2); \
    VRD(6); SBAR(); GAPA(C1=__builtin_amdgcn_mfma_f32_32x32x16_bf16(kf[5],qr[2],C1,0,0,0),   P1[6],P1[7],P1[8],P1[9],     pw2[2]=PKW(P1,4), pw2[3]=PKW(P1,6), pw2); \
    VRD(3); SBAR(); GAPA(C0=__builtin_amdgcn_mfma_f32_32x32x16_bf16(kf[6],qr[3],C0,0,0,0),   P1[10],P1[11],P1[12],P1[13], pw3[0]=PKW(P1,8), pw3[1]=PKW(P1,10), pw3); \
    VRD(7); SBAR(); GAPA(C1=__builtin_amdgcn_mfma_f32_32x32x16_bf16(kf[7],qr[3],C1,0,0,0),   P1[14],P1[15],0.f,0.f,       pw3[2]=PKW(P1,12),pw3[3]=PKW(P1,14), pw3); \
    l_reg+=sacc; \
    if(GK){DMA_K((t)+3,sl_cur);} if(GV){DMA_V((t)+1,sl_next);} \
    CMASK(C0,C1,t); \
    { float a=MX3(C0[0],C0[1],C1[0]),b=MX3(C0[2],C0[3],C1[1]); a=MX3(a,C1[2],C1[3]); \
      _Pragma("unroll") for(int r=4;r<16;r+=4){a=MX3(a,C0[r],C0[r+1]);b=MX3(b,C0[r+2],C0[r+3]);a=MX3(a,C1[r],C1[r+1]);b=MX3(b,C1[r+2],C1[r+3]);} \
      float rm=__builtin_fmaxf(a,b); { auto rr=__builtin_amdgcn_permlane32_swap(__float_as_uint(rm),__float_as_uint(rm),false,false); rm=__builtin_fmaxf(__uint_as_float(rr[0]),__uint_as_float(rr[1])); } \
      resc=false; \
      if(__builtin_expect(__any(rm>(float)THRL),0)){ const float dl=__builtin_fmaxf(rm,0.f); mhat+=dl; \
        _Pragma("unroll") for(int r=0;r<16;++r){C0[r]-=dl;C1[r]-=dl;} \
        _Pragma("unroll") for(int r=0;r<16;++r)negm[r]=-mhat; asm volatile("":"+v"(negm)); \
        const float f=__builtin_amdgcn_exp2f(-dl); l_reg*=f; if(hi==0)wsf[r32]=f; resc=true; } } \
    SBAR(); \
    GAPB(o[0]=__builtin_amdgcn_mfma_f32_32x32x16_bf16(PAF(0),VFR(0),o[0],0,0,0), C0,0); \
    GAPB(o[1]=__builtin_amdgcn_mfma_f32_32x32x16_bf16(PAF(0),VFR(4),o[1],0,0,0), C0,4); \
    KRD(GL,0); GAPB(o[0]=__builtin_amdgcn_mfma_f32_32x32x16_bf16(PAF(1),VFR(1),o[0],0,0,0), C0,8); \
    KRD(GL,1); GAPB(o[1]=__builtin_amdgcn_mfma_f32_32x32x16_bf16(PAF(1),VFR(5),o[1],0,0,0), C0,12); \
    KRD(GL,2); GAPB(o[0]=__builtin_amdgcn_mfma_f32_32x32x16_bf16(PAF(2),VFR(2),o[0],0,0,0), C1,0); \
    KRD(GL,3); GAPB(o[1]=__builtin_amdgcn_mfma_f32_32x32x16_bf16(PAF(2),VFR(6),o[1],0,0,0), C1,4); \
    GAPB(o[0]=__builtin_amdgcn_mfma_f32_32x32x16_bf16(PAF(3),VFR(3),o[0],0,0,0), C1,8); \
    GAPB(o[1]=__builtin_amdgcn_mfma_f32_32x32x16_bf16(PAF(3),VFR(7),o[1],0,0,0), C1,12); \
    }while(0)
  int t=1;
  #undef CMASK
  #define CMASK(P0,P1,t) do{}while(0)
  for(;t+5<NT;t+=2){
    STEP(pB0,pB1,pA0,pA1,t,true,true,true);     WAIT_BAR(2); RESC(); ROT();
    STEP(pA0,pA1,pB0,pB1,t+1,true,true,true);   WAIT_BAR(2); RESC(); ROT();
  }
  #undef CMASK
  #define CMASK(P0,P1,t) do{int jb_=(t)-(NT-4); if(jb_>=0)cmask(P0,P1,jb_,qrel,hi);}while(0)
  #define ENDW(tt) do{ if((tt)+3<NT){WAIT_BAR(2);} else if((tt)+2<NT){WAIT_BAR(1);} else {WAIT_BAR(0);} }while(0)
  for(;t+1<NT;t+=2){
    STEP(pB0,pB1,pA0,pA1,t,(t+3<NT),(t+1<NT),(t+1<NT));       ENDW(t);   RESC(); ROT();
    STEP(pA0,pA1,pB0,pB1,t+1,(t+4<NT),(t+2<NT),(t+2<NT));     ENDW(t+1); RESC(); ROT();
  }
  STEP(pB0,pB1,pA0,pA1,NT-1,false,false,false); RESC();
  { float sacc=pB0[0]+pB0[1]; _Pragma("unroll") for(int r=2;r<16;++r)sacc+=pB0[r]; _Pragma("unroll") for(int r=0;r<16;++r)sacc+=pB1[r]; l_reg+=sacc;
    pw0=(u32x4){PKW(pB0,0),PKW(pB0,2),PKW(pB0,4),PKW(pB0,6)};pw1=(u32x4){PKW(pB0,8),PKW(pB0,10),PKW(pB0,12),PKW(pB0,14)};pw2=(u32x4){PKW(pB1,0),PKW(pB1,2),PKW(pB1,4),PKW(pB1,6)};pw3=(u32x4){PKW(pB1,8),PKW(pB1,10),PKW(pB1,12),PKW(pB1,14)};
    SBAR(); pv(o,vb0+sl_cur,PAF(0),PAF(1),PAF(2),PAF(3)); }
  #undef PKW
  #undef PAF
  #undef VFR
  #undef PIN
  #undef MX3
  #undef GAPA
  #undef GAPB
  #undef EX
  #undef VRD
  #undef KRD
  #undef STEP
  #undef ENDW
  {auto rr=__builtin_amdgcn_permlane32_swap(__float_as_uint(l_reg),__float_as_uint(l_reg),false,false);l_reg=__uint_as_float(rr[0])+__uint_as_float(rr[1]);}
  if(hi==0)wsf[32+r32]=l_reg;asm volatile("s_waitcnt lgkmcnt(0)":::"memory");
  float rli[16];
  #pragma unroll
  for(int r=0;r<16;++r)rli[r]=__builtin_amdgcn_rcpf(wsf[32+crow(r,hi)]);
  bf16*Ow=O+(rowbase+q0+wid*QBLK)*PO+ocol;
  { bf16*stg=(bf16*)(shm+LDS_OST)+wid*2048;
    #pragma unroll
    for(int r=0;r<16;++r){const int orow=crow(r,hi);
      #pragma unroll
      for(int d0=0;d0<2;++d0)stg[orow*64+d0*32+r32]=__float2bfloat16(o[d0][r]*rli[r]);}
    asm volatile("s_waitcnt lgkmcnt(0)":::"memory");
    #pragma unroll
    for(int i=0;i<4;++i){const int row=i*8+(lane>>3),ch=lane&7; const u32x4 v=*(const u32x4*)(stg+row*64+ch*8); ATTN_STORE16(Ow+(long)row*PO+ch*8,v);} }
  asm volatile("s_waitcnt lgkmcnt(0)\n\ts_barrier":::"memory");
  #undef DMA_K
  #undef DMA_V
  #undef CMASK
  #undef START
  #undef RESC
  #undef ROT
}
constexpr int ATTN_LDS_BYTES=LDS_BYTES;
#undef SBAR
#undef WAIT_BAR
}
constexpr int NWAVES = 8;
constexpr int BATCH = 4, T = 4096, D = 1024, FF = 2816, M = BATCH * T;
constexpr int NGU = 2 * FF;
constexpr int RW_H = 8, RW_N = 64, RW_W = 512;
constexpr int SHIFT_COLS = 1824, PROJ_W = 3360;
constexpr int PRW = 2048, PDF = 1536, NPW = PRW + PDF;
constexpr int CH = 64, NCH = T / CH, NITEM = BATCH * RW_H * NCH;
constexpr float NORM_EPS = 1e-6f, GN_EPS = 64e-5f, SUBLN_EPS = 1e-5f, LAMBDA_INIT = 0.2f;
#ifndef MK_PER_PHASE
#define MK_PER_PHASE 0
#endif
constexpr int N_PHASES = 13;

constexpr size_t MiB = 1u << 20;
constexpr size_t WS_CTL = 0, CTL_ZERO_BYTES = 32768;
constexpr size_t WS_LORA = 1 * MiB;
constexpr size_t WS_WGU1 = 2 * MiB, WS_WD1 = 13 * MiB, WS_WIN = 19 * MiB, WS_WO = 26 * MiB, WS_WGU2 = 28 * MiB, WS_WD2 = 39 * MiB;
constexpr size_t WS_S = 2 * MiB;
constexpr size_t WS_XN = 48 * MiB;
constexpr size_t WS_PT = 48 * MiB, WS_QC = 64 * MiB;
constexpr size_t WS_ACT = 80 * MiB;
constexpr size_t WS_PRW = 80 * MiB, WS_PDF = 144 * MiB;
constexpr size_t WS_O = 80 * MiB, WS_YMIX = 112 * MiB;
constexpr size_t WS_VB = 192 * MiB, WS_G = 208 * MiB, WS_RP = 224 * MiB, WS_Y0 = 240 * MiB;
constexpr size_t WS_Y = 192 * MiB;
constexpr size_t WS_YM = 144 * MiB;
constexpr size_t WS_END = 256 * MiB;
constexpr int CW_QUEUE = 64, CW_BAR = 4096;
constexpr size_t WS_PRM = 65536;

constexpr int ARR = 64 * 72 * 2;
constexpr int L_AT = 0, L_BT = ARR, L_KT = 2 * ARR, L_RT = 3 * ARR, L_ATT = 4 * ARR, L_VT = 5 * ARR, L_BH = 6 * ARR, L_KH = 7 * ARR;
constexpr int L_M = 8 * ARR, L_MT = 9 * ARR, L_TT = 10 * ARR, L_NAK = 11 * ARR, L_NRK = 12 * ARR, L_NRB = 13 * ARR;
constexpr int L_APT = L_AT, L_W1T = L_BT, L_U0T = L_KT;
constexpr int L_XW = L_M, L_XA = L_M + ARR, L_XG = L_M + 2 * ARR;
constexpr int FARR = 64 * 65 * 4;
constexpr int L_WL = L_M, L_AL = L_M + FARR, L_GL = L_M + 2 * FARR;
constexpr int L_GT = 14 * ARR;
constexpr int L_WC = L_GT + 2048;
constexpr int L_MISC = L_WC + 256;
constexpr int LDS_BYTES = 150 * 1024;
static_assert(L_GL + FARR <= L_GT && L_XG + 64 * 168 * 2 <= L_GT && L_MISC + 64 <= LDS_BYTES, "LDS map");
constexpr int L_YL = 0;

#define GAS __attribute__((address_space(1)))
#define LAS __attribute__((address_space(3)))
typedef unsigned short bf16;
typedef unsigned v4u __attribute__((ext_vector_type(4)));
typedef unsigned v2u __attribute__((ext_vector_type(2)));
typedef float f32x4 __attribute__((ext_vector_type(4)));
typedef short bf16x8 __attribute__((ext_vector_type(8)));
#define LDS_WAIT() asm volatile("s_waitcnt lgkmcnt(0)" ::: "memory")
__device__ __forceinline__ unsigned f2bf(float f) { unsigned u = __builtin_bit_cast(unsigned, f); return (u + 0x7fffu + ((u >> 16) & 1u)) >> 16; }
__device__ __forceinline__ unsigned pk2(float lo, float hi) { return f2bf(lo) | (f2bf(hi) << 16); }
__device__ __forceinline__ float bf2f(unsigned short b) { return __builtin_bit_cast(float, (unsigned)b << 16); }
__device__ __forceinline__ float bflo(unsigned w) { return __builtin_bit_cast(float, w << 16); }
__device__ __forceinline__ float bfhi(unsigned w) { return __builtin_bit_cast(float, w & 0xffff0000u); }
__device__ __forceinline__ float wave_sum(float v) {
#pragma unroll
    for (int o = 1; o < 64; o <<= 1) v += __shfl_xor(v, o);
    return v;
}
__device__ __forceinline__ float sigmoidf_(float x) { return 1.0f / (1.0f + __expf(-x)); }

typedef GAS unsigned gu32;
#define RLX_AGENT __ATOMIC_RELAXED, __HIP_MEMORY_SCOPE_AGENT
#define XB_TMO      128
#define XB_XCNT(j)  (256  + 64 * (j))
#define XB_XSUB(j)  (1280 + 64 * (j))
#define XB_XGEN(j)  (2304 + 64 * (j))
#define XB_TOP      3328
#define XB_TOPGEN   3392
#define XCD_BAR_WORDS 3456
#define XB_SPIN_CAP (1u << 18)

__device__ __forceinline__ unsigned xb_ld(unsigned* p)              { return __hip_atomic_load(p, __ATOMIC_RELAXED, __HIP_MEMORY_SCOPE_AGENT); }
__device__ __forceinline__ unsigned xb_add(unsigned* p, unsigned v) { return __hip_atomic_fetch_add(p, v, __ATOMIC_RELAXED, __HIP_MEMORY_SCOPE_AGENT); }
__device__ __forceinline__ unsigned xb_xcc_id() { return (unsigned)__builtin_amdgcn_s_getreg((3 << 11) | 20) & 0xFu; }
#define XB_SPIN(cond, bar) do { unsigned _sp = 0; while (cond) { __builtin_amdgcn_s_sleep(1); \
    if ((++_sp & 255u) == 0u) { if (xb_ld(&(bar)[XB_TMO])) break; if (_sp > XB_SPIN_CAP) { atomicAdd(&(bar)[XB_TMO], 1u); break; } } } } while (0)

struct XcdBarrier {
    unsigned* bar; unsigned x;
    volatile LAS unsigned* st;
};

__device__ __forceinline__ XcdBarrier xcd_barrier_post(unsigned* bar, volatile LAS unsigned* st) {
    XcdBarrier b; b.bar = bar; b.x = xb_xcc_id(); b.st = st;
    if (threadIdx.x == 0) (void)xb_add(&bar[XB_XCNT(b.x)], 1u);
    return b;
}
__device__ __forceinline__ void xcd_barrier_complete(unsigned* bar, unsigned x, unsigned& nloc, unsigned& nx) {
    const unsigned G = gridDim.x * gridDim.y * gridDim.z;
    unsigned sum, cnt, mine, sp = 0u;
    for (;;) {
        sum = 0u; cnt = 0u; mine = 0u;
#pragma unroll
        for (unsigned j = 0; j < 16; ++j) { const unsigned c = xb_ld(&bar[XB_XCNT(j)]); sum += c; cnt += (c > 0u) ? 1u : 0u; mine = (j == x) ? c : mine; }
        if (sum == G) break;
        __builtin_amdgcn_s_sleep(1);
        if ((++sp & 255u) == 0u) { if (xb_ld(&bar[XB_TMO])) break; if (sp > XB_SPIN_CAP) { atomicAdd(&bar[XB_TMO], 1u); break; } }
    }
    nloc = mine > 0u ? mine : 1u; nx = cnt > 0u ? cnt : 1u;
}

__device__ __forceinline__ void xcd_barrier(const XcdBarrier& b) {
    asm volatile("s_waitcnt vmcnt(0)" ::: "memory");
    __syncthreads();
    if (threadIdx.x == 0) {
        unsigned* bar = b.bar;
        __builtin_amdgcn_s_waitcnt(0);
        unsigned nloc = b.st[0], nx = b.st[1];
        if (nloc == 0u) { xcd_barrier_complete(bar, b.x, nloc, nx); b.st[0] = nloc; b.st[1] = nx; }
        const unsigned old = xb_add(&bar[XB_XSUB(b.x)], 1u);
        const unsigned gen = old / nloc;
        if (old + 1u == (gen + 1u) * nloc) {
            __builtin_amdgcn_fence(__ATOMIC_RELEASE, "agent");
            asm volatile("s_waitcnt vmcnt(0)" ::: "memory");
            const unsigned og = xb_add(&bar[XB_TOP], 1u);
            const unsigned tg = og / nx;
            if (og + 1u == (tg + 1u) * nx) xb_add(&bar[XB_TOPGEN], 1u);
            else XB_SPIN(xb_ld(&bar[XB_TOPGEN]) == tg, bar);
            __builtin_amdgcn_fence(__ATOMIC_ACQUIRE, "agent");
            xb_add(&bar[XB_XGEN(b.x)], 1u);
            asm volatile("s_waitcnt vmcnt(0)" ::: "memory");
        } else {
            XB_SPIN(xb_ld(&bar[XB_XGEN(b.x)]) == gen, bar);
            __builtin_amdgcn_fence(__ATOMIC_ACQUIRE, "agent");
            asm volatile("s_waitcnt vmcnt(0)" ::: "memory");
        }
    }
    __syncthreads();
}

struct Args { const float* in[31]; float* out; unsigned char* ws; int ph_lo, ph_hi; };
struct Frame {
    LAS unsigned char* lds;
    unsigned* ctl;
    int tid, lane, wave, vcu, G;
    float* out; unsigned char* ws;
};

__device__ __forceinline__ void p0_transpose_item(const float* W, int K, int N, bf16* WT, int ldk, int drow0, float scale, LAS float* scr, int k0, int n0, int lane) {
#pragma unroll 8
    for (int i = 0; i < 32; ++i) { const int kk = 2 * i + (lane >> 5); scr[kk * 33 + (lane & 31)] = (k0 + kk < K) ? W[(size_t)(k0 + kk) * N + n0 + (lane & 31)] * scale : 0.f; }
    LDS_WAIT(); asm volatile("" ::: "memory");
    const int c = lane & 7;
#pragma unroll
    for (int j = 0; j < 4; ++j) { const int n = (lane >> 3) + 8 * j; const LAS float* s = scr + (8 * c) * 33 + n;
        v4u o; o.x = pk2(s[0 * 33], s[1 * 33]); o.y = pk2(s[2 * 33], s[3 * 33]); o.z = pk2(s[4 * 33], s[5 * 33]); o.w = pk2(s[6 * 33], s[7 * 33]);
        if (k0 + 8 * c < K) *(GAS v4u*)(WT + (size_t)(drow0 + n) * ldk + k0 + 8 * c) = o; }
    LDS_WAIT(); asm volatile("" ::: "memory");
}
template <int MODE> __device__ __forceinline__ void norm_rows(Frame& F, const float* xin, const float* y, const float* g1, float coef, float* xo, const float* g2, bf16* xn) {
    const int gw = F.vcu * NWAVES + F.wave, NGW = F.G * NWAVES;
    f32x4 gg1[4], gg2[4];
#pragma unroll
    for (int j = 0; j < 4; ++j) { if (MODE != 0) gg1[j] = ((const f32x4*)g1)[F.lane + 64 * j]; if (MODE != 2) gg2[j] = ((const f32x4*)g2)[F.lane + 64 * j]; }
    for (int m = gw; m < M; m += NGW) {
        f32x4 v[4];
#pragma unroll
        for (int j = 0; j < 4; ++j) v[j] = ((const f32x4*)(xin + (size_t)m * D))[F.lane + 64 * j];
        if (MODE != 0) {
            f32x4 yy[4]; float s = 0.f;
#pragma unroll
            for (int j = 0; j < 4; ++j) { yy[j] = ((const f32x4*)(y + (size_t)m * D))[F.lane + 64 * j]; s += (yy[j].x * yy[j].x + yy[j].y * yy[j].y) + (yy[j].z * yy[j].z + yy[j].w * yy[j].w); }
            const float rs = coef * __builtin_amdgcn_rsqf(wave_sum(s) * (1.f / D) + NORM_EPS);
#pragma unroll
            for (int j = 0; j < 4; ++j) { v[j] = v[j] + yy[j] * gg1[j] * rs; ((f32x4*)(xo + (size_t)m * D))[F.lane + 64 * j] = v[j]; }
        }
        if (MODE != 2) {
            float s = 0.f;
#pragma unroll
            for (int j = 0; j < 4; ++j) s += (v[j].x * v[j].x + v[j].y * v[j].y) + (v[j].z * v[j].z + v[j].w * v[j].w);
            const float rs = __builtin_amdgcn_rsqf(wave_sum(s) * (1.f / D) + NORM_EPS);
            unsigned long long* o8 = (unsigned long long*)(xn + (size_t)m * D) + F.lane;
#pragma unroll
            for (int j = 0; j < 4; ++j) { const f32x4 o = v[j] * gg2[j] * rs; o8[64 * j] = (unsigned long long)pk2(o.x, o.y) | ((unsigned long long)pk2(o.z, o.w) << 32); }
        }
    }
}
__device__ __forceinline__ void p0_job(const float* W, int K, int N, bf16* WT, int ldk, int kind, LAS float* scr, int r, int lane) {
    const int nblk = N / 32, kb = r / nblk, nb = r % nblk, k0 = 64 * kb, n0 = 32 * nb;
    int drow0 = n0; float scale = 1.f;
    if (kind == 1) drow0 = 256 * (n0 >> 7) + (n0 & 127);
    else if (kind == 2) drow0 = 256 * (n0 >> 7) + 128 + (n0 & 127);
    else if (kind == 3) { if (n0 >= SHIFT_COLS) { drow0 = n0 + (PRW - SHIFT_COLS); if (n0 < SHIFT_COLS + 512) scale = attn_body::C2; } }
    p0_transpose_item(W, K, N, WT, ldk, drow0, scale, scr, k0, n0, lane);
}
__device__ __forceinline__ void p0_prologue(Frame& F, const Args& A) {
    LAS float* scr = (LAS float*)(F.lds + F.wave * 16384);
    const int gw = F.vcu * NWAVES + F.wave, NGW = F.G * NWAVES;
    bf16* lora = (bf16*)(F.ws + WS_LORA);
    constexpr int I_GU = (D / 64) * (FF / 32), I_DN = (FF / 64) * (D / 32), I_IN = (D / 64) * (PROJ_W / 32), I_O = (D / 64) * (D / 32), I_L = 512 / 32, I_G = 3 * (512 / 32);
    constexpr int NITEMS = 4 * I_GU + 2 * I_DN + I_IN + I_O + 2 * I_L + I_G;
    for (int it = gw; it < NITEMS; it += NGW) {
        int r = it;
        if (r < I_GU) { p0_job(A.in[3], D, FF, (bf16*)(F.ws + WS_WGU1), D, 1, scr, r, F.lane); continue; } r -= I_GU;
        if (r < I_GU) { p0_job(A.in[4], D, FF, (bf16*)(F.ws + WS_WGU1), D, 2, scr, r, F.lane); continue; } r -= I_GU;
        if (r < I_DN) { p0_job(A.in[5], FF, D, (bf16*)(F.ws + WS_WD1), FF, 0, scr, r, F.lane); continue; } r -= I_DN;
        if (r < I_IN) { p0_job(A.in[8], D, PROJ_W, (bf16*)(F.ws + WS_WIN), D, 3, scr, r, F.lane); continue; } r -= I_IN;
        if (r < I_O) { p0_job(A.in[10], D, D, (bf16*)(F.ws + WS_WO), D, 0, scr, r, F.lane); continue; } r -= I_O;
        if (r < I_GU) { p0_job(A.in[28], D, FF, (bf16*)(F.ws + WS_WGU2), D, 1, scr, r, F.lane); continue; } r -= I_GU;
        if (r < I_GU) { p0_job(A.in[29], D, FF, (bf16*)(F.ws + WS_WGU2), D, 2, scr, r, F.lane); continue; } r -= I_GU;
        if (r < I_DN) { p0_job(A.in[30], FF, D, (bf16*)(F.ws + WS_WD2), FF, 0, scr, r, F.lane); continue; } r -= I_DN;
        if (r < I_L) { p0_job(A.in[12], 64, 512, lora, 64, 0, scr, r, F.lane); continue; } r -= I_L;
        if (r < I_L) { p0_job(A.in[14], 64, 512, lora + 512 * 64, 64, 0, scr, r, F.lane); continue; } r -= I_L;
        p0_job(A.in[15], 160, 512, lora + 2 * 512 * 64, 160, 0, scr, r, F.lane);
    }
    {
        GAS v4u* z = (GAS v4u*)(F.ws + WS_WIN + (size_t)SHIFT_COLS * D * 2); const int nz = (PRW - SHIFT_COLS) * D * 2 / 16;
        for (int i = (F.vcu * NWAVES + F.wave) * 64 + F.lane; i < nz; i += F.G * NWAVES * 64) z[i] = (v4u){0u, 0u, 0u, 0u};
    }
    {
        float* PRMw = (float*)(F.ws + WS_PRM); const int gt = (F.vcu * NWAVES + F.wave) * 64 + F.lane, GT = F.G * NWAVES * 64;
        for (int i = gt; i < 1824; i += GT) PRMw[0 + i] = A.in[9][i];
        for (int i = gt; i < 512; i += GT) PRMw[2048 + i] = A.in[11][i];
        for (int i = gt; i < 512; i += GT) PRMw[2560 + i] = A.in[13][i];
        for (int i = gt; i < 512; i += GT) PRMw[3072 + i] = A.in[16][i];
        for (int i = gt; i < 512; i += GT) PRMw[3584 + i] = A.in[17][i];
        for (int i = gt; i < 512; i += GT) PRMw[4096 + i] = A.in[18][i];
        for (int i = gt; i < 512; i += GT) PRMw[4608 + i] = A.in[19][i];
        for (int i = gt; i < 512; i += GT) PRMw[5120 + i] = A.in[20][i];
        for (int i = gt; i < 64; i += GT) PRMw[5632 + i] = A.in[21][i];
        for (int i = gt; i < 64; i += GT) PRMw[5696 + i] = A.in[22][i];
        for (int i = gt; i < 64; i += GT) PRMw[5760 + i] = A.in[23][i];
        for (int i = gt; i < 64; i += GT) PRMw[5824 + i] = A.in[24][i];
        for (int i = gt; i < 128; i += GT) PRMw[5888 + i] = A.in[25][i];
        for (int i = gt; i < 1024; i += GT) PRMw[6144 + i] = A.in[2][i];
        for (int i = gt; i < 1024; i += GT) PRMw[7168 + i] = A.in[6][i];
        for (int i = gt; i < 1024; i += GT) PRMw[8192 + i] = A.in[7][i];
        for (int i = gt; i < 1024; i += GT) PRMw[9216 + i] = A.in[26][i];
        for (int i = gt; i < 1024; i += GT) PRMw[10240 + i] = A.in[27][i];
    }
    norm_rows<0>(F, A.in[0], nullptr, nullptr, 0.f, nullptr, A.in[1], (bf16*)(F.ws + WS_XN));
}

__device__ __forceinline__ f32x4 mm_tile(const LAS unsigned char* X, int ldx, int x0, const LAS unsigned char* Y, int ldy, int y0, int ksteps, f32x4 acc, int fr, int fq) {
    const LAS unsigned char* xp = X + (x0 + fr) * ldx + fq * 16; const LAS unsigned char* yp = Y + (y0 + fr) * ldy + fq * 16;
    for (int k = 0; k < ksteps; ++k) { const bf16x8 a = *(const LAS bf16x8*)(xp + k * 64), b = *(const LAS bf16x8*)(yp + k * 64); acc = __builtin_amdgcn_mfma_f32_16x16x32_bf16(a, b, acc, 0, 0, 0); }
    return acc;
}
__device__ __forceinline__ void st4_lds(LAS unsigned char* p, f32x4 v) { v2u w; w.x = pk2(v[0], v[1]); w.y = pk2(v[2], v[3]); *(LAS v2u*)p = w; }
__device__ __forceinline__ void st4_g(bf16* p, f32x4 v) { v2u w; w.x = pk2(v[0], v[1]); w.y = pk2(v[2], v[3]); *(GAS v2u*)p = w; }
__device__ __forceinline__ f32x4 ld4_lds(const LAS unsigned char* p) { const v2u w = *(const LAS v2u*)p; return (f32x4){bflo(w.x), bfhi(w.x), bflo(w.y), bfhi(w.y)}; }
__device__ __forceinline__ f32x4 ld4_g(const bf16* p) { const v2u w = *(const GAS v2u*)p; return (f32x4){bflo(w.x), bfhi(w.x), bflo(w.y), bfhi(w.y)}; }
constexpr int LD = 144;

__device__ __forceinline__ void rwkv_chunk_prep(Frame& F, int item) {
    const float* PRM = (const float*)(F.ws + WS_PRM);
    LAS unsigned char* L = F.lds;
    const int tid = F.tid, lane = F.lane, w = F.wave, fr = lane & 15, fq = lane >> 4;
    const int bh = item / NCH, c = item % NCH, b = bh / RW_H, h = bh % RW_H;
    const int row0 = b * T + c * CH;
    const bf16* P = (const bf16*)(F.ws + WS_PRW);
    const float* mu = (PRM + 0);
    for (int e = tid; e < CH * 288; e += NWAVES * 64) {
        const int t = e / 288, l = e % 288; const size_t off = (size_t)(row0 + t) * PRW + 1536 + l;
        const float cur = bf2f(P[off]); const float prv = (c * CH + t > 0) ? bf2f(P[off - PRW]) : 0.f;
        const float x = cur + (prv - cur) * mu[1536 + l];
        if (l < 64) *(LAS bf16*)(L + L_XW + t * LD + l * 2) = (bf16)f2bf(tanhf(x));
        else if (l < 128) *(LAS bf16*)(L + L_XA + t * LD + (l - 64) * 2) = (bf16)f2bf(x);
        else *(LAS bf16*)(L + L_XG + t * 336 + (l - 128) * 2) = (bf16)f2bf(sigmoidf_(x));
    }
    __syncthreads();
    {
        const bf16* lora = (const bf16*)(F.ws + WS_LORA);
        f32x4 aw[2], aa[2], ag[2];
#pragma unroll
        for (int q = 0; q < 2; ++q) { const int tw = 2 * w + q, m0 = 16 * (tw >> 2), n0 = 16 * (tw & 3);
            aw[q] = (f32x4){0.f, 0.f, 0.f, 0.f}; aa[q] = aw[q]; ag[q] = aw[q];
            const bf16* wrow = lora + (size_t)(h * 64 + n0 + fr) * 64 + fq * 8; const bf16* arow = wrow + 512 * 64; const bf16* grow = lora + 2 * 512 * 64 + (size_t)(h * 64 + n0 + fr) * 160 + fq * 8;
#pragma unroll
            for (int k = 0; k < 2; ++k) { const bf16x8 xa = *(const LAS bf16x8*)(L + L_XW + (m0 + fr) * LD + fq * 16 + k * 64); const bf16x8 wb = *(const GAS bf16x8*)(wrow + k * 32);
                aw[q] = __builtin_amdgcn_mfma_f32_16x16x32_bf16(xa, wb, aw[q], 0, 0, 0);
                const bf16x8 xb = *(const LAS bf16x8*)(L + L_XA + (m0 + fr) * LD + fq * 16 + k * 64); const bf16x8 ab = *(const GAS bf16x8*)(arow + k * 32);
                aa[q] = __builtin_amdgcn_mfma_f32_16x16x32_bf16(xb, ab, aa[q], 0, 0, 0); }
#pragma unroll
            for (int k = 0; k < 5; ++k) { const bf16x8 xg = *(const LAS bf16x8*)(L + L_XG + (m0 + fr) * 336 + fq * 16 + k * 64); const bf16x8 gb = *(const GAS bf16x8*)(grow + k * 32);
                ag[q] = __builtin_amdgcn_mfma_f32_16x16x32_bf16(xg, gb, ag[q], 0, 0, 0); }
        }
        __syncthreads();
#pragma unroll
        for (int q = 0; q < 2; ++q) { const int tw = 2 * w + q, m0 = 16 * (tw >> 2), n0 = 16 * (tw & 3);
#pragma unroll
            for (int v = 0; v < 4; ++v) { const int t = m0 + 4 * fq + v, ch = n0 + fr;
                *(LAS float*)(L + L_WL + (t * 65 + ch) * 4) = aw[q][v]; *(LAS float*)(L + L_AL + (t * 65 + ch) * 4) = aa[q][v]; *(LAS float*)(L + L_GL + (t * 65 + ch) * 4) = ag[q][v]; } }
        __syncthreads();
    }
    {
        const int ch = lane, gc = h * 64 + ch;
        const float mur = mu[gc], muk = mu[512 + gc], muv = mu[1024 + gc];
        const float w0 = (PRM + 2048)[gc], a0 = (PRM + 2560)[gc], k_k = (PRM + 3072)[gc], k_a = (PRM + 3584)[gc], r_k = (PRM + 4096)[gc];
        float rr[8], kp[8], vv[8], aa[8], bb[8], ld[8];
        const int tb = 8 * w;
        float pr, pk, pv;
        { const bool has = (c * CH + tb > 0); const size_t offp = (size_t)(row0 + tb - 1) * PRW + gc;
          pr = has ? bf2f(P[offp]) : 0.f; pk = has ? bf2f(P[offp + 512]) : 0.f; pv = has ? bf2f(P[offp + 1024]) : 0.f; }
        bf16* VBp = (bf16*)(F.ws + WS_VB) + (size_t)item * 4096; bf16* Gp = (bf16*)(F.ws + WS_G) + (size_t)item * 4096;
        float run = 0.f;
#pragma unroll
        for (int tt = 0; tt < 8; ++tt) { const int t = tb + tt; const size_t off = (size_t)(row0 + t) * PRW + gc;
            const float cr = bf2f(P[off]), ck = bf2f(P[off + 512]), cv = bf2f(P[off + 1024]);
            const float r = cr + (pr - cr) * mur, k = ck + (pk - ck) * muk, v = cv + (pv - cv) * muv; pr = cr; pk = ck; pv = cv;
            const float wl = *(const LAS float*)(L + L_WL + (t * 65 + ch) * 4), al = *(const LAS float*)(L + L_AL + (t * 65 + ch) * 4), gl = *(const LAS float*)(L + L_GL + (t * 65 + ch) * 4);
            const float z = -(w0 + wl); const float sp = fmaxf(z, 0.f) + log1pf(__expf(-fabsf(z)));
            const float lgd = -__expf(-sp - 0.5f);
            const float ic = sigmoidf_(a0 + al);
            const float kkv = k * k_k; const float ss = wave_sum(kkv * kkv); const float kn = kkv * __builtin_amdgcn_rsqf(fmaxf(ss, 1e-24f));
            const float kq = k * (1.f + (ic - 1.f) * k_a);
            const float bonus = wave_sum(r * kq * r_k);
            rr[tt] = r; kp[tt] = kq; vv[tt] = v; aa[tt] = -kn; bb[tt] = kn * ic; run += lgd; ld[tt] = run;
            VBp[t * 64 + ch] = (bf16)f2bf(bonus * v); Gp[t * 64 + ch] = (bf16)f2bf(gl);
        }
        *(LAS float*)(L + L_GT + (w * 64 + ch) * 4) = run;
        __syncthreads();
        float offs = 0.f, tot = 0.f;
#pragma unroll
        for (int g = 0; g < 8; ++g) { const float x = *(const LAS float*)(L + L_GT + (g * 64 + ch) * 4); if (g < w) offs += x; tot += x; }
        if (w == 0) *(LAS float*)(L + L_WC + ch * 4) = __expf(tot);
        unsigned patt[4], pvt[4], pbh[4], pkh[4];
        float prevcl = offs;
#pragma unroll
        for (int tt = 0; tt < 8; ++tt) { const int t = tb + tt; const float cl = offs + ld[tt];
            const float e_in = __expf(cl), e_ex = __expf(prevcl), e_inv = __expf(-cl), e_hat = __expf(tot - cl); prevcl = cl;
            const float At = aa[tt] * e_ex, Bt = bb[tt] * e_inv, Kt = kp[tt] * e_inv, Rt = rr[tt] * e_in, Bh = bb[tt] * e_hat, Kh = kp[tt] * e_hat;
            *(LAS bf16*)(L + L_AT + t * LD + ch * 2) = (bf16)f2bf(At); *(LAS bf16*)(L + L_BT + t * LD + ch * 2) = (bf16)f2bf(Bt);
            *(LAS bf16*)(L + L_KT + t * LD + ch * 2) = (bf16)f2bf(Kt); *(LAS bf16*)(L + L_RT + t * LD + ch * 2) = (bf16)f2bf(Rt);
            const unsigned sh = (tt & 1) * 16;
            if (!(tt & 1)) { patt[tt >> 1] = 0u; pvt[tt >> 1] = 0u; pbh[tt >> 1] = 0u; pkh[tt >> 1] = 0u; }
            patt[tt >> 1] |= f2bf(At) << sh; pvt[tt >> 1] |= f2bf(vv[tt]) << sh; pbh[tt >> 1] |= f2bf(Bh) << sh; pkh[tt >> 1] |= f2bf(Kh) << sh;
        }
        *(LAS v4u*)(L + L_ATT + ch * LD + tb * 2) = (v4u){patt[0], patt[1], patt[2], patt[3]};
        *(LAS v4u*)(L + L_VT + ch * LD + tb * 2) = (v4u){pvt[0], pvt[1], pvt[2], pvt[3]};
        *(LAS v4u*)(L + L_BH + ch * LD + tb * 2) = (v4u){pbh[0], pbh[1], pbh[2], pbh[3]};
        *(LAS v4u*)(L + L_KH + ch * LD + tb * 2) = (v4u){pkh[0], pkh[1], pkh[2], pkh[3]};
        __syncthreads();
    }
    const f32x4 Z4 = (f32x4){0.f, 0.f, 0.f, 0.f};
#pragma unroll
    for (int q = 0; q < 2; ++q) { const int tw = 2 * w + q, p0 = 16 * (tw >> 2), q0 = 16 * (tw & 3);
        f32x4 m = mm_tile(L + L_AT, LD, q0, L + L_BT, LD, p0, 2, Z4, fr, fq);
        f32x4 mt = mm_tile(L + L_BT, LD, q0, L + L_AT, LD, p0, 2, Z4, fr, fq);
        f32x4 nak = mm_tile(L + L_KT, LD, q0, L + L_AT, LD, p0, 2, Z4, fr, fq);
        f32x4 nrk = mm_tile(L + L_KT, LD, q0, L + L_RT, LD, p0, 2, Z4, fr, fq);
        f32x4 nrb = mm_tile(L + L_BT, LD, q0, L + L_RT, LD, p0, 2, Z4, fr, fq);
        f32x4 tt;
        const int p = p0 + fr;
#pragma unroll
        for (int v = 0; v < 4; ++v) { const int qq = q0 + 4 * fq + v;
            if (!(p < qq)) m[v] = 0.f;
            if (!(qq < p)) { mt[v] = 0.f; nak[v] = 0.f; }
            if (!(qq <= p)) { nrk[v] = 0.f; nrb[v] = 0.f; }
            tt[v] = (p == qq) ? 1.f : 0.f; }
        const int o = p * LD + (q0 + 4 * fq) * 2;
        st4_lds(L + L_M + o, m); st4_lds(L + L_MT + o, mt); st4_lds(L + L_NAK + o, nak); st4_lds(L + L_NRK + o, nrk); st4_lds(L + L_NRB + o, nrb); st4_lds(L + L_TT + o, tt);
    }
    __syncthreads();
    for (int it = 0; it < 6; ++it) {
        f32x4 tn[2], mn[2], mtn[2];
#pragma unroll
        for (int q = 0; q < 2; ++q) { const int tw = 2 * w + q, p0 = 16 * (tw >> 2), q0 = 16 * (tw & 3); const int o = (p0 + fr) * LD + (q0 + 4 * fq) * 2;
            tn[q] = mm_tile(L + L_M, LD, q0, L + L_TT, LD, p0, 2, ld4_lds(L + L_TT + o), fr, fq);
            if (it < 5) { mn[q] = mm_tile(L + L_MT, LD, q0, L + L_M, LD, p0, 2, Z4, fr, fq);
                          mtn[q] = mm_tile(L + L_M, LD, q0, L + L_MT, LD, p0, 2, Z4, fr, fq); }
        }
        __syncthreads();
#pragma unroll
        for (int q = 0; q < 2; ++q) { const int tw = 2 * w + q, p0 = 16 * (tw >> 2), q0 = 16 * (tw & 3); const int o = (p0 + fr) * LD + (q0 + 4 * fq) * 2;
            st4_lds(L + L_TT + o, tn[q]); if (it < 5) { st4_lds(L + L_M + o, mn[q]); st4_lds(L + L_MT + o, mtn[q]); } }
        __syncthreads();
    }
#pragma unroll
    for (int q = 0; q < 2; ++q) { const int tw = 2 * w + q, p0 = 16 * (tw >> 2), q0 = 16 * (tw & 3); const int o = (p0 + fr) * LD + (q0 + 4 * fq) * 2;
        const f32x4 ap = mm_tile(L + L_TT, LD, q0, L + L_ATT, LD, p0, 2, Z4, fr, fq);
        const f32x4 w1 = mm_tile(L + L_NAK, LD, q0, L + L_VT, LD, p0, 2, Z4, fr, fq);
        st4_lds(L + L_APT + o, ap); st4_lds(L + L_W1T + o, w1); }
    __syncthreads();
    {
        bf16* RPp = (bf16*)(F.ws + WS_RP) + (size_t)item * 4096; bf16* PTp = (bf16*)(F.ws + WS_PT) + (size_t)item * 4096;
#pragma unroll
        for (int q = 0; q < 2; ++q) { const int tw = 2 * w + q, p0 = 16 * (tw >> 2), q0 = 16 * (tw & 3); const int p = p0 + fr; const int o = p * LD + (q0 + 4 * fq) * 2;
            const f32x4 u0 = mm_tile(L + L_TT, LD, q0, L + L_W1T, LD, p0, 2, Z4, fr, fq);
            const f32x4 rp = mm_tile(L + L_APT, LD, q0, L + L_NRB, LD, p0, 2, ld4_lds(L + L_RT + o), fr, fq);
            f32x4 pt = mm_tile(L + L_APT, LD, q0, L + L_BH, LD, p0, 2, Z4, fr, fq);
            const float wc = *(const LAS float*)(L + L_WC + p * 4);
#pragma unroll
            for (int v = 0; v < 4; ++v) if (p == q0 + 4 * fq + v) pt[v] += wc;
            st4_lds(L + L_U0T + o, u0);
            st4_g(RPp + p * 64 + q0 + 4 * fq, rp); st4_g(PTp + p * 64 + q0 + 4 * fq, pt); }
    }
    __syncthreads();
    {
        bf16* Y0p = (bf16*)(F.ws + WS_Y0) + (size_t)item * 4096; bf16* QCp = (bf16*)(F.ws + WS_QC) + (size_t)item * 4096;
#pragma unroll
        for (int q = 0; q < 2; ++q) { const int tw = 2 * w + q, p0 = 16 * (tw >> 2), q0 = 16 * (tw & 3); const int p = p0 + fr;
            f32x4 y0 = mm_tile(L + L_VT, LD, q0, L + L_NRK, LD, p0, 2, Z4, fr, fq);
            y0 = mm_tile(L + L_U0T, LD, q0, L + L_NRB, LD, p0, 2, y0, fr, fq);
            f32x4 qc = mm_tile(L + L_KH, LD, q0, L + L_VT, LD, p0, 2, Z4, fr, fq);
            qc = mm_tile(L + L_BH, LD, q0, L + L_U0T, LD, p0, 2, qc, fr, fq);
            st4_g(Y0p + p * 64 + q0 + 4 * fq, y0); st4_g(QCp + p * 64 + q0 + 4 * fq, qc); }
    }
    __syncthreads();
}
__device__ __forceinline__ void rwkv_state_scan(Frame& F, int bh) {
    LAS unsigned char* L = F.lds;
    const int lane = F.lane, w = F.wave, fr = lane & 15, fq = lane >> 4;
    const bf16* PT = (const bf16*)(F.ws + WS_PT) + (size_t)bh * NCH * 4096; const bf16* QC = (const bf16*)(F.ws + WS_QC) + (size_t)bh * NCH * 4096;
    bf16* S = (bf16*)(F.ws + WS_S) + (size_t)bh * NCH * 4096;
    f32x4 acc[2]; acc[0] = (f32x4){0.f, 0.f, 0.f, 0.f}; acc[1] = acc[0];
    for (int c = 0; c < NCH; ++c) {
        bf16x8 pf[2][2]; f32x4 qi[2];
#pragma unroll
        for (int q = 0; q < 2; ++q) { const int tw = 2 * w + q, p0 = 16 * (tw >> 2), q0 = 16 * (tw & 3);
            const int o = (p0 + fr) * 64 + q0 + 4 * fq;
            st4_g(S + (size_t)c * 4096 + o, acc[q]);
            st4_lds(L + (c & 1) * ARR + (p0 + fr) * LD + (q0 + 4 * fq) * 2, acc[q]);
            pf[q][0] = *(const GAS bf16x8*)(PT + (size_t)c * 4096 + (q0 + fr) * 64 + fq * 8); pf[q][1] = *(const GAS bf16x8*)(PT + (size_t)c * 4096 + (q0 + fr) * 64 + 32 + fq * 8);
            qi[q] = ld4_g(QC + (size_t)c * 4096 + o); }
        __syncthreads();
#pragma unroll
        for (int q = 0; q < 2; ++q) { const int tw = 2 * w + q, p0 = 16 * (tw >> 2);
            const LAS unsigned char* sp = L + (c & 1) * ARR + (p0 + fr) * LD + fq * 16;
            const bf16x8 s0 = *(const LAS bf16x8*)sp, s1 = *(const LAS bf16x8*)(sp + 64);
            f32x4 a = qi[q];
            a = __builtin_amdgcn_mfma_f32_16x16x32_bf16(pf[q][0], s0, a, 0, 0, 0);
            a = __builtin_amdgcn_mfma_f32_16x16x32_bf16(pf[q][1], s1, a, 0, 0, 0);
            acc[q] = a; }
    }
    __syncthreads();
}
__device__ __forceinline__ void rwkv_chunk_out(Frame& F, int item) {
    const float* PRM = (const float*)(F.ws + WS_PRM);
    LAS unsigned char* L = F.lds;
    const int lane = F.lane, w = F.wave, fr = lane & 15, fq = lane >> 4;
    const int bh = item / NCH, c = item % NCH, b = bh / RW_H, h = bh % RW_H; const int row0 = b * T + c * CH;
    const bf16* S = (const bf16*)(F.ws + WS_S) + (size_t)item * 4096; const bf16* RP = (const bf16*)(F.ws + WS_RP) + (size_t)item * 4096; const bf16* Y0 = (const bf16*)(F.ws + WS_Y0) + (size_t)item * 4096;
#pragma unroll
    for (int q = 0; q < 2; ++q) { const int tw = 2 * w + q, p0 = 16 * (tw >> 2), q0 = 16 * (tw & 3);
        f32x4 a = ld4_g(Y0 + (p0 + fr) * 64 + q0 + 4 * fq);
#pragma unroll
        for (int k = 0; k < 2; ++k) { const bf16x8 sf = *(const GAS bf16x8*)(S + (q0 + fr) * 64 + k * 32 + fq * 8), rf = *(const GAS bf16x8*)(RP + (p0 + fr) * 64 + k * 32 + fq * 8);
            a = __builtin_amdgcn_mfma_f32_16x16x32_bf16(sf, rf, a, 0, 0, 0); }
#pragma unroll
        for (int v = 0; v < 4; ++v) *(LAS float*)(L + L_YL + ((p0 + fr) * 65 + q0 + 4 * fq + v) * 4) = a[v];
    }
    __syncthreads();
    {
        const int ch = lane, gc = h * 64 + ch; const float gw = (PRM + 4608)[gc], gb = (PRM + 5120)[gc];
        const bf16* VB = (const bf16*)(F.ws + WS_VB) + (size_t)item * 4096; const bf16* G = (const bf16*)(F.ws + WS_G) + (size_t)item * 4096;
        bf16* YM = (bf16*)(F.ws + WS_YMIX);
#pragma unroll
        for (int tt = 0; tt < 8; ++tt) { const int t = 8 * w + tt;
            const float y = *(const LAS float*)(L + L_YL + (t * 65 + ch) * 4);
            const float mean = wave_sum(y) * (1.f / 64.f); const float d = y - mean; const float var = wave_sum(d * d) * (1.f / 64.f);
            const float yn = d * __builtin_amdgcn_rsqf(var + GN_EPS) * gw + gb;
            const float o = (yn + bf2f(VB[t * 64 + ch])) * bf2f(G[t * 64 + ch]);
            YM[(size_t)(row0 + t) * D + gc] = (bf16)f2bf(o); }
    }
    __syncthreads();
}
__device__ __forceinline__ void diff_post_rows(Frame& F) {
    const float* PRM = (const float*)(F.ws + WS_PRM);
    const int lane = F.lane; const int gw = F.vcu * NWAVES + F.wave, NGW = F.G * NWAVES;
    const float l1 = wave_sum((PRM + 5632)[lane] * (PRM + 5696)[lane]), l2 = wave_sum((PRM + 5760)[lane] * (PRM + 5824)[lane]);
    const float lam = __expf(l1) - __expf(l2) + LAMBDA_INIT;
    const int e0 = 2 * lane, vh = e0 >> 6, d = e0 & 63;
    const float sw0 = (PRM + 5888)[e0] * (1.f - LAMBDA_INIT), sw1 = (PRM + 5888)[e0 + 1] * (1.f - LAMBDA_INIT);
    const bf16* O = (const bf16*)(F.ws + WS_O); bf16* YM = (bf16*)(F.ws + WS_YMIX);
    for (int m = gw; m < M; m += NGW) {
#pragma unroll
        for (int hd = 0; hd < 4; ++hd) {
            const unsigned w1 = *(const GAS unsigned*)(O + (size_t)m * 1024 + (hd * 4 + vh) * 64 + d), w2 = *(const GAS unsigned*)(O + (size_t)m * 1024 + (hd * 4 + 2 + vh) * 64 + d);
            const float o0 = bflo(w1) - lam * bflo(w2), o1 = bfhi(w1) - lam * bfhi(w2);
            const float rs = __builtin_amdgcn_rsqf(wave_sum(o0 * o0 + o1 * o1) * (1.f / 128.f) + SUBLN_EPS);
            *(GAS unsigned*)(YM + (size_t)m * D + 512 + hd * 128 + e0) = pk2(o0 * rs * sw0, o1 * rs * sw1);
        }
    }
}
__global__ void __launch_bounds__(NWAVES * 64, 2) hybrid_fwd(const Args A) {
    extern __shared__ __attribute__((aligned(16))) unsigned char lds[];
    Frame F;
    F.lds = (LAS unsigned char*)lds;
    F.tid = threadIdx.x; F.lane = F.tid & 63; F.wave = __builtin_amdgcn_readfirstlane(F.tid >> 6);
    F.G = gridDim.x; { const int bx = blockIdx.x; F.vcu = (F.G % 8 == 0) ? (bx % 8) * (F.G / 8) + bx / 8 : bx; }
    F.ws = A.ws; F.ctl = (unsigned*)(A.ws + WS_CTL); F.out = A.out;
    const int lo = A.ph_lo, hi = A.ph_hi;
    cg::grid_group grid = cg::this_grid();
    volatile LAS unsigned* MISC = (volatile LAS unsigned*)(F.lds + L_MISC);
    if (F.tid < 16) MISC[F.tid] = 0u;
    __syncthreads();
    XcdBarrier bar; bar.bar = F.ctl + CW_BAR; bar.x = 0; bar.st = nullptr;
    if (hi - lo > 1) bar = xcd_barrier_post(F.ctl + CW_BAR, MISC + 8);
    const float* PRM = (const float*)(F.ws + WS_PRM);
#define IN(k) (lo <= (k) && (k) < hi)
#define SEAM(k) do { if (IN(k) && IN((k) + 1)) { if ((k) == 0) grid.sync(); else xcd_barrier(bar); } } while (0)
    bf16* XN = (bf16*)(F.ws + WS_XN); bf16* ACT = (bf16*)(F.ws + WS_ACT); float* Y = (float*)(F.ws + WS_Y); float* YMo = (float*)(F.ws + WS_YM);

    if (IN(0)) { p0_prologue(F, A); } SEAM(0);
    if (IN(1)) { pg8::Gemm g{XN, (const bf16*)(F.ws + WS_WGU1), M, NGU, D}; pg8::StaticOrder S; S.init(M, NGU, F.G, (int)blockIdx.x);
        pg8::EpiSwiGLU E{ACT, FF}; pg8::gemm_phase<pg8::EpiSwiGLU, pg8::StaticOrder, true, true>(F.lds, g, S, E); } SEAM(1);
    if (IN(2)) { pg8::Gemm g{ACT, (const bf16*)(F.ws + WS_WD1), M, D, FF}; pg8::StaticOrder S; S.init(M, D, F.G, (int)blockIdx.x);
        pg8::EpiF32 E{Y, D}; pg8::gemm_phase<pg8::EpiF32, pg8::StaticOrder, true, true>(F.lds, g, S, E); } SEAM(2);
    if (IN(3)) { norm_rows<1>(F, A.in[0], Y, PRM + 6144, 0.5f, F.out, PRM + 7168, XN); } SEAM(3);
    if (IN(4)) { pg8::Gemm g{XN, (const bf16*)(F.ws + WS_WIN), M, NPW, D}; pg8::StaticOrder S; S.init(M, NPW, F.G, (int)blockIdx.x);
        pg8::EpiP E{(bf16*)(F.ws + WS_PRW), PRW, (bf16*)(F.ws + WS_PDF), PDF}; pg8::gemm_phase<pg8::EpiP, pg8::StaticOrder, true, true>(F.lds, g, S, E); } SEAM(4);
    if (IN(5)) { for (int it = F.vcu; it < NITEM; it += F.G) rwkv_chunk_prep(F, it); } SEAM(5);
    if (IN(6)) {
        if (F.vcu < BATCH * RW_H) rwkv_state_scan(F, F.vcu);
        LAS unsigned* misc = (LAS unsigned*)(F.lds + L_MISC);
        const attn_body::bf16* Pd = (const attn_body::bf16*)(F.ws + WS_PDF);
        for (;;) {
            if (F.tid == 0) misc[0] = atomicAdd(F.ctl + CW_QUEUE, 1u);
            __syncthreads(); const unsigned idx = misc[0]; __syncthreads();
            if (idx >= 1024u) break;
            const int qb = 15 - (int)(idx >> 6), bhv = (int)(idx & 63u);
            attn_body::attn_unit<8>(bhv >> 4, bhv & 15, qb, Pd, Pd, Pd, (attn_body::bf16*)(F.ws + WS_O), (char*)lds);
        }
    } SEAM(6);
    if (IN(7)) { for (int it = F.vcu; it < NITEM; it += F.G) rwkv_chunk_out(F, it); diff_post_rows(F); } SEAM(7);
    if (IN(8)) { pg8::Gemm g{(const bf16*)(F.ws + WS_YMIX), (const bf16*)(F.ws + WS_WO), M, D, D}; pg8::StaticOrder S; S.init(M, D, F.G, (int)blockIdx.x);
        pg8::EpiF32 E{YMo, D}; pg8::gemm_phase<pg8::EpiF32, pg8::StaticOrder, true, true>(F.lds, g, S, E); } SEAM(8);
    if (IN(9)) { norm_rows<1>(F, F.out, YMo, PRM + 8192, 1.0f, F.out, PRM + 9216, XN); } SEAM(9);
    if (IN(10)) { pg8::Gemm g{XN, (const bf16*)(F.ws + WS_WGU2), M, NGU, D}; pg8::StaticOrder S; S.init(M, NGU, F.G, (int)blockIdx.x);
        pg8::EpiSwiGLU E{ACT, FF}; pg8::gemm_phase<pg8::EpiSwiGLU, pg8::StaticOrder, true, true>(F.lds, g, S, E); } SEAM(10);
    if (IN(11)) { pg8::Gemm g{ACT, (const bf16*)(F.ws + WS_WD2), M, D, FF}; pg8::StaticOrder S; S.init(M, D, F.G, (int)blockIdx.x);
        pg8::EpiF32 E{Y, D}; pg8::gemm_phase<pg8::EpiF32, pg8::StaticOrder, true, true>(F.lds, g, S, E); } SEAM(11);
    if (IN(12)) { norm_rows<2>(F, F.out, Y, PRM + 10240, 0.5f, F.out, nullptr, nullptr); }
#undef IN
#undef SEAM
}

extern "C" void kernel_launch(void* const* d_in, const int* in_sizes, int n_in, void* d_out, int out_size, void* d_ws, size_t ws_size, hipStream_t stream) {
    static int grid = 0;
    if (grid == 0) {
        if (n_in != 31 || in_sizes[0] != M * D || out_size != M * D || ws_size < WS_END) { fprintf(stderr, "kernel_launch: unexpected shapes (n_in %d, in0 %d, out %d, ws %zu); nothing launched\n", n_in, n_in > 0 ? in_sizes[0] : -1, out_size, ws_size); grid = -1; return; }
        int dev = 0, cus = 0, per_cu = 0;
        if (hipGetDevice(&dev) != hipSuccess || hipDeviceGetAttribute(&cus, hipDeviceAttributeMultiprocessorCount, dev) != hipSuccess) { grid = -1; return; }
        if (hipFuncSetAttribute((const void*)hybrid_fwd, hipFuncAttributeMaxDynamicSharedMemorySize, LDS_BYTES) != hipSuccess) { fprintf(stderr, "kernel_launch: hipFuncSetAttribute failed\n"); grid = -1; return; }
        if (hipOccupancyMaxActiveBlocksPerMultiprocessor(&per_cu, (const void*)hybrid_fwd, NWAVES * 64, LDS_BYTES) != hipSuccess || per_cu < 1) { fprintf(stderr, "kernel_launch: occupancy query reports %d workgroups per CU\n", per_cu); per_cu = 1; }
        (void)hipGetLastError();
        grid = cus;
    }
    if (grid < 0) return;
    (void)hipMemsetAsync((char*)d_ws + WS_CTL, 0, CTL_ZERO_BYTES, stream);
    Args a{};
    for (int i = 0; i < 31; ++i) a.in[i] = (const float*)d_in[i];
    a.out = (float*)d_out; a.ws = (unsigned char*)d_ws;
#if MK_PER_PHASE
    for (int p = 0; p < N_PHASES; ++p) { a.ph_lo = p; a.ph_hi = p + 1; hipLaunchKernelGGL(hybrid_fwd, dim3(grid), dim3(NWAVES * 64), LDS_BYTES, stream, a); }
#else
    a.ph_lo = 0; a.ph_hi = N_PHASES;
    void* kargs[] = {&a};
    const hipError_t e = hipLaunchCooperativeKernel((const void*)hybrid_fwd, dim3(grid), dim3(NWAVES * 64), kargs, LDS_BYTES, stream);
    if (e != hipSuccess) fprintf(stderr, "kernel_launch: cooperative launch failed: %s (grid %d)\n", hipGetErrorString(e), grid);
#endif
}
```

```cpp
#include <hip/hip_runtime.h>
#include <hip/hip_cooperative_groups.h>
#include <cstdio>
#include <cstdint>
namespace cg = cooperative_groups;
__device__ __forceinline__ int lane_id_asm() { int l; asm volatile("v_mbcnt_lo_u32_b32 %0, -1, 0\n\tv_mbcnt_hi_u32_b32 %0, -1, %0" : "=v"(l)); return l; }
namespace pg8 {
#define PG8_LAS __attribute__((address_space(3)))
typedef unsigned short bf16_t;
typedef short bf16x8 __attribute__((ext_vector_type(8)));
typedef float f32x4 __attribute__((ext_vector_type(4)));
typedef unsigned u32x4 __attribute__((ext_vector_type(4)));
constexpr int BM = 256, BK = 64, HALF = 128, HTB = HALF * BK * 2  , STAGE_BYTES = 8 * HTB, NXCD = 8, WGM = 8;

__host__ __device__ __forceinline__ int lds_byte(int r, int c) { const int st = (r >> 4) * 2 + (c >> 5), rr = r & 15, cc = c & 31, ob = rr * 64 + cc * 2; return st * 1024 + (ob ^ (((ob >> 9) & 1) << 5)); }
__host__ __device__ __forceinline__ void stage_rc(int b, int& R, int& C) { const int st = b / 1024, sb = b % 1024, swz = sb ^ (((sb >> 9) & 1) << 5); R = (st >> 1) * 16 + swz / 64; C = (st & 1) * 32 + (swz % 64) / 2; }
__host__ __device__ __forceinline__ int perm32(int rho) { const int n = rho >> 4, i = rho & 15; return 8 * (i >> 2) + 4 * n + (i & 3); }

struct Unit { int pm, pn; };
struct Gemm { const bf16_t* A; const bf16_t* Bt; int M, N, K; };

struct StaticOrder {
    int nM, nN, nwg, G, c;
    __host__ __device__ void init(int M, int N, int G_, int c_) { nM = M / BM; nN = N / BM; nwg = nM * nN; G = G_; c = c_; }
    __host__ __device__ bool next(int i, Unit& u) const {
        const long L = (long)i * G + c; if (L >= nwg) return false;
        int wgid = (int)L; { const int q = nwg / NXCD, r = nwg % NXCD, xcd = wgid % NXCD, off = wgid / NXCD; wgid = (xcd < r ? xcd * (q + 1) : r * (q + 1) + (xcd - r) * q) + off; }
        const int nig = WGM * nN, gid = wgid / nig, fm = gid * WGM, gsz = (nM - fm) < WGM ? (nM - fm) : WGM;
        u.pm = fm + ((wgid % nig) % gsz); u.pn = (wgid % nig) / gsz; return true;
    }
    __device__ __forceinline__ void a_ready(const Unit&) const {}
    __device__ __forceinline__ void done(const Unit&) const {}
};

__device__ __forceinline__ unsigned cvt_pk_bf16(float lo, float hi) { unsigned r; asm volatile("v_cvt_pk_bf16_f32 %0, %1, %2" : "=v"(r) : "v"(lo), "v"(hi)); return r; }
__device__ __forceinline__ float silu_mul(float g, float u) { return g * __builtin_amdgcn_rcpf(1.0f + __builtin_amdgcn_exp2f(-1.4426950408889634f * g)) * u; }
struct EpiSwiGLU {
    static constexpr bool PERM = true, AFTER_DRAIN = false;
    bf16_t* O; int ldc;
    __device__ __forceinline__ void operator()(const f32x4 (&acc)[2][2][4][2], const Unit& u, int wr, int wc, int fr, int fq) const {
        const int row0 = u.pm * BM + wr * 64 + fr, col0 = u.pn * HALF + wc * 32 + 8 * fq;
#pragma unroll
        for (int ai = 0; ai < 2; ++ai)
#pragma unroll
            for (int m = 0; m < 4; ++m) { bf16_t* rowp = O + (size_t)(row0 + ai * HALF + m * 16) * ldc + col0;
                const f32x4 g0 = acc[ai][0][m][0], g1 = acc[ai][0][m][1], u0 = acc[ai][1][m][0], u1 = acc[ai][1][m][1];
                u32x4 w; w.x = cvt_pk_bf16(silu_mul(g0[0], u0[0]), silu_mul(g0[1], u0[1])); w.y = cvt_pk_bf16(silu_mul(g0[2], u0[2]), silu_mul(g0[3], u0[3]));
                w.z = cvt_pk_bf16(silu_mul(g1[0], u1[0]), silu_mul(g1[1], u1[1])); w.w = cvt_pk_bf16(silu_mul(g1[2], u1[2]), silu_mul(g1[3], u1[3]));
                *(u32x4*)rowp = w; }
    }
};
struct EpiF32 {
    static constexpr bool PERM = false, AFTER_DRAIN = false;
    float* O; int ldc;
    __device__ __forceinline__ void operator()(const f32x4 (&acc)[2][2][4][2], const Unit& u, int wr, int wc, int fr, int fq) const {
        const int row0 = u.pm * BM + wr * 64 + fr, col0 = u.pn * BM + wc * 32 + 4 * fq;
#pragma unroll
        for (int ai = 0; ai < 2; ++ai)
#pragma unroll
            for (int m = 0; m < 4; ++m) { float* rowp = O + (size_t)(row0 + ai * HALF + m * 16) * ldc + col0;
#pragma unroll
                for (int bj = 0; bj < 2; ++bj)
#pragma unroll
                    for (int n = 0; n < 2; ++n) *(f32x4*)(rowp + bj * HALF + n * 16) = acc[ai][bj][m][n]; }
    }
};
struct EpiP {
    static constexpr bool PERM = true, AFTER_DRAIN = false;
    bf16_t* O0; int ld0; bf16_t* O1; int ld1;
    __device__ __forceinline__ void operator()(const f32x4 (&acc)[2][2][4][2], const Unit& u, int wr, int wc, int fr, int fq) const {
        const int row0 = u.pm * BM + wr * 64 + fr; const bool first = u.pn < 8;
        bf16_t* base = first ? O0 : O1; const int ldc = first ? ld0 : ld1; const int col0 = (first ? u.pn : u.pn - 8) * BM + wc * 32 + 8 * fq;
#pragma unroll
        for (int ai = 0; ai < 2; ++ai)
#pragma unroll
            for (int m = 0; m < 4; ++m) { bf16_t* rowp = base + (size_t)(row0 + ai * HALF + m * 16) * ldc + col0;
#pragma unroll
                for (int bj = 0; bj < 2; ++bj) { const f32x4 v0 = acc[ai][bj][m][0], v1 = acc[ai][bj][m][1];
                    u32x4 w; w.x = cvt_pk_bf16(v0[0], v0[1]); w.y = cvt_pk_bf16(v0[2], v0[3]); w.z = cvt_pk_bf16(v1[0], v1[1]); w.w = cvt_pk_bf16(v1[2], v1[3]);
                    *(u32x4*)(rowp + bj * HALF) = w; } }
    }
};

struct PanelRms {
    float* xbuf;
    unsigned* cnt;
    float eps;
    __device__ __forceinline__ void run(const f32x4 (&v)[2][2][4][2], const Unit& u, int wr, int wc, int fr, int fq, PG8_LAS unsigned char* lds, int wid, int lane) const {
        PG8_LAS float* P = (PG8_LAS float*)lds;
        PG8_LAS float* S = (PG8_LAS float*)(lds + 8192);
#pragma unroll
        for (int ai = 0; ai < 2; ++ai)
#pragma unroll
            for (int m = 0; m < 4; ++m) {
                float s = 0.f;
#pragma unroll
                for (int bj = 0; bj < 2; ++bj)
#pragma unroll
                    for (int n = 0; n < 2; ++n) { const f32x4 x = v[ai][bj][m][n]; s += (x[0] * x[0] + x[1] * x[1]) + (x[2] * x[2] + x[3] * x[3]); }
                s += __shfl_xor(s, 16); s += __shfl_xor(s, 32);
                if (fq == 0) P[(ai * HALF + wr * 64 + m * 16 + fr) * 4 + wc] = s;
            }
        asm volatile("s_waitcnt lgkmcnt(0)" ::: "memory"); __builtin_amdgcn_s_barrier(); asm volatile("" ::: "memory");
        const int row = wid * 32 + (lane & 31);
        if (lane < 32) {
            const float t = (P[row * 4 + 0] + P[row * 4 + 1]) + (P[row * 4 + 2] + P[row * 4 + 3]);
            __hip_atomic_store(xbuf + ((size_t)(u.pm * BM + row) * 4 + u.pn), t, __ATOMIC_RELAXED, __HIP_MEMORY_SCOPE_AGENT);
        }
        asm volatile("s_waitcnt vmcnt(0)" ::: "memory");
        if (lane == 0) __hip_atomic_fetch_add(cnt + 64 * u.pm, 1u, __ATOMIC_RELAXED, __HIP_MEMORY_SCOPE_AGENT);
        if (wid == 0) {
            unsigned spins = 0;
            for (;;) {
                if ((unsigned)__builtin_amdgcn_readfirstlane(__hip_atomic_load(cnt + 64 * u.pm, __ATOMIC_RELAXED, __HIP_MEMORY_SCOPE_AGENT)) >= 32u) break;
                if (++spins > (1u << 22)) break;
                __builtin_amdgcn_s_sleep(2);
            }
            __builtin_amdgcn_fence(__ATOMIC_ACQUIRE, "agent");
        }
        asm volatile("s_waitcnt vmcnt(0) lgkmcnt(0)" ::: "memory"); __builtin_amdgcn_s_barrier(); asm volatile("" ::: "memory");
        if (lane < 32) {
            const float* slot = xbuf + (size_t)(u.pm * BM + row) * 4; float q = 0.f;
#pragma unroll
            for (int t = 0; t < 4; ++t) q += __hip_atomic_load(slot + t, __ATOMIC_RELAXED, __HIP_MEMORY_SCOPE_AGENT);
            S[row] = __builtin_amdgcn_rsqf(q * (1.0f / 1024.0f) + eps);
        }
        asm volatile("s_waitcnt lgkmcnt(0)" ::: "memory"); __builtin_amdgcn_s_barrier(); asm volatile("" ::: "memory");
    }
};
struct EpiRmsRes {
    static constexpr bool PERM = false, AFTER_DRAIN = true;
    const float* base; float* out; int ldc; const float* g1; float coef; PanelRms st;
    __device__ __forceinline__ void fused(f32x4 (&acc)[2][2][4][2], const Unit& u, int wr, int wc, int fr, int fq, PG8_LAS unsigned char* lds, int wid, int lane) const {
        const PG8_LAS float* S = (const PG8_LAS float*)(lds + 8192);
        const int col0 = u.pn * BM + wc * 32 + 4 * fq;
        st.run(acc, u, wr, wc, fr, fq, lds, wid, lane);
        f32x4 gv[2][2];
#pragma unroll
        for (int bj = 0; bj < 2; ++bj)
#pragma unroll
            for (int n = 0; n < 2; ++n) gv[bj][n] = *(const f32x4*)(g1 + col0 + bj * HALF + n * 16) * coef;
#pragma unroll
        for (int ai = 0; ai < 2; ++ai)
#pragma unroll
            for (int m = 0; m < 4; ++m) { const int r = ai * HALF + wr * 64 + m * 16 + fr; const float rs = S[r]; const size_t off = (size_t)(u.pm * BM + r) * ldc + col0;
#pragma unroll
                for (int bj = 0; bj < 2; ++bj)
#pragma unroll
                    for (int n = 0; n < 2; ++n) { const f32x4 bs = *(const f32x4*)(base + off + bj * HALF + n * 16); *(f32x4*)(out + off + bj * HALF + n * 16) = bs + acc[ai][bj][m][n] * gv[bj][n] * rs; }
                if (m & 1) asm volatile("" ::: "memory"); }
    }
};
struct EpiRmsResRms {
    static constexpr bool PERM = false, AFTER_DRAIN = true;
    const float* base; float* out; bf16_t* xn; int ldc; const float* g1; float coef; const float* g2; PanelRms st1, st2;
    __device__ __forceinline__ void fused(f32x4 (&acc)[2][2][4][2], const Unit& u, int wr, int wc, int fr, int fq, PG8_LAS unsigned char* lds, int wid, int lane) const {
        typedef unsigned u32x2v __attribute__((ext_vector_type(2)));
        const PG8_LAS float* S = (const PG8_LAS float*)(lds + 8192);
        const int col0 = u.pn * BM + wc * 32 + 4 * fq;
        st1.run(acc, u, wr, wc, fr, fq, lds, wid, lane);
        {
            f32x4 gv[2][2];
#pragma unroll
            for (int bj = 0; bj < 2; ++bj)
#pragma unroll
                for (int n = 0; n < 2; ++n) gv[bj][n] = *(const f32x4*)(g1 + col0 + bj * HALF + n * 16) * coef;
#pragma unroll
            for (int ai = 0; ai < 2; ++ai)
#pragma unroll
                for (int m = 0; m < 4; ++m) { const int r = ai * HALF + wr * 64 + m * 16 + fr; const float rs = S[r]; const size_t off = (size_t)(u.pm * BM + r) * ldc + col0;
#pragma unroll
                    for (int bj = 0; bj < 2; ++bj)
#pragma unroll
                        for (int n = 0; n < 2; ++n) { const f32x4 bs = *(const f32x4*)(base + off + bj * HALF + n * 16); acc[ai][bj][m][n] = bs + acc[ai][bj][m][n] * gv[bj][n] * rs; }
                    asm volatile("" : "+v"(acc[ai][0][m][0]), "+v"(acc[ai][0][m][1]), "+v"(acc[ai][1][m][0]), "+v"(acc[ai][1][m][1]));
                    if (m & 1) asm volatile("" ::: "memory"); }
        }
        st2.run(acc, u, wr, wc, fr, fq, lds, wid, lane);
        f32x4 gv[2][2];
#pragma unroll
        for (int bj = 0; bj < 2; ++bj)
#pragma unroll
            for (int n = 0; n < 2; ++n) gv[bj][n] = *(const f32x4*)(g2 + col0 + bj * HALF + n * 16);
#pragma unroll
        for (int ai = 0; ai < 2; ++ai)
#pragma unroll
            for (int m = 0; m < 4; ++m) { const int r = ai * HALF + wr * 64 + m * 16 + fr; const float rs = S[r]; const size_t off = (size_t)(u.pm * BM + r) * ldc + col0;
#pragma unroll
                for (int bj = 0; bj < 2; ++bj)
#pragma unroll
                    for (int n = 0; n < 2; ++n) { const f32x4 x1 = acc[ai][bj][m][n]; *(f32x4*)(out + off + bj * HALF + n * 16) = x1;
                        const f32x4 o = x1 * gv[bj][n] * rs; u32x2v w; w.x = cvt_pk_bf16(o[0], o[1]); w.y = cvt_pk_bf16(o[2], o[3]); *(u32x2v*)(xn + off + bj * HALF + n * 16) = w; }
                asm volatile("" ::: "memory"); }
    }
};

template <class Epi, class Sched, bool ALIGN_EPI = false, bool SP2 = false>
__device__ __forceinline__ void gemm_phase(PG8_LAS unsigned char* lds, const Gemm g, const Sched& S, const Epi& E, const int wid) {
    const int lane = lane_id_asm(), tid = wid * 64 + lane, wr = wid >> 2, wc = wid & 3, fr = lane & 15, fq = lane >> 4;
    const int K = g.K, nt = K / BK;
    unsigned voffA[2], voffB[2];
#pragma unroll
    for (int i = 0; i < 2; ++i) { int R, C; stage_rc(tid * 16 + i * 8192, R, C); const int Rb = Epi::PERM ? ((R & ~31) + perm32(R & 31)) : R;
        voffA[i] = (unsigned)(R * K + C) * 2u; voffB[i] = (unsigned)(Rb * K + C) * 2u; }
    const size_t kstep = (size_t)(BK * 2);
    const size_t hstep = (size_t)HALF * K * 2;
    const size_t tstep = 2 * hstep;
    const unsigned ldsw = (unsigned)wid * 1024u;
    const int aoff = lds_byte(wr * 64 + fr, fq * 8), boff = lds_byte(wc * 32 + fr, fq * 8);
#define PG8_SA(b, h) (((b) * 2 + (h)) * HTB)
#define PG8_SB(b, h) ((4 + (b) * 2 + (h)) * HTB)
#define PG8_STAGE(bufoff, gbase, voff) do { _Pragma("unroll") for (int _i = 0; _i < 2; ++_i) \
        __builtin_amdgcn_global_load_lds((const unsigned*)((const char*)(gbase) + (voff)[_i]), (PG8_LAS unsigned*)(lds + (bufoff) + ldsw + _i * 8192), 16, 0, 0); } while (0)
#define PG8_LDA(dst, b, h) do { _Pragma("unroll") for (int m = 0; m < 4; ++m) _Pragma("unroll") for (int k = 0; k < 2; ++k) dst[m][k] = *(const PG8_LAS bf16x8*)(lds + PG8_SA(b, h) + aoff + m * 2048 + k * 1024); } while (0)
#define PG8_LDB(dst, b, h) do { _Pragma("unroll") for (int n = 0; n < 2; ++n) _Pragma("unroll") for (int k = 0; k < 2; ++k) dst[n][k] = *(const PG8_LAS bf16x8*)(lds + PG8_SB(b, h) + boff + n * 2048 + k * 1024); } while (0)
#define PG8_MMA(ai, bj, At, Bt) do { __builtin_amdgcn_s_setprio(1); _Pragma("unroll") for (int m = 0; m < 4; ++m) _Pragma("unroll") for (int n = 0; n < 2; ++n) _Pragma("unroll") for (int k = 0; k < 2; ++k) \
        acc[ai][bj][m][n] = __builtin_amdgcn_mfma_f32_16x16x32_bf16(Bt[n][k], At[m][k], acc[ai][bj][m][n], 0, 0, 0); __builtin_amdgcn_s_setprio(0); } while (0)
#define PG8_WAIT_V(n) asm volatile("s_waitcnt vmcnt(" #n ")" ::: "memory")
#define PG8_WAIT_L(n) asm volatile("s_waitcnt lgkmcnt(" #n ")" ::: "memory")
#define PG8_BAR __builtin_amdgcn_s_barrier()
#define PG8_SCHED __builtin_amdgcn_sched_barrier(0)
    Unit cur, nxt; int ui = 0;
    if (!S.next(0, cur)) return;
    f32x4 acc[2][2][4][2];
#pragma unroll
    for (int a = 0; a < 2; ++a)
#pragma unroll
        for (int b = 0; b < 2; ++b)
#pragma unroll
            for (int m = 0; m < 4; ++m)
#pragma unroll
                for (int n = 0; n < 2; ++n) acc[a][b][m][n] = (f32x4){0.f, 0.f, 0.f, 0.f};
    bf16x8 At[4][2], B0[2][2], B1[2][2];
    const char* cA = (const char*)g.A + (size_t)cur.pm * tstep; const char* cB = (const char*)g.Bt + (size_t)cur.pn * tstep;
    S.a_ready(cur);
    if constexpr (SP2) {
        PG8_STAGE(PG8_SB(0, 0), cB, voffB); PG8_STAGE(PG8_SB(0, 1), cB + hstep, voffB); PG8_STAGE(PG8_SA(0, 0), cA, voffA); PG8_STAGE(PG8_SA(0, 1), cA + hstep, voffA);
        if (wr == 1) PG8_BAR;
        PG8_WAIT_V(2); PG8_BAR;
        PG8_STAGE(PG8_SB(1, 0), cB + kstep, voffB); PG8_STAGE(PG8_SA(1, 0), cA + kstep, voffA); PG8_STAGE(PG8_SB(1, 1), cB + hstep + kstep, voffB);
        PG8_WAIT_V(6); PG8_BAR;
    } else {
        PG8_STAGE(PG8_SB(0, 0), cB, voffB); PG8_STAGE(PG8_SA(0, 0), cA, voffA); PG8_STAGE(PG8_SB(0, 1), cB + hstep, voffB); PG8_STAGE(PG8_SA(0, 1), cA + hstep, voffA);
        if (wr == 1) PG8_BAR;
        PG8_WAIT_V(4); PG8_BAR;
        PG8_STAGE(PG8_SB(1, 0), cB + kstep, voffB); PG8_STAGE(PG8_SA(1, 0), cA + kstep, voffA); PG8_STAGE(PG8_SB(1, 1), cB + hstep + kstep, voffB);
        PG8_WAIT_V(6); PG8_BAR;
    }
    for (;;) {
        const bool has_next = S.next(ui + 1, nxt);
        const char* nA = has_next ? (const char*)g.A + (size_t)nxt.pm * tstep : cA; const char* nB = has_next ? (const char*)g.Bt + (size_t)nxt.pn * tstep : cB;
        for (int t = 0; t < nt; t += 2) {
            const bool last = (t == nt - 2);
            const char* a1 = cA + (size_t)(t + 1) * kstep;
            const char* a2 = last ? nA : cA + (size_t)(t + 2) * kstep; const char* b2 = last ? nB : cB + (size_t)(t + 2) * kstep;
            const char* a3 = a2 + kstep; const char* b3 = b2 + kstep;
            if (last && has_next) S.a_ready(nxt);
            if constexpr (SP2) {
            PG8_LDB(B0, 0, 0); PG8_LDB(B1, 0, 1); PG8_SCHED; PG8_LDA(At, 0, 0); PG8_STAGE(PG8_SA(1, 1), a1 + hstep, voffA);
            PG8_WAIT_V(8); PG8_WAIT_L(0); PG8_BAR; PG8_MMA(0, 0, At, B0); PG8_MMA(0, 1, At, B1); PG8_BAR; PG8_SCHED;
            PG8_LDA(At, 0, 1); PG8_STAGE(PG8_SB(0, 0), b2, voffB); PG8_STAGE(PG8_SB(0, 1), b2 + hstep, voffB); PG8_STAGE(PG8_SA(0, 0), a2, voffA);
            PG8_WAIT_V(8); PG8_WAIT_L(0); PG8_BAR; PG8_MMA(1, 0, At, B0); PG8_MMA(1, 1, At, B1); PG8_BAR; PG8_SCHED;
            PG8_LDB(B0, 1, 0); PG8_LDB(B1, 1, 1); PG8_SCHED; PG8_LDA(At, 1, 0); PG8_STAGE(PG8_SA(0, 1), a2 + hstep, voffA);
            PG8_WAIT_V(8); PG8_WAIT_L(0); PG8_BAR; PG8_MMA(0, 0, At, B0); PG8_MMA(0, 1, At, B1); PG8_BAR; PG8_SCHED;
            PG8_LDA(At, 1, 1); PG8_STAGE(PG8_SB(1, 0), b3, voffB); PG8_STAGE(PG8_SB(1, 1), b3 + hstep, voffB); PG8_STAGE(PG8_SA(1, 0), a3, voffA);
            PG8_WAIT_V(8); PG8_WAIT_L(0); PG8_BAR; PG8_MMA(1, 0, At, B0); PG8_MMA(1, 1, At, B1); PG8_BAR; PG8_SCHED;
            } else {
            PG8_LDB(B0, 0, 0); PG8_SCHED; PG8_LDA(At, 0, 0); PG8_STAGE(PG8_SA(1, 1), a1 + hstep, voffA);
            PG8_WAIT_L(8); PG8_BAR; PG8_WAIT_L(0); PG8_MMA(0, 0, At, B0); PG8_BAR; PG8_SCHED;
            PG8_LDB(B1, 0, 1); PG8_STAGE(PG8_SB(0, 0), b2, voffB);
            PG8_BAR; PG8_WAIT_L(0); PG8_MMA(0, 1, At, B1); PG8_BAR;
            PG8_LDA(At, 0, 1); PG8_STAGE(PG8_SA(0, 0), a2, voffA);
            PG8_BAR; PG8_WAIT_L(0); PG8_MMA(1, 0, At, B0); PG8_BAR; PG8_SCHED;
            PG8_STAGE(PG8_SB(0, 1), b2 + hstep, voffB);
            PG8_WAIT_V(6); PG8_BAR; PG8_MMA(1, 1, At, B1); PG8_BAR;
            PG8_LDB(B0, 1, 0); PG8_SCHED; PG8_LDA(At, 1, 0); PG8_STAGE(PG8_SA(0, 1), a2 + hstep, voffA);
            PG8_WAIT_L(8); PG8_BAR; PG8_WAIT_L(0); PG8_MMA(0, 0, At, B0); PG8_BAR; PG8_SCHED;
            PG8_LDB(B1, 1, 1); PG8_STAGE(PG8_SB(1, 0), b3, voffB);
            PG8_BAR; PG8_WAIT_L(0); PG8_MMA(0, 1, At, B1); PG8_BAR;
            PG8_LDA(At, 1, 1); PG8_STAGE(PG8_SA(1, 0), a3, voffA);
            PG8_BAR; PG8_WAIT_L(0); PG8_MMA(1, 0, At, B0); PG8_BAR; PG8_SCHED;
            PG8_STAGE(PG8_SB(1, 1), b3 + hstep, voffB);
            PG8_WAIT_V(6); PG8_BAR; PG8_MMA(1, 1, At, B1); PG8_BAR;
            }
        }
        if constexpr (ALIGN_EPI) { if (wr == 0) PG8_BAR; }
        if constexpr (!Epi::AFTER_DRAIN) { E(acc, cur, wr, wc, fr, fq); S.done(cur); }
        if (!has_next) break;
#pragma unroll
        for (int a = 0; a < 2; ++a)
#pragma unroll
            for (int b = 0; b < 2; ++b)
#pragma unroll
                for (int m = 0; m < 4; ++m)
#pragma unroll
                    for (int n = 0; n < 2; ++n) acc[a][b][m][n] = (f32x4){0.f, 0.f, 0.f, 0.f};
        cur = nxt; cA = nA; cB = nB; ++ui;
        if constexpr (ALIGN_EPI) { if (wr == 1) PG8_BAR; }
    }
    PG8_WAIT_V(0);
    if constexpr (!ALIGN_EPI) { if (wr == 0) PG8_BAR; }
    PG8_BAR;
    if constexpr (Epi::AFTER_DRAIN) { E.fused(acc, cur, wr, wc, fr, fq, lds, wid, lane); S.done(cur); }
#undef PG8_SA
#undef PG8_SB
#undef PG8_STAGE
#undef PG8_LDA
#undef PG8_LDB
#undef PG8_MMA
#undef PG8_WAIT_V
#undef PG8_WAIT_L
#undef PG8_BAR
#undef PG8_SCHED
}
}
#include <hip/hip_bf16.h>
#include <cmath>
namespace attn_body {
using bf16=__hip_bfloat16;
using bf16x8=__attribute__((ext_vector_type(8)))short;
using s16x4=__attribute__((ext_vector_type(4)))short;
using f32x16=__attribute__((ext_vector_type(16)))float;
using u32x4=__attribute__((ext_vector_type(4)))unsigned;
constexpr int BATCH=4,NHEAD=16,SEQ=4096,D=64,PD=1536,PO=1024;
constexpr int NW=8,QBLK=32,QB=QBLK*NW,KVBLK=64,NQB=SEQ/QB;
constexpr int ATTN_UNIT_ROWS=QB;
__device__ __forceinline__ int crow(int r,int hi){return (r&3)+8*(r>>2)+4*hi;}
#define SBAR() __builtin_amdgcn_sched_barrier(0)
__device__ __forceinline__ void cmask(f32x16&p0,f32x16&p1,int jb,int qrel,int hi){
  const float NEG=-INFINITY; int kb=64*jb+4*hi;
  #pragma unroll
  for(int r=0;r<16;++r){int kv=kb+(r&3)+8*(r>>2); if(kv>qrel)p0[r]=NEG; if(kv+32>qrel)p1[r]=NEG;}
}

constexpr int NSLOT=3, SLOTB=8192;
constexpr int LDS_K=0, LDS_V=NSLOT*SLOTB, LDS_WS=2*NSLOT*SLOTB, LDS_OST=LDS_WS+NW*64*4, LDS_BYTES=LDS_OST+NW*4096;
constexpr float C2=0.125f*1.4426950408889634f;
__device__ __forceinline__ void glds16(const void*gsrc,unsigned lds_dst){unsigned keep;
  asm volatile("s_mov_b32 %0, m0\n\ts_mov_b32 m0, %2\n\ts_nop 0\n\tglobal_load_lds_dwordx4 %1, off\n\ts_mov_b32 m0, %0":"=&s"(keep):"v"(gsrc),"s"(lds_dst):"memory");}
__device__ __forceinline__ float max3f(float a,float b,float c){float r;asm("v_max3_f32 %0, %1, %2, %3":"=v"(r):"v"(a),"v"(b),"v"(c));return r;}
__device__ __forceinline__ float max2f(float a,float b){float r;asm("v_max_f32_e32 %0, %1, %2":"=v"(r):"v"(a),"v"(b));return r;}
__device__ __forceinline__ float fadd_s(float a,float b){float r;asm("v_add_f32_e32 %0, %1, %2":"=v"(r):"v"(a),"v"(b));return r;}
__device__ __forceinline__ float fsub_s(float a,float b){float r;asm("v_sub_f32_e32 %0, %1, %2":"=v"(r):"v"(a),"v"(b));return r;}
typedef float f32x2_t __attribute__((ext_vector_type(2))); typedef __bf16 bf16x2_t __attribute__((ext_vector_type(2)));
__device__ __forceinline__ unsigned cvtpk_s(float lo,float hi){f32x2_t v={lo,hi};bf16x2_t b=__builtin_convertvector(v,bf16x2_t);return __builtin_bit_cast(unsigned,b);}
#define WAIT_BAR(N) asm volatile("s_waitcnt vmcnt(" #N ") lgkmcnt(0)\n\ts_barrier":::"memory")

__device__ __forceinline__ void qkt(f32x16&p0,f32x16&p1,const char*Kslot,const bf16x8*qr,const f32x16&negm,int r32,int hi){
  const char*kb=Kslot+hi*1024+r32*16;
  #pragma unroll
  for(int d0=0;d0<4;++d0){
    const bf16x8 b0=*reinterpret_cast<const bf16x8*>(kb+d0*2048);
    const bf16x8 b1=*reinterpret_cast<const bf16x8*>(kb+d0*2048+512);
    if(d0==0){p0=__builtin_amdgcn_mfma_f32_32x32x16_bf16(b0,qr[0],negm,0,0,0);p1=__builtin_amdgcn_mfma_f32_32x32x16_bf16(b1,qr[0],negm,0,0,0);}
    else{p0=__builtin_amdgcn_mfma_f32_32x32x16_bf16(b0,qr[d0],p0,0,0,0);p1=__builtin_amdgcn_mfma_f32_32x32x16_bf16(b1,qr[d0],p1,0,0,0);}}
}
typedef __attribute__((address_space(3))) const char* lds_cptr;
typedef short v4i16_t __attribute__((ext_vector_type(4)));
__device__ __forceinline__ void kload8(bf16x8*kf,lds_cptr kp){
  kf[0]=*(const __attribute__((address_space(3))) bf16x8*)(kp);      kf[1]=*(const __attribute__((address_space(3))) bf16x8*)(kp+512);
  kf[2]=*(const __attribute__((address_space(3))) bf16x8*)(kp+2048); kf[3]=*(const __attribute__((address_space(3))) bf16x8*)(kp+2560);
  kf[4]=*(const __attribute__((address_space(3))) bf16x8*)(kp+4096); kf[5]=*(const __attribute__((address_space(3))) bf16x8*)(kp+4608);
  kf[6]=*(const __attribute__((address_space(3))) bf16x8*)(kp+6144); kf[7]=*(const __attribute__((address_space(3))) bf16x8*)(kp+6656);
}
__device__ __forceinline__ void kload2(bf16x8*kf,lds_cptr kp,int j){ kf[2*j]=*(const __attribute__((address_space(3))) bf16x8*)(kp+j*2048); kf[2*j+1]=*(const __attribute__((address_space(3))) bf16x8*)(kp+j*2048+512); }
__device__ __forceinline__ s16x4 vtr(lds_cptr p){ return __builtin_bit_cast(s16x4,__builtin_amdgcn_ds_read_tr16_b64_v4i16((__attribute__((address_space(3))) v4i16_t*)p)); }
__device__ __forceinline__ float rowmax(const f32x16&p0,const f32x16&p1){
  float a=max3f(p0[0],p0[1],p1[0]),b=max3f(p0[2],p0[3],p1[1]);a=max3f(a,p1[2],p1[3]);
  #pragma unroll
  for(int r=4;r<16;r+=4){a=max3f(a,p0[r],p0[r+1]);b=max3f(b,p0[r+2],p0[r+3]);a=max3f(a,p1[r],p1[r+1]);b=max3f(b,p1[r+2],p1[r+3]);}
  const float m=max2f(a,b);
  auto rr=__builtin_amdgcn_permlane32_swap(__float_as_uint(m),__float_as_uint(m),false,false);
  return max2f(__uint_as_float(rr[0]),__uint_as_float(rr[1]));
}
__device__ __forceinline__ void pv(f32x16*o,int vb,bf16x8 pa0,bf16x8 pa1,bf16x8 pa2,bf16x8 pa3){
  #pragma unroll
  for(int d0=0;d0<2;++d0){s16x4 lo[4],hi[4];
    #pragma unroll
    for(int ks=0;ks<4;++ks){
      asm volatile("ds_read_b64_tr_b16 %0,%1 offset:%c2":"=&v"(lo[ks]):"v"(vb),"i"(d0*4096+ks*1024):"memory");
      asm volatile("ds_read_b64_tr_b16 %0,%1 offset:%c2":"=&v"(hi[ks]):"v"(vb),"i"(d0*4096+ks*1024+512):"memory");}
    asm volatile("s_waitcnt lgkmcnt(0)":::"memory");SBAR();
    #define PK(k) (bf16x8){lo[k][0],lo[k][1],lo[k][2],lo[k][3],hi[k][0],hi[k][1],hi[k][2],hi[k][3]}
    o[d0]=__builtin_amdgcn_mfma_f32_32x32x16_bf16(pa0,PK(0),o[d0],0,0,0);
    o[d0]=__builtin_amdgcn_mfma_f32_32x32x16_bf16(pa1,PK(1),o[d0],0,0,0);
    o[d0]=__builtin_amdgcn_mfma_f32_32x32x16_bf16(pa2,PK(2),o[d0],0,0,0);
    o[d0]=__builtin_amdgcn_mfma_f32_32x32x16_bf16(pa3,PK(3),o[d0],0,0,0);
    #undef PK
  }
}

#ifndef ATTN_STORE16
#define ATTN_STORE16(p,v) (*(u32x4*)(p)=(v))
#endif
template<int THRL> __device__ __forceinline__ void attn_unit(int b,int h,int qb,const bf16*Q,const bf16*__restrict__ K,const bf16*__restrict__ V,bf16*O,char*shm,const int wid){
  const int lane=lane_id_asm(),tid=wid*64+lane,r32=lane&31,hi=lane>>5;
  const long rowbase=(long)b*SEQ; const int q0=qb*QB;
  const int qcol=(h>>1)*64, kcol=512+(h>>1)*64, vcol=1024+(h>>2)*128+(h&1)*64, ocol=h*64;
  const bf16*Qw=Q+(rowbase+q0+wid*QBLK)*PD+qcol;
  const bf16*Kh=K+rowbase*PD+kcol,*Vh=V+rowbase*PD+vcol;
  const unsigned lds0=(unsigned)(uintptr_t)shm;
  float*wsf=(float*)(shm+LDS_WS)+wid*64;
  const bf16*ksrc=Kh+(long)lane*PD+wid*8;
  const bf16*vsrc=Vh+(long)(16*(wid&3)+(lane>>2))*PD+(wid>>2)*32+(lane&3)*8;
  const unsigned kdst=lds0+LDS_K+wid*1024, vdst=lds0+LDS_V+wid*1024;
  #define DMA_K(t,slot) glds16(ksrc+(long)(t)*KVBLK*PD,(unsigned)__builtin_amdgcn_readfirstlane(kdst+(slot)))
  #define DMA_V(t,slot) glds16(vsrc+(long)(t)*KVBLK*PD,(unsigned)__builtin_amdgcn_readfirstlane(vdst+(slot)))
  const int vb0=(int)(lds0+LDS_V)+((lane>>4)&1)*32+(lane&3)*8+(4*hi+((lane&15)>>2))*64;
  const char*Kbase=shm+LDS_K; bf16x8 kf[8];
  const lds_cptr shm3=(lds_cptr)shm; const lds_cptr kp0=shm3+LDS_K+hi*1024+r32*16; const lds_cptr vp0=shm3+LDS_V+((lane>>4)&1)*32+(lane&3)*8+(4*hi+((lane&15)>>2))*64;
  const int NT=(q0+QB)/KVBLK;
  DMA_K(0,0);DMA_V(0,0);DMA_K(1,SLOTB);
  bf16x8 qr[4];
  #pragma unroll
  for(int d0=0;d0<4;++d0)qr[d0]=*reinterpret_cast<const bf16x8*>(&Qw[(long)r32*PD+d0*16+hi*8]);
  float mhat=0.f,l_reg=0.f;f32x16 o[2];o[0]=f32x16{};o[1]=f32x16{};f32x16 negm=f32x16{};asm volatile("":"+v"(negm));
  const int qrel=wid*QBLK+r32;
  #define CMASK(P0,P1,t) do{int jb_=(t)-(NT-4); if(jb_>=0)cmask(P0,P1,jb_,qrel,hi);}while(0)
  bool resc=false;
  #define START(P0,P1) do{ const float rm=rowmax(P0,P1); resc=false; \
    { const float dl=rm; mhat=fadd_s(mhat,dl); \
      _Pragma("unroll") for(int r=0;r<16;++r){P0[r]=fsub_s(P0[r],dl);P1[r]=fsub_s(P1[r],dl);} \
      _Pragma("unroll") for(int r=0;r<16;++r)negm[r]=-mhat; asm volatile("":"+v"(negm)); } \
    _Pragma("unroll") for(int r=0;r<16;++r)P0[r]=__builtin_amdgcn_exp2f(P0[r]); }while(0)
  #define RESC() do{ if(resc){ asm volatile("s_waitcnt lgkmcnt(0)":::"memory"); \
      _Pragma("unroll") for(int d_=0;d_<2;++d_) _Pragma("unroll") for(int r=0;r<16;++r)o[d_][r]*=wsf[crow(r,hi)]; } }while(0)
  f32x16 pA0,pA1,pB0,pB1;
  int sl_prev=0,sl_cur=0,sl_next=SLOTB;
  #define ROT() do{sl_prev=sl_cur;sl_cur=sl_next;sl_next=(sl_next==(NSLOT-1)*SLOTB)?0:sl_next+SLOTB;}while(0)
  DMA_K(2,2*SLOTB);
  WAIT_BAR(3);
  qkt(pA0,pA1,Kbase,qr,negm,r32,hi);asm volatile("s_nop 15\n\ts_nop 7":"+v"(pA0),"+v"(pA1));CMASK(pA0,pA1,0);
  START(pA0,pA1);
  _Pragma("unroll") for(int r=0;r<16;++r)pA1[r]=__builtin_amdgcn_exp2f(pA1[r]);
  WAIT_BAR(0);
  DMA_K(3,0);DMA_V(1,SLOTB);
  ROT();
  kload8(kf,kp0+sl_cur);
  WAIT_BAR(2);
  s16x4 vlo[8],vhi[8]; u32x4 pw0,pw1,pw2,pw3;
  #define PKW(P,B) cvtpk_s(P[B],P[B+1])
  #define PAF(k) __builtin_bit_cast(bf16x8,pw##k)
  #define VFR(i) (bf16x8){vlo[i][0],vlo[i][1],vlo[i][2],vlo[i][3],vhi[i][0],vhi[i][1],vhi[i][2],vhi[i][3]}
  #define PIN(x) asm volatile("":"+v"(x))
  #define MX3(a,b,c) __builtin_fmaxf(__builtin_fmaxf((a),(b)),(c))
  #define GAPA(MF,A0,A1,A2,A3,W0,W1,PW) do{ MF; sacc+=A0; sacc+=A1; sacc+=A2; sacc+=A3; PIN(sacc); W0; W1; PIN(PW); SBAR(); }while(0)
  #define EX(v) __builtin_amdgcn_exp2f(v)
  #define GAPB(MF,X,B) do{ MF; X[B]=EX(X[B]); X[B+1]=EX(X[B+1]); X[B+2]=EX(X[B+2]); X[B+3]=EX(X[B+3]); PIN(X); SBAR(); }while(0)
  #define VRD(i) do{ vlo[i]=vtr(vp_+(((i)>>2)*4096+((i)&3)*1024)); vhi[i]=vtr(vp_+(((i)>>2)*4096+((i)&3)*1024+512)); }while(0)
  #define KRD(G,j) do{ if(G){ kload2(kf,kp0+sl_next,j); SBAR(); } }while(0)
  #define STEP(C0,C1,P0,P1,t,GK,GV,GL) do{ SBAR(); \
    const lds_cptr vp_=vp0+sl_prev; \
    VRD(0); SBAR(); float sacc=(P0[0]+P0[1]); \
    GAPA(C0=__builtin_amdgcn_mfma_f32_32x32x16_bf16(kf[0],qr[0],negm,0,0,0), P0[2],P0[3],P0[4],P0[5],     pw0[0]=PKW(P0,0), pw0[1]=PKW(P0,2), pw0); \
    VRD(4); SBAR(); GAPA(C1=__builtin_amdgcn_mfma_f32_32x32x16_bf16(kf[1],qr[0],negm,0,0,0), P0[6],P0[7],P0[8],P0[9],     pw0[2]=PKW(P0,4), pw0[3]=PKW(P0,6), pw0); \
    VRD(1); SBAR(); GAPA(C0=__builtin_amdgcn_mfma_f32_32x32x16_bf16(kf[2],qr[1],C0,0,0,0),   P0[10],P0[11],P0[12],P0[13], pw1[0]=PKW(P0,8), pw1[1]=PKW(P0,10), pw1); \
    VRD(5); SBAR(); GAPA(C1=__builtin_amdgcn_mfma_f32_32x32x16_bf16(kf[3],qr[1],C1,0,0,0),   P0[14],P0[15],P1[0],P1[1],   pw1[2]=PKW(P0,12),pw1[3]=PKW(P0,14), pw1); \
    VRD(2); SBAR(); GAPA(C0=__builtin_amdgcn_mfma_f32_32x32x16_bf16(kf[4],qr[2],C0,0,0,0),   P1[2],P1[3],P1[4],P1[5],     pw2[0]=PKW(P1,0), pw2[1]=PKW(P1,2), pw2); \
    VRD(6); SBAR(); GAPA(C1=__builtin_amdgcn_mfma_f32_32x32x16_bf16(kf[5],qr[2],C1,0,0,0),   P1[6],P1[7],P1[8],P1[9],     pw2[2]=PKW(P1,4), pw2[3]=PKW(P1,6), pw2); \
    VRD(3); SBAR(); GAPA(C0=__builtin_amdgcn_mfma_f32_32x32x16_bf16(kf[6],qr[3],C0,0,0,0),   P1[10],P1[11],P1[12],P1[13], pw3[0]=PKW(P1,8), pw3[1]=PKW(P1,10), pw3); \
    VRD(7); SBAR(); GAPA(C1=__builtin_amdgcn_mfma_f32_32x32x16_bf16(kf[7],qr[3],C1,0,0,0),   P1[14],P1[15],0.f,0.f,       pw3[2]=PKW(P1,12),pw3[3]=PKW(P1,14), pw3); \
    l_reg+=sacc; \
    if(GK){DMA_K((t)+3,sl_cur);} if(GV){DMA_V((t)+1,sl_next);} \
    CMASK(C0,C1,t); \
    { float a=MX3(C0[0],C0[1],C1[0]),b=MX3(C0[2],C0[3],C1[1]); a=MX3(a,C1[2],C1[3]); \
      _Pragma("unroll") for(int r=4;r<16;r+=4){a=MX3(a,C0[r],C0[r+1]);b=MX3(b,C0[r+2],C0[r+3]);a=MX3(a,C1[r],C1[r+1]);b=MX3(b,C1[r+2],C1[r+3]);} \
      float rm=__builtin_fmaxf(a,b); { auto rr=__builtin_amdgcn_permlane32_swap(__float_as_uint(rm),__float_as_uint(rm),false,false); rm=__builtin_fmaxf(__uint_as_float(rr[0]),__uint_as_float(rr[1])); } \
      resc=false; \
      if(__builtin_expect(__any(rm>(float)THRL),0)){ const float dl=__builtin_fmaxf(rm,0.f); mhat+=dl; \
        _Pragma("unroll") for(int r=0;r<16;++r){C0[r]-=dl;C1[r]-=dl;} \
        _Pragma("unroll") for(int r=0;r<16;++r)negm[r]=-mhat; asm volatile("":"+v"(negm)); \
        const float f=__builtin_amdgcn_exp2f(-dl); l_reg*=f; if(hi==0)wsf[r32]=f; resc=true; } } \
    SBAR(); \
    GAPB(o[0]=__builtin_amdgcn_mfma_f32_32x32x16_bf16(PAF(0),VFR(0),o[0],0,0,0), C0,0); \
    GAPB(o[1]=__builtin_amdgcn_mfma_f32_32x32x16_bf16(PAF(0),VFR(4),o[1],0,0,0), C0,4); \
    KRD(GL,0); GAPB(o[0]=__builtin_amdgcn_mfma_f32_32x32x16_bf16(PAF(1),VFR(1),o[0],0,0,0), C0,8); \
    KRD(GL,1); GAPB(o[1]=__builtin_amdgcn_mfma_f32_32x32x16_bf16(PAF(1),VFR(5),o[1],0,0,0), C0,12); \
    KRD(GL,2); GAPB(o[0]=__builtin_amdgcn_mfma_f32_32x32x16_bf16(PAF(2),VFR(2),o[0],0,0,0), C1,0); \
    KRD(GL,3); GAPB(o[1]=__builtin_amdgcn_mfma_f32_32x32x16_bf16(PAF(2),VFR(6),o[1],0,0,0), C1,4); \
    GAPB(o[0]=__builtin_amdgcn_mfma_f32_32x32x16_bf16(PAF(3),VFR(3),o[0],0,0,0), C1,8); \
    GAPB(o[1]=__builtin_amdgcn_mfma_f32_32x32x16_bf16(PAF(3),VFR(7),o[1],0,0,0), C1,12); \
    }while(0)
  int t=1;
  #undef CMASK
  #define CMASK(P0,P1,t) do{}while(0)
  for(;t+5<NT;t+=2){
    STEP(pB0,pB1,pA0,pA1,t,true,true,true);     WAIT_BAR(2); RESC(); ROT();
    STEP(pA0,pA1,pB0,pB1,t+1,true,true,true);   WAIT_BAR(2); RESC(); ROT();
  }
  #undef CMASK
  #define CMASK(P0,P1,t) do{int jb_=(t)-(NT-4); if(jb_>=0)cmask(P0,P1,jb_,qrel,hi);}while(0)
  #define ENDW(tt) do{ if((tt)+3<NT){WAIT_BAR(2);} else if((tt)+2<NT){WAIT_BAR(1);} else {WAIT_BAR(0);} }while(0)
  for(;t+1<NT;t+=2){
    STEP(pB0,pB1,pA0,pA1,t,(t+3<NT),(t+1<NT),(t+1<NT));       ENDW(t);   RESC(); ROT();
    STEP(pA0,pA1,pB0,pB1,t+1,(t+4<NT),(t+2<NT),(t+2<NT));     ENDW(t+1); RESC(); ROT();
  }
  STEP(pB0,pB1,pA0,pA1,NT-1,false,false,false); RESC();
  { float sacc=pB0[0]+pB0[1]; _Pragma("unroll") for(int r=2;r<16;++r)sacc+=pB0[r]; _Pragma("unroll") for(int r=0;r<16;++r)sacc+=pB1[r]; l_reg+=sacc;
    pw0=(u32x4){PKW(pB0,0),PKW(pB0,2),PKW(pB0,4),PKW(pB0,6)};pw1=(u32x4){PKW(pB0,8),PKW(pB0,10),PKW(pB0,12),PKW(pB0,14)};pw2=(u32x4){PKW(pB1,0),PKW(pB1,2),PKW(pB1,4),PKW(pB1,6)};pw3=(u32x4){PKW(pB1,8),PKW(pB1,10),PKW(pB1,12),PKW(pB1,14)};
    SBAR(); pv(o,vb0+sl_cur,PAF(0),PAF(1),PAF(2),PAF(3)); }
  #undef PKW
  #undef PAF
  #undef VFR
  #undef PIN
  #undef MX3
  #undef GAPA
  #undef GAPB
  #undef EX
  #undef VRD
  #undef KRD
  #undef STEP
  #undef ENDW
  {auto rr=__builtin_amdgcn_permlane32_swap(__float_as_uint(l_reg),__float_as_uint(l_reg),false,false);l_reg=__uint_as_float(rr[0])+__uint_as_float(rr[1]);}
  if(hi==0)wsf[32+r32]=l_reg;asm volatile("s_waitcnt lgkmcnt(0)":::"memory");
  float rli[16];
  #pragma unroll
  for(int r=0;r<16;++r)rli[r]=__builtin_amdgcn_rcpf(wsf[32+crow(r,hi)]);
  bf16*Ow=O+(rowbase+q0+wid*QBLK)*PO+ocol;
  { bf16*stg=(bf16*)(shm+LDS_OST)+wid*2048;
    #pragma unroll
    for(int r=0;r<16;++r){const int orow=crow(r,hi);
      #pragma unroll
      for(int d0=0;d0<2;++d0)stg[orow*64+d0*32+r32]=__float2bfloat16(o[d0][r]*rli[r]);}
    asm volatile("s_waitcnt lgkmcnt(0)":::"memory");
    #pragma unroll
    for(int i=0;i<4;++i){const int row=i*8+(lane>>3),ch=lane&7; const u32x4 v=*(const u32x4*)(stg+row*64+ch*8); ATTN_STORE16(Ow+(long)row*PO+ch*8,v);} }
  asm volatile("s_waitcnt lgkmcnt(0)\n\ts_barrier":::"memory");
  #undef DMA_K
  #undef DMA_V
  #undef CMASK
  #undef START
  #undef RESC
  #undef ROT
}
constexpr int ATTN_LDS_BYTES=LDS_BYTES;
#undef SBAR
#undef WAIT_BAR
}
constexpr int NWAVES = 8;
constexpr int BATCH = 4, T = 4096, D = 1024, FF = 2816, M = BATCH * T;
constexpr int NGU = 2 * FF;
constexpr int RW_H = 8, RW_N = 64, RW_W = 512;
constexpr int SHIFT_COLS = 1824, PROJ_W = 3360;
constexpr int PRW = 2048, PDF = 1536, NPW = PRW + PDF;
constexpr int CH = 64, NCH = T / CH, NITEM = BATCH * RW_H * NCH;
constexpr float NORM_EPS = 1e-6f, GN_EPS = 64e-5f, SUBLN_EPS = 1e-5f, LAMBDA_INIT = 0.2f;
#ifndef MK_PER_PHASE
#define MK_PER_PHASE 0
#endif
constexpr int N_PHASES = 13;
#ifndef REP0
#define REP0 1
#endif
#ifndef REP5
#define REP5 1
#endif
#ifndef REP6
#define REP6 1
#endif
#ifndef REP7
#define REP7 1
#endif

constexpr size_t MiB = 1u << 20;
constexpr size_t WS_CTL = 0, CTL_ZERO_BYTES = 262144;
constexpr size_t WS_LORA = 1 * MiB;
constexpr size_t WS_WGU1 = 2 * MiB, WS_WD1 = 13 * MiB, WS_WIN = 19 * MiB, WS_WO = 26 * MiB, WS_WGU2 = 28 * MiB, WS_WD2 = 39 * MiB;
constexpr size_t WS_S = 2 * MiB;
constexpr size_t WS_XN = 48 * MiB;
constexpr size_t WS_PT = 48 * MiB, WS_QC = 64 * MiB;
constexpr size_t WS_ACT = 80 * MiB;
constexpr size_t WS_PRW = 80 * MiB, WS_PDF = 144 * MiB;
constexpr size_t WS_O = 80 * MiB, WS_YMIX = 112 * MiB;
constexpr size_t WS_VB = 192 * MiB, WS_G = 208 * MiB, WS_RP = 224 * MiB, WS_Y0 = 240 * MiB;
constexpr size_t WS_Y = 192 * MiB;
constexpr size_t WS_YM = 144 * MiB;
constexpr size_t WS_X = 45 * MiB;
constexpr int CW_SEAM = 32768, SEAM_BANK = 64 * 64;
constexpr size_t WS_END = 256 * MiB;
constexpr int CW_QUEUE = 64, CW_BAR = 4096;
constexpr size_t WS_PRM = 65536;

constexpr int ARR = 64 * 72 * 2;
constexpr int L_AT = 0, L_BT = ARR, L_KT = 2 * ARR, L_RT = 3 * ARR, L_ATT = 4 * ARR, L_VT = 5 * ARR, L_BH = 6 * ARR, L_KH = 7 * ARR;
constexpr int L_M = 8 * ARR, L_MT = 9 * ARR, L_TT = 10 * ARR, L_NAK = 11 * ARR, L_NRK = 12 * ARR, L_NRB = 13 * ARR;
constexpr int L_APT = L_AT, L_W1T = L_BT, L_U0T = L_KT;
constexpr int L_XW = L_M, L_XA = L_M + ARR, L_XG = L_M + 2 * ARR;
constexpr int FARR = 64 * 65 * 4;
constexpr int L_WL = L_M, L_AL = L_M + FARR, L_GL = L_M + 2 * FARR;
constexpr int L_GT = 14 * ARR;
constexpr int L_WC = L_GT + 2048;
constexpr int L_MISC = L_WC + 256;
constexpr int LDS_BYTES = 150 * 1024;
static_assert(L_GL + FARR <= L_GT && L_XG + 64 * 168 * 2 <= L_GT && L_MISC + 64 <= LDS_BYTES, "LDS map");
constexpr int L_YL = 0;

#define GAS __attribute__((address_space(1)))
#define LAS __attribute__((address_space(3)))
typedef unsigned short bf16;
typedef unsigned v4u __attribute__((ext_vector_type(4)));
typedef unsigned v2u __attribute__((ext_vector_type(2)));
typedef float f32x4 __attribute__((ext_vector_type(4)));
typedef short bf16x8 __attribute__((ext_vector_type(8)));
#define LDS_WAIT() asm volatile("s_waitcnt lgkmcnt(0)" ::: "memory")
__device__ __forceinline__ unsigned f2bf(float f) { unsigned u = __builtin_bit_cast(unsigned, f); return (u + 0x7fffu + ((u >> 16) & 1u)) >> 16; }
__device__ __forceinline__ unsigned pk2(float lo, float hi) { return f2bf(lo) | (f2bf(hi) << 16); }
__device__ __forceinline__ float bf2f(unsigned short b) { return __builtin_bit_cast(float, (unsigned)b << 16); }
__device__ __forceinline__ float bflo(unsigned w) { return __builtin_bit_cast(float, w << 16); }
__device__ __forceinline__ float bfhi(unsigned w) { return __builtin_bit_cast(float, w & 0xffff0000u); }
__device__ __forceinline__ float dpp_add(float v, const int ctrl_sel) {
    const int x = __builtin_bit_cast(int, v); int y;
    if (ctrl_sel == 0) y = __builtin_amdgcn_update_dpp(0, x, 0xB1, 0xF, 0xF, true);
    else if (ctrl_sel == 1) y = __builtin_amdgcn_update_dpp(0, x, 0x4E, 0xF, 0xF, true);
    else if (ctrl_sel == 2) y = __builtin_amdgcn_update_dpp(0, x, 0x141, 0xF, 0xF, true);
    else y = __builtin_amdgcn_update_dpp(0, x, 0x140, 0xF, 0xF, true);
    return v + __builtin_bit_cast(float, y);
}
__device__ __forceinline__ float wave_sum(float v) {
    v = dpp_add(v, 0); v = dpp_add(v, 1); v = dpp_add(v, 2); v = dpp_add(v, 3);
    { auto rr = __builtin_amdgcn_permlane16_swap(__float_as_uint(v), __float_as_uint(v), false, false); v = __uint_as_float(rr[0]) + __uint_as_float(rr[1]); }
    { auto rr = __builtin_amdgcn_permlane32_swap(__float_as_uint(v), __float_as_uint(v), false, false); v = __uint_as_float(rr[0]) + __uint_as_float(rr[1]); }
    return v;
}
__device__ __forceinline__ float sigmoidf_(float x) { return 1.0f / (1.0f + __expf(-x)); }

typedef GAS unsigned gu32;
#define RLX_AGENT __ATOMIC_RELAXED, __HIP_MEMORY_SCOPE_AGENT
#define XB_TMO      128
#define XB_XCNT(j)  (256  + 64 * (j))
#define XB_XSUB(j)  (1280 + 64 * (j))
#define XB_XGEN(j)  (2304 + 64 * (j))
#define XB_TOP      3328
#define XB_TOPGEN   3392
#define XCD_BAR_WORDS 3456
#define XB_SPIN_CAP (1u << 18)

__device__ __forceinline__ unsigned xb_ld(unsigned* p)              { return __hip_atomic_load(p, __ATOMIC_RELAXED, __HIP_MEMORY_SCOPE_AGENT); }
__device__ __forceinline__ unsigned xb_add(unsigned* p, unsigned v) { return __hip_atomic_fetch_add(p, v, __ATOMIC_RELAXED, __HIP_MEMORY_SCOPE_AGENT); }
__device__ __forceinline__ unsigned xb_xcc_id() { return (unsigned)__builtin_amdgcn_s_getreg((3 << 11) | 20) & 0xFu; }
#define XB_SPIN(cond, bar) do { unsigned _sp = 0; while (cond) { __builtin_amdgcn_s_sleep(1); \
    if ((++_sp & 255u) == 0u) { if (xb_ld(&(bar)[XB_TMO])) break; if (_sp > XB_SPIN_CAP) { atomicAdd(&(bar)[XB_TMO], 1u); break; } } } } while (0)

struct XcdBarrier {
    unsigned* bar; unsigned x;
    volatile LAS unsigned* st;
};

__device__ __forceinline__ XcdBarrier xcd_barrier_post(unsigned* bar, volatile LAS unsigned* st, const int wid) {
    XcdBarrier b; b.bar = bar; b.x = xb_xcc_id(); b.st = st;
    if (wid == 0 && lane_id_asm() == 0) (void)xb_add(&bar[XB_XCNT(b.x)], 1u);
    return b;
}
__device__ __forceinline__ void xcd_barrier_complete(unsigned* bar, unsigned x, unsigned& nloc, unsigned& nx) {
    const unsigned G = gridDim.x * gridDim.y * gridDim.z;
    unsigned sum, cnt, mine, sp = 0u;
    for (;;) {
        sum = 0u; cnt = 0u; mine = 0u;
#pragma unroll
        for (unsigned j = 0; j < 16; ++j) { const unsigned c = xb_ld(&bar[XB_XCNT(j)]); sum += c; cnt += (c > 0u) ? 1u : 0u; mine = (j == x) ? c : mine; }
        if (sum == G) break;
        __builtin_amdgcn_s_sleep(1);
        if ((++sp & 255u) == 0u) { if (xb_ld(&bar[XB_TMO])) break; if (sp > XB_SPIN_CAP) { atomicAdd(&bar[XB_TMO], 1u); break; } }
    }
    nloc = mine > 0u ? mine : 1u; nx = cnt > 0u ? cnt : 1u;
}

__device__ __forceinline__ void xcd_barrier(const XcdBarrier& b, const int wid) {
    asm volatile("s_waitcnt vmcnt(0)" ::: "memory");
    __syncthreads();
    if (wid == 0 && lane_id_asm() == 0) {
        unsigned* bar = b.bar;
        __builtin_amdgcn_s_waitcnt(0);
        unsigned nloc = b.st[0], nx = b.st[1];
        if (nloc == 0u) { xcd_barrier_complete(bar, b.x, nloc, nx); b.st[0] = nloc; b.st[1] = nx; }
        const unsigned old = xb_add(&bar[XB_XSUB(b.x)], 1u);
        const unsigned gen = old / nloc;
        if (old + 1u == (gen + 1u) * nloc) {
            __builtin_amdgcn_fence(__ATOMIC_RELEASE, "agent");
            asm volatile("s_waitcnt vmcnt(0)" ::: "memory");
            const unsigned og = xb_add(&bar[XB_TOP], 1u);
            const unsigned tg = og / nx;
            if (og + 1u == (tg + 1u) * nx) xb_add(&bar[XB_TOPGEN], 1u);
            else XB_SPIN(xb_ld(&bar[XB_TOPGEN]) == tg, bar);
            __builtin_amdgcn_fence(__ATOMIC_ACQUIRE, "agent");
            xb_add(&bar[XB_XGEN(b.x)], 1u);
            asm volatile("s_waitcnt vmcnt(0)" ::: "memory");
        } else {
            XB_SPIN(xb_ld(&bar[XB_XGEN(b.x)]) == gen, bar);
            __builtin_amdgcn_fence(__ATOMIC_ACQUIRE, "agent");
            asm volatile("s_waitcnt vmcnt(0)" ::: "memory");
        }
    }
    __syncthreads();
}

struct Args { const float* in[31]; float* out; unsigned char* ws; int ph_lo, ph_hi; };
struct Frame {
    LAS unsigned char* lds;
    unsigned* ctl;
    int tid, lane, wave, vcu, G;
    float* out; unsigned char* ws;
};

__device__ __forceinline__ void p0_transpose_item(const float* W, int K, int N, bf16* WT, int ldk, int drow0, float scale, LAS float* scr, int k0, int n0, int lane) {
#pragma unroll 8
    for (int i = 0; i < 32; ++i) { const int kk = 2 * i + (lane >> 5); scr[kk * 33 + (lane & 31)] = (k0 + kk < K) ? W[(size_t)(k0 + kk) * N + n0 + (lane & 31)] * scale : 0.f; }
    LDS_WAIT(); asm volatile("" ::: "memory");
    const int c = lane & 7;
#pragma unroll
    for (int j = 0; j < 4; ++j) { const int n = (lane >> 3) + 8 * j; const LAS float* s = scr + (8 * c) * 33 + n;
        v4u o; o.x = pk2(s[0 * 33], s[1 * 33]); o.y = pk2(s[2 * 33], s[3 * 33]); o.z = pk2(s[4 * 33], s[5 * 33]); o.w = pk2(s[6 * 33], s[7 * 33]);
        if (k0 + 8 * c < K) *(GAS v4u*)(WT + (size_t)(drow0 + n) * ldk + k0 + 8 * c) = o; }
    LDS_WAIT(); asm volatile("" ::: "memory");
}
template <int MODE> __device__ __forceinline__ void norm_rows(Frame& F, const float* xin, const float* y, const float* g1, float coef, float* xo, const float* g2, bf16* xn) {
    const int gw = F.vcu * NWAVES + F.wave, NGW = F.G * NWAVES;
    f32x4 gg1[4], gg2[4];
#pragma unroll
    for (int j = 0; j < 4; ++j) { if (MODE != 0) gg1[j] = ((const f32x4*)g1)[F.lane + 64 * j]; if (MODE != 2) gg2[j] = ((const f32x4*)g2)[F.lane + 64 * j]; }
    for (int m = gw; m < M; m += NGW) {
        f32x4 v[4];
#pragma unroll
        for (int j = 0; j < 4; ++j) v[j] = ((const f32x4*)(xin + (size_t)m * D))[F.lane + 64 * j];
        if (MODE != 0) {
            f32x4 yy[4]; float s = 0.f;
#pragma unroll
            for (int j = 0; j < 4; ++j) { yy[j] = ((const f32x4*)(y + (size_t)m * D))[F.lane + 64 * j]; s += (yy[j].x * yy[j].x + yy[j].y * yy[j].y) + (yy[j].z * yy[j].z + yy[j].w * yy[j].w); }
            const float rs = coef * __builtin_amdgcn_rsqf(wave_sum(s) * (1.f / D) + NORM_EPS);
#pragma unroll
            for (int j = 0; j < 4; ++j) { v[j] = v[j] + yy[j] * gg1[j] * rs; ((f32x4*)(xo + (size_t)m * D))[F.lane + 64 * j] = v[j]; }
        }
        if (MODE != 2) {
            float s = 0.f;
#pragma unroll
            for (int j = 0; j < 4; ++j) s += (v[j].x * v[j].x + v[j].y * v[j].y) + (v[j].z * v[j].z + v[j].w * v[j].w);
            const float rs = __builtin_amdgcn_rsqf(wave_sum(s) * (1.f / D) + NORM_EPS);
            unsigned long long* o8 = (unsigned long long*)(xn + (size_t)m * D) + F.lane;
#pragma unroll
            for (int j = 0; j < 4; ++j) { const f32x4 o = v[j] * gg2[j] * rs; o8[64 * j] = (unsigned long long)pk2(o.x, o.y) | ((unsigned long long)pk2(o.z, o.w) << 32); }
        }
    }
}
__device__ __forceinline__ void p0_job(const float* W, int K, int N, bf16* WT, int ldk, int kind, LAS float* scr, int r, int lane) {
    const int nblk = N / 32, kb = r / nblk, nb = r % nblk, k0 = 64 * kb, n0 = 32 * nb;
    int drow0 = n0; float scale = 1.f;
    if (kind == 1) drow0 = 256 * (n0 >> 7) + (n0 & 127);
    else if (kind == 2) drow0 = 256 * (n0 >> 7) + 128 + (n0 & 127);
    else if (kind == 3) { if (n0 >= SHIFT_COLS) { drow0 = n0 + (PRW - SHIFT_COLS); if (n0 < SHIFT_COLS + 512) scale = attn_body::C2; } }
    p0_transpose_item(W, K, N, WT, ldk, drow0, scale, scr, k0, n0, lane);
}
__device__ __forceinline__ void p0_prologue(Frame& F, const Args& A) {
    LAS float* scr = (LAS float*)(F.lds + F.wave * 16384);
    const int gw = F.vcu * NWAVES + F.wave, NGW = F.G * NWAVES;
    bf16* lora = (bf16*)(F.ws + WS_LORA);
    constexpr int I_GU = (D / 64) * (FF / 32), I_DN = (FF / 64) * (D / 32), I_IN = (D / 64) * (PROJ_W / 32), I_O = (D / 64) * (D / 32), I_L = 512 / 32, I_G = 3 * (512 / 32);
    constexpr int NITEMS = 4 * I_GU + 2 * I_DN + I_IN + I_O + 2 * I_L + I_G;
    for (int it = gw; it < NITEMS; it += NGW) {
        int r = it;
        if (r < I_GU) { p0_job(A.in[3], D, FF, (bf16*)(F.ws + WS_WGU1), D, 1, scr, r, F.lane); continue; } r -= I_GU;
        if (r < I_GU) { p0_job(A.in[4], D, FF, (bf16*)(F.ws + WS_WGU1), D, 2, scr, r, F.lane); continue; } r -= I_GU;
        if (r < I_DN) { p0_job(A.in[5], FF, D, (bf16*)(F.ws + WS_WD1), FF, 0, scr, r, F.lane); continue; } r -= I_DN;
        if (r < I_IN) { p0_job(A.in[8], D, PROJ_W, (bf16*)(F.ws + WS_WIN), D, 3, scr, r, F.lane); continue; } r -= I_IN;
        if (r < I_O) { p0_job(A.in[10], D, D, (bf16*)(F.ws + WS_WO), D, 0, scr, r, F.lane); continue; } r -= I_O;
        if (r < I_GU) { p0_job(A.in[28], D, FF, (bf16*)(F.ws + WS_WGU2), D, 1, scr, r, F.lane); continue; } r -= I_GU;
        if (r < I_GU) { p0_job(A.in[29], D, FF, (bf16*)(F.ws + WS_WGU2), D, 2, scr, r, F.lane); continue; } r -= I_GU;
        if (r < I_DN) { p0_job(A.in[30], FF, D, (bf16*)(F.ws + WS_WD2), FF, 0, scr, r, F.lane); continue; } r -= I_DN;
        if (r < I_L) { p0_job(A.in[12], 64, 512, lora, 64, 0, scr, r, F.lane); continue; } r -= I_L;
        if (r < I_L) { p0_job(A.in[14], 64, 512, lora + 512 * 64, 64, 0, scr, r, F.lane); continue; } r -= I_L;
        p0_job(A.in[15], 160, 512, lora + 2 * 512 * 64, 160, 0, scr, r, F.lane);
    }
    {
        GAS v4u* z = (GAS v4u*)(F.ws + WS_WIN + (size_t)SHIFT_COLS * D * 2); const int nz = (PRW - SHIFT_COLS) * D * 2 / 16;
        for (int i = (F.vcu * NWAVES + F.wave) * 64 + F.lane; i < nz; i += F.G * NWAVES * 64) z[i] = (v4u){0u, 0u, 0u, 0u};
    }
    {
        float* PRMw = (float*)(F.ws + WS_PRM); const int gt = (F.vcu * NWAVES + F.wave) * 64 + F.lane, GT = F.G * NWAVES * 64;
        for (int i = gt; i < 1824; i += GT) PRMw[0 + i] = A.in[9][i];
        for (int i = gt; i < 512; i += GT) PRMw[2048 + i] = A.in[11][i];
        for (int i = gt; i < 512; i += GT) PRMw[2560 + i] = A.in[13][i];
        for (int i = gt; i < 512; i += GT) PRMw[3072 + i] = A.in[16][i];
        for (int i = gt; i < 512; i += GT) PRMw[3584 + i] = A.in[17][i];
        for (int i = gt; i < 512; i += GT) PRMw[4096 + i] = A.in[18][i];
        for (int i = gt; i < 512; i += GT) PRMw[4608 + i] = A.in[19][i];
        for (int i = gt; i < 512; i += GT) PRMw[5120 + i] = A.in[20][i];
        for (int i = gt; i < 64; i += GT) PRMw[5632 + i] = A.in[21][i];
        for (int i = gt; i < 64; i += GT) PRMw[5696 + i] = A.in[22][i];
        for (int i = gt; i < 64; i += GT) PRMw[5760 + i] = A.in[23][i];
        for (int i = gt; i < 64; i += GT) PRMw[5824 + i] = A.in[24][i];
        for (int i = gt; i < 128; i += GT) PRMw[5888 + i] = A.in[25][i];
        for (int i = gt; i < 1024; i += GT) PRMw[6144 + i] = A.in[2][i];
        for (int i = gt; i < 1024; i += GT) PRMw[7168 + i] = A.in[6][i];
        for (int i = gt; i < 1024; i += GT) PRMw[8192 + i] = A.in[7][i];
        for (int i = gt; i < 1024; i += GT) PRMw[9216 + i] = A.in[26][i];
        for (int i = gt; i < 1024; i += GT) PRMw[10240 + i] = A.in[27][i];
    }
    norm_rows<0>(F, A.in[0], nullptr, nullptr, 0.f, nullptr, A.in[1], (bf16*)(F.ws + WS_XN));
}

__device__ __forceinline__ f32x4 mm_tile(const LAS unsigned char* X, int ldx, int x0, const LAS unsigned char* Y, int ldy, int y0, int ksteps, f32x4 acc, int fr, int fq) {
    const LAS unsigned char* xp = X + (x0 + fr) * ldx + fq * 16; const LAS unsigned char* yp = Y + (y0 + fr) * ldy + fq * 16;
    for (int k = 0; k < ksteps; ++k) { const bf16x8 a = *(const LAS bf16x8*)(xp + k * 64), b = *(const LAS bf16x8*)(yp + k * 64); acc = __builtin_amdgcn_mfma_f32_16x16x32_bf16(a, b, acc, 0, 0, 0); }
    return acc;
}
__device__ __forceinline__ void st4_lds(LAS unsigned char* p, f32x4 v) { v2u w; w.x = pk2(v[0], v[1]); w.y = pk2(v[2], v[3]); *(LAS v2u*)p = w; }
__device__ __forceinline__ void st4_g(bf16* p, f32x4 v) { v2u w; w.x = pk2(v[0], v[1]); w.y = pk2(v[2], v[3]); *(GAS v2u*)p = w; }
__device__ __forceinline__ f32x4 ld4_lds(const LAS unsigned char* p) { const v2u w = *(const LAS v2u*)p; return (f32x4){bflo(w.x), bfhi(w.x), bflo(w.y), bfhi(w.y)}; }
__device__ __forceinline__ f32x4 ld4_g(const bf16* p) { const v2u w = *(const GAS v2u*)p; return (f32x4){bflo(w.x), bfhi(w.x), bflo(w.y), bfhi(w.y)}; }
constexpr int LD = 144;

__device__ __forceinline__ void rwkv_chunk_prep(Frame& F, int item) {
    const float* PRM = (const float*)(F.ws + WS_PRM);
    LAS unsigned char* L = F.lds;
    const int tid = F.tid, lane = F.lane, w = F.wave, fr = lane & 15, fq = lane >> 4;
    const int bh = item / NCH, c = item % NCH, b = bh / RW_H, h = bh % RW_H;
    const int row0 = b * T + c * CH;
    const bf16* P = (const bf16*)(F.ws + WS_PRW);
    const float* mu = (PRM + 0);
    {
        v4u cur[5], prv[5];
#pragma unroll
        for (int i = 0; i < 5; ++i) { const int qd = tid + 512 * i; const int t = qd / 36, l0 = 8 * (qd % 36);
            cur[i] = (v4u){0u, 0u, 0u, 0u}; prv[i] = cur[i];
            if (qd < CH * 36) { const size_t off = (size_t)(row0 + t) * PRW + 1536 + l0; cur[i] = *(const GAS v4u*)(P + off); if (c * CH + t > 0) prv[i] = *(const GAS v4u*)(P + off - PRW); } }
#pragma unroll
        for (int i = 0; i < 5; ++i) { const int qd = tid + 512 * i; const int t = qd / 36, l0 = 8 * (qd % 36);
            if (qd < CH * 36) {
                const f32x4 m0 = *(const f32x4*)(mu + 1536 + l0), m1 = *(const f32x4*)(mu + 1536 + l0 + 4);
                float x[8];
#pragma unroll
                for (int e = 0; e < 4; ++e) { const unsigned cw = cur[i][e], pw = prv[i][e]; const float c0 = bflo(cw), c1 = bfhi(cw), p0 = bflo(pw), p1 = bfhi(pw);
                    const float ma = (e < 2) ? m0[2 * e] : m1[2 * e - 4], mb = (e < 2) ? m0[2 * e + 1] : m1[2 * e - 3];
                    x[2 * e] = c0 + (p0 - c0) * ma; x[2 * e + 1] = c1 + (p1 - c1) * mb; }
                LAS unsigned char* dst;
                if (l0 < 64) { dst = L + L_XW + t * LD + l0 * 2;
#pragma unroll
                    for (int e = 0; e < 8; ++e) x[e] = 1.f - 2.f * __builtin_amdgcn_rcpf(1.f + __expf(2.f * x[e])); }
                else if (l0 < 128) { dst = L + L_XA + t * LD + (l0 - 64) * 2; }
                else { dst = L + L_XG + t * 336 + (l0 - 128) * 2;
#pragma unroll
                    for (int e = 0; e < 8; ++e) x[e] = __builtin_amdgcn_rcpf(1.f + __expf(-x[e])); }
                *(LAS v4u*)dst = (v4u){pk2(x[0], x[1]), pk2(x[2], x[3]), pk2(x[4], x[5]), pk2(x[6], x[7])};
            } }
    }
    __syncthreads();
    {
        const bf16* lora = (const bf16*)(F.ws + WS_LORA);
        f32x4 aw[2], aa[2], ag[2];
#pragma unroll
        for (int q = 0; q < 2; ++q) { const int tw = 2 * w + q, m0 = 16 * (tw >> 2), n0 = 16 * (tw & 3);
            aw[q] = (f32x4){0.f, 0.f, 0.f, 0.f}; aa[q] = aw[q]; ag[q] = aw[q];
            const bf16* wrow = lora + (size_t)(h * 64 + n0 + fr) * 64 + fq * 8; const bf16* arow = wrow + 512 * 64; const bf16* grow = lora + 2 * 512 * 64 + (size_t)(h * 64 + n0 + fr) * 160 + fq * 8;
#pragma unroll
            for (int k = 0; k < 2; ++k) { const bf16x8 xa = *(const LAS bf16x8*)(L + L_XW + (m0 + fr) * LD + fq * 16 + k * 64); const bf16x8 wb = *(const GAS bf16x8*)(wrow + k * 32);
                aw[q] = __builtin_amdgcn_mfma_f32_16x16x32_bf16(xa, wb, aw[q], 0, 0, 0);
                const bf16x8 xb = *(const LAS bf16x8*)(L + L_XA + (m0 + fr) * LD + fq * 16 + k * 64); const bf16x8 ab = *(const GAS bf16x8*)(arow + k * 32);
                aa[q] = __builtin_amdgcn_mfma_f32_16x16x32_bf16(xb, ab, aa[q], 0, 0, 0); }
#pragma unroll
            for (int k = 0; k < 5; ++k) { const bf16x8 xg = *(const LAS bf16x8*)(L + L_XG + (m0 + fr) * 336 + fq * 16 + k * 64); const bf16x8 gb = *(const GAS bf16x8*)(grow + k * 32);
                ag[q] = __builtin_amdgcn_mfma_f32_16x16x32_bf16(xg, gb, ag[q], 0, 0, 0); }
        }
        __syncthreads();
#pragma unroll
        for (int q = 0; q < 2; ++q) { const int tw = 2 * w + q, m0 = 16 * (tw >> 2), n0 = 16 * (tw & 3);
#pragma unroll
            for (int v = 0; v < 4; ++v) { const int t = m0 + 4 * fq + v, ch = n0 + fr;
                *(LAS float*)(L + L_WL + (t * 65 + ch) * 4) = aw[q][v]; *(LAS float*)(L + L_AL + (t * 65 + ch) * 4) = aa[q][v]; *(LAS float*)(L + L_GL + (t * 65 + ch) * 4) = ag[q][v]; } }
        __syncthreads();
    }
    {
        const int ch = lane, gc = h * 64 + ch;
        const float mur = mu[gc], muk = mu[512 + gc], muv = mu[1024 + gc];
        const float w0 = (PRM + 2048)[gc], a0 = (PRM + 2560)[gc], k_k = (PRM + 3072)[gc], k_a = (PRM + 3584)[gc], r_k = (PRM + 4096)[gc];
        float rr[8], kp[8], vv[8], aa[8], bb[8], ld[8];
        const int tb = 8 * w;
        float pr, pk, pv;
        { const bool has = (c * CH + tb > 0); const size_t offp = (size_t)(row0 + tb - 1) * PRW + gc;
          pr = has ? bf2f(P[offp]) : 0.f; pk = has ? bf2f(P[offp + 512]) : 0.f; pv = has ? bf2f(P[offp + 1024]) : 0.f; }
        bf16 raw[8][3];
#pragma unroll
        for (int tt = 0; tt < 8; ++tt) { const size_t off = (size_t)(row0 + tb + tt) * PRW + gc; raw[tt][0] = P[off]; raw[tt][1] = P[off + 512]; raw[tt][2] = P[off + 1024]; }
        bf16* VBp = (bf16*)(F.ws + WS_VB) + (size_t)item * 4096; bf16* Gp = (bf16*)(F.ws + WS_G) + (size_t)item * 4096;
        float run = 0.f;
#pragma unroll
        for (int tt = 0; tt < 8; ++tt) { const int t = tb + tt;
            const float cr = bf2f(raw[tt][0]), ck = bf2f(raw[tt][1]), cv = bf2f(raw[tt][2]);
            const float r = cr + (pr - cr) * mur, k = ck + (pk - ck) * muk, v = cv + (pv - cv) * muv; pr = cr; pk = ck; pv = cv;
            const float wl = *(const LAS float*)(L + L_WL + (t * 65 + ch) * 4), al = *(const LAS float*)(L + L_AL + (t * 65 + ch) * 4), gl = *(const LAS float*)(L + L_GL + (t * 65 + ch) * 4);
            const float z = -(w0 + wl); const float sp = fmaxf(z, 0.f) + __logf(1.f + __expf(-fabsf(z)));
            const float lgd = -__expf(-sp - 0.5f);
            const float ic = sigmoidf_(a0 + al);
            const float kkv = k * k_k; const float ss = wave_sum(kkv * kkv); const float kn = kkv * __builtin_amdgcn_rsqf(fmaxf(ss, 1e-24f));
            const float kq = k * (1.f + (ic - 1.f) * k_a);
            const float bonus = wave_sum(r * kq * r_k);
            rr[tt] = r; kp[tt] = kq; vv[tt] = v; aa[tt] = -kn; bb[tt] = kn * ic; run += lgd; ld[tt] = run;
            VBp[t * 64 + ch] = (bf16)f2bf(bonus * v); Gp[t * 64 + ch] = (bf16)f2bf(gl);
        }
        *(LAS float*)(L + L_GT + (w * 64 + ch) * 4) = run;
        __syncthreads();
        float offs = 0.f, tot = 0.f;
#pragma unroll
        for (int g = 0; g < 8; ++g) { const float x = *(const LAS float*)(L + L_GT + (g * 64 + ch) * 4); if (g < w) offs += x; tot += x; }
        if (w == 0) *(LAS float*)(L + L_WC + ch * 4) = __expf(tot);
        unsigned patt[4], pvt[4], pbh[4], pkh[4];
        float prevcl = offs;
#pragma unroll
        for (int tt = 0; tt < 8; ++tt) { const int t = tb + tt; const float cl = offs + ld[tt];
            const float e_in = __expf(cl), e_ex = __expf(prevcl), e_inv = __expf(-cl), e_hat = __expf(tot - cl); prevcl = cl;
            const float At = aa[tt] * e_ex, Bt = bb[tt] * e_inv, Kt = kp[tt] * e_inv, Rt = rr[tt] * e_in, Bh = bb[tt] * e_hat, Kh = kp[tt] * e_hat;
            *(LAS bf16*)(L + L_AT + t * LD + ch * 2) = (bf16)f2bf(At); *(LAS bf16*)(L + L_BT + t * LD + ch * 2) = (bf16)f2bf(Bt);
            *(LAS bf16*)(L + L_KT + t * LD + ch * 2) = (bf16)f2bf(Kt); *(LAS bf16*)(L + L_RT + t * LD + ch * 2) = (bf16)f2bf(Rt);
            const unsigned sh = (tt & 1) * 16;
            if (!(tt & 1)) { patt[tt >> 1] = 0u; pvt[tt >> 1] = 0u; pbh[tt >> 1] = 0u; pkh[tt >> 1] = 0u; }
            patt[tt >> 1] |= f2bf(At) << sh; pvt[tt >> 1] |= f2bf(vv[tt]) << sh; pbh[tt >> 1] |= f2bf(Bh) << sh; pkh[tt >> 1] |= f2bf(Kh) << sh;
        }
        *(LAS v4u*)(L + L_ATT + ch * LD + tb * 2) = (v4u){patt[0], patt[1], patt[2], patt[3]};
        *(LAS v4u*)(L + L_VT + ch * LD + tb * 2) = (v4u){pvt[0], pvt[1], pvt[2], pvt[3]};
        *(LAS v4u*)(L + L_BH + ch * LD + tb * 2) = (v4u){pbh[0], pbh[1], pbh[2], pbh[3]};
        *(LAS v4u*)(L + L_KH + ch * LD + tb * 2) = (v4u){pkh[0], pkh[1], pkh[2], pkh[3]};
        __syncthreads();
    }
    const f32x4 Z4 = (f32x4){0.f, 0.f, 0.f, 0.f};
#pragma unroll
    for (int q = 0; q < 2; ++q) { const int tw = 2 * w + q, p0 = 16 * (tw >> 2), q0 = 16 * (tw & 3);
        f32x4 m = mm_tile(L + L_AT, LD, q0, L + L_BT, LD, p0, 2, Z4, fr, fq);
        f32x4 mt = mm_tile(L + L_BT, LD, q0, L + L_AT, LD, p0, 2, Z4, fr, fq);
        f32x4 nak = mm_tile(L + L_KT, LD, q0, L + L_AT, LD, p0, 2, Z4, fr, fq);
        f32x4 nrk = mm_tile(L + L_KT, LD, q0, L + L_RT, LD, p0, 2, Z4, fr, fq);
        f32x4 nrb = mm_tile(L + L_BT, LD, q0, L + L_RT, LD, p0, 2, Z4, fr, fq);
        f32x4 tt;
        const int p = p0 + fr;
#pragma unroll
        for (int v = 0; v < 4; ++v) { const int qq = q0 + 4 * fq + v;
            if (!(p < qq)) m[v] = 0.f;
            if (!(qq < p)) { mt[v] = 0.f; nak[v] = 0.f; }
            if (!(qq <= p)) { nrk[v] = 0.f; nrb[v] = 0.f; }
            tt[v] = (p == qq) ? 1.f : 0.f; }
        const int o = p * LD + (q0 + 4 * fq) * 2;
        st4_lds(L + L_M + o, m); st4_lds(L + L_MT + o, mt); st4_lds(L + L_NAK + o, nak); st4_lds(L + L_NRK + o, nrk); st4_lds(L + L_NRB + o, nrb); st4_lds(L + L_TT + o, tt);
    }
    __syncthreads();
    for (int it = 0; it < 6; ++it) {
        f32x4 tn[2], mn[2], mtn[2];
#pragma unroll
        for (int q = 0; q < 2; ++q) { const int tw = 2 * w + q, p0 = 16 * (tw >> 2), q0 = 16 * (tw & 3); const int o = (p0 + fr) * LD + (q0 + 4 * fq) * 2;
            tn[q] = mm_tile(L + L_M, LD, q0, L + L_TT, LD, p0, 2, ld4_lds(L + L_TT + o), fr, fq);
            if (it < 5) { mn[q] = mm_tile(L + L_MT, LD, q0, L + L_M, LD, p0, 2, Z4, fr, fq);
                          mtn[q] = mm_tile(L + L_M, LD, q0, L + L_MT, LD, p0, 2, Z4, fr, fq); }
        }
        __syncthreads();
#pragma unroll
        for (int q = 0; q < 2; ++q) { const int tw = 2 * w + q, p0 = 16 * (tw >> 2), q0 = 16 * (tw & 3); const int o = (p0 + fr) * LD + (q0 + 4 * fq) * 2;
            st4_lds(L + L_TT + o, tn[q]); if (it < 5) { st4_lds(L + L_M + o, mn[q]); st4_lds(L + L_MT + o, mtn[q]); } }
        __syncthreads();
    }
#pragma unroll
    for (int q = 0; q < 2; ++q) { const int tw = 2 * w + q, p0 = 16 * (tw >> 2), q0 = 16 * (tw & 3); const int o = (p0 + fr) * LD + (q0 + 4 * fq) * 2;
        const f32x4 ap = mm_tile(L + L_TT, LD, q0, L + L_ATT, LD, p0, 2, Z4, fr, fq);
        const f32x4 w1 = mm_tile(L + L_NAK, LD, q0, L + L_VT, LD, p0, 2, Z4, fr, fq);
        st4_lds(L + L_APT + o, ap); st4_lds(L + L_W1T + o, w1); }
    __syncthreads();
    {
        bf16* RPp = (bf16*)(F.ws + WS_RP) + (size_t)item * 4096; bf16* PTp = (bf16*)(F.ws + WS_PT) + (size_t)item * 4096;
#pragma unroll
        for (int q = 0; q < 2; ++q) { const int tw = 2 * w + q, p0 = 16 * (tw >> 2), q0 = 16 * (tw & 3); const int p = p0 + fr; const int o = p * LD + (q0 + 4 * fq) * 2;
            const f32x4 u0 = mm_tile(L + L_TT, LD, q0, L + L_W1T, LD, p0, 2, Z4, fr, fq);
            const f32x4 rp = mm_tile(L + L_APT, LD, q0, L + L_NRB, LD, p0, 2, ld4_lds(L + L_RT + o), fr, fq);
            f32x4 pt = mm_tile(L + L_APT, LD, q0, L + L_BH, LD, p0, 2, Z4, fr, fq);
            const float wc = *(const LAS float*)(L + L_WC + p * 4);
#pragma unroll
            for (int v = 0; v < 4; ++v) if (p == q0 + 4 * fq + v) pt[v] += wc;
            st4_lds(L + L_U0T + o, u0);
            st4_g(RPp + p * 64 + q0 + 4 * fq, rp); st4_g(PTp + p * 64 + q0 + 4 * fq, pt); }
    }
    __syncthreads();
    {
        bf16* Y0p = (bf16*)(F.ws + WS_Y0) + (size_t)item * 4096; bf16* QCp = (bf16*)(F.ws + WS_QC) + (size_t)item * 4096;
#pragma unroll
        for (int q = 0; q < 2; ++q) { const int tw = 2 * w + q, p0 = 16 * (tw >> 2), q0 = 16 * (tw & 3); const int p = p0 + fr;
            f32x4 y0 = mm_tile(L + L_VT, LD, q0, L + L_NRK, LD, p0, 2, Z4, fr, fq);
            y0 = mm_tile(L + L_U0T, LD, q0, L + L_NRB, LD, p0, 2, y0, fr, fq);
            f32x4 qc = mm_tile(L + L_KH, LD, q0, L + L_VT, LD, p0, 2, Z4, fr, fq);
            qc = mm_tile(L + L_BH, LD, q0, L + L_U0T, LD, p0, 2, qc, fr, fq);
            st4_g(Y0p + p * 64 + q0 + 4 * fq, y0); st4_g(QCp + p * 64 + q0 + 4 * fq, qc); }
    }
    __syncthreads();
}
__device__ __forceinline__ void rwkv_state_scan(Frame& F, int bh) {
    LAS unsigned char* L = F.lds;
    const int lane = F.lane, w = F.wave, fr = lane & 15, fq = lane >> 4;
    const bf16* PT = (const bf16*)(F.ws + WS_PT) + (size_t)bh * NCH * 4096; const bf16* QC = (const bf16*)(F.ws + WS_QC) + (size_t)bh * NCH * 4096;
    bf16* S = (bf16*)(F.ws + WS_S) + (size_t)bh * NCH * 4096;
    f32x4 acc[2]; acc[0] = (f32x4){0.f, 0.f, 0.f, 0.f}; acc[1] = acc[0];
    for (int c = 0; c < NCH; ++c) {
        bf16x8 pf[2][2]; f32x4 qi[2];
#pragma unroll
        for (int q = 0; q < 2; ++q) { const int tw = 2 * w + q, p0 = 16 * (tw >> 2), q0 = 16 * (tw & 3);
            const int o = (p0 + fr) * 64 + q0 + 4 * fq;
            st4_g(S + (size_t)c * 4096 + o, acc[q]);
            st4_lds(L + (c & 1) * ARR + (p0 + fr) * LD + (q0 + 4 * fq) * 2, acc[q]);
            pf[q][0] = *(const GAS bf16x8*)(PT + (size_t)c * 4096 + (q0 + fr) * 64 + fq * 8); pf[q][1] = *(const GAS bf16x8*)(PT + (size_t)c * 4096 + (q0 + fr) * 64 + 32 + fq * 8);
            qi[q] = ld4_g(QC + (size_t)c * 4096 + o); }
        __syncthreads();
#pragma unroll
        for (int q = 0; q < 2; ++q) { const int tw = 2 * w + q, p0 = 16 * (tw >> 2);
            const LAS unsigned char* sp = L + (c & 1) * ARR + (p0 + fr) * LD + fq * 16;
            const bf16x8 s0 = *(const LAS bf16x8*)sp, s1 = *(const LAS bf16x8*)(sp + 64);
            f32x4 a = qi[q];
            a = __builtin_amdgcn_mfma_f32_16x16x32_bf16(pf[q][0], s0, a, 0, 0, 0);
            a = __builtin_amdgcn_mfma_f32_16x16x32_bf16(pf[q][1], s1, a, 0, 0, 0);
            acc[q] = a; }
    }
    __syncthreads();
}
__device__ __forceinline__ void rwkv_chunk_out(Frame& F, int item) {
    const float* PRM = (const float*)(F.ws + WS_PRM);
    LAS unsigned char* L = F.lds;
    const int lane = F.lane, w = F.wave, fr = lane & 15, fq = lane >> 4;
    const int bh = item / NCH, c = item % NCH, b = bh / RW_H, h = bh % RW_H; const int row0 = b * T + c * CH;
    const bf16* S = (const bf16*)(F.ws + WS_S) + (size_t)item * 4096; const bf16* RP = (const bf16*)(F.ws + WS_RP) + (size_t)item * 4096; const bf16* Y0 = (const bf16*)(F.ws + WS_Y0) + (size_t)item * 4096;
#pragma unroll
    for (int q = 0; q < 2; ++q) { const int tw = 2 * w + q, p0 = 16 * (tw >> 2), q0 = 16 * (tw & 3);
        f32x4 a = ld4_g(Y0 + (p0 + fr) * 64 + q0 + 4 * fq);
#pragma unroll
        for (int k = 0; k < 2; ++k) { const bf16x8 sf = *(const GAS bf16x8*)(S + (q0 + fr) * 64 + k * 32 + fq * 8), rf = *(const GAS bf16x8*)(RP + (p0 + fr) * 64 + k * 32 + fq * 8);
            a = __builtin_amdgcn_mfma_f32_16x16x32_bf16(sf, rf, a, 0, 0, 0); }
#pragma unroll
        for (int v = 0; v < 4; ++v) *(LAS float*)(L + L_YL + ((p0 + fr) * 65 + q0 + 4 * fq + v) * 4) = a[v];
    }
    __syncthreads();
    {
        const int ch = lane, gc = h * 64 + ch; const float gw = (PRM + 4608)[gc], gb = (PRM + 5120)[gc];
        const bf16* VB = (const bf16*)(F.ws + WS_VB) + (size_t)item * 4096; const bf16* G = (const bf16*)(F.ws + WS_G) + (size_t)item * 4096;
        bf16* YM = (bf16*)(F.ws + WS_YMIX);
#pragma unroll
        for (int tt = 0; tt < 8; ++tt) { const int t = 8 * w + tt;
            const float y = *(const LAS float*)(L + L_YL + (t * 65 + ch) * 4);
            const float mean = wave_sum(y) * (1.f / 64.f); const float d = y - mean; const float var = wave_sum(d * d) * (1.f / 64.f);
            const float yn = d * __builtin_amdgcn_rsqf(var + GN_EPS) * gw + gb;
            const float o = (yn + bf2f(VB[t * 64 + ch])) * bf2f(G[t * 64 + ch]);
            YM[(size_t)(row0 + t) * D + gc] = (bf16)f2bf(o); }
    }
    __syncthreads();
}
__device__ __forceinline__ void diff_post_rows(Frame& F) {
    const float* PRM = (const float*)(F.ws + WS_PRM);
    const int lane = F.lane; const int gw = F.vcu * NWAVES + F.wave, NGW = F.G * NWAVES;
    const float l1 = wave_sum((PRM + 5632)[lane] * (PRM + 5696)[lane]), l2 = wave_sum((PRM + 5760)[lane] * (PRM + 5824)[lane]);
    const float lam = __expf(l1) - __expf(l2) + LAMBDA_INIT;
    const int e0 = 2 * lane, vh = e0 >> 6, d = e0 & 63;
    const float sw0 = (PRM + 5888)[e0] * (1.f - LAMBDA_INIT), sw1 = (PRM + 5888)[e0 + 1] * (1.f - LAMBDA_INIT);
    const bf16* O = (const bf16*)(F.ws + WS_O); bf16* YM = (bf16*)(F.ws + WS_YMIX);
    for (int m = gw; m < M; m += NGW) {
#pragma unroll
        for (int hd = 0; hd < 4; ++hd) {
            const unsigned w1 = *(const GAS unsigned*)(O + (size_t)m * 1024 + (hd * 4 + vh) * 64 + d), w2 = *(const GAS unsigned*)(O + (size_t)m * 1024 + (hd * 4 + 2 + vh) * 64 + d);
            const float o0 = bflo(w1) - lam * bflo(w2), o1 = bfhi(w1) - lam * bfhi(w2);
            const float rs = __builtin_amdgcn_rsqf(wave_sum(o0 * o0 + o1 * o1) * (1.f / 128.f) + SUBLN_EPS);
            *(GAS unsigned*)(YM + (size_t)m * D + 512 + hd * 128 + e0) = pk2(o0 * rs * sw0, o1 * rs * sw1);
        }
    }
}
__global__ void __launch_bounds__(NWAVES * 64, 2) hybrid_fwd(const Args A) {
    extern __shared__ __attribute__((aligned(16))) unsigned char lds[];
    Frame F;
    F.lds = (LAS unsigned char*)lds;
    F.wave = __builtin_amdgcn_readfirstlane((int)threadIdx.x >> 6); F.lane = lane_id_asm(); F.tid = F.wave * 64 + F.lane;
    F.G = gridDim.x; { const int bx = blockIdx.x; F.vcu = (F.G % 8 == 0) ? (bx % 8) * (F.G / 8) + bx / 8 : bx; }
    F.ws = A.ws; F.ctl = (unsigned*)(A.ws + WS_CTL); F.out = A.out;
    const int lo = A.ph_lo, hi = A.ph_hi;
    cg::grid_group grid = cg::this_grid();
    volatile LAS unsigned* MISC = (volatile LAS unsigned*)(F.lds + L_MISC);
    if (F.tid < 16) MISC[F.tid] = 0u;
    __syncthreads();
    XcdBarrier bar; bar.bar = F.ctl + CW_BAR; bar.x = 0; bar.st = nullptr;
    if (hi - lo > 1) bar = xcd_barrier_post(F.ctl + CW_BAR, MISC + 8, F.wave);
    const float* PRM = (const float*)(F.ws + WS_PRM);
#define IN(k) (lo <= (k) && (k) < hi)
#define SEAM(k) do { if (hi - lo > 1) { if ((k) == 0) grid.sync(); else xcd_barrier(bar, F.wave); F.lane = lane_id_asm(); F.tid = F.wave * 64 + F.lane; } } while (0)
    bf16* XN = (bf16*)(F.ws + WS_XN); bf16* ACT = (bf16*)(F.ws + WS_ACT); float* Y = (float*)(F.ws + WS_Y); float* YMo = (float*)(F.ws + WS_YM);

    if (IN(0)) { for (int rep = 0; rep < REP0; ++rep) p0_prologue(F, A); } SEAM(0);
    if (IN(1)) { pg8::Gemm g{XN, (const bf16*)(F.ws + WS_WGU1), M, NGU, D}; pg8::StaticOrder S; S.init(M, NGU, F.G, (int)blockIdx.x);
        pg8::EpiSwiGLU E{ACT, FF}; pg8::gemm_phase<pg8::EpiSwiGLU, pg8::StaticOrder, true, true>(F.lds, g, S, E, F.wave); } SEAM(1);
    if (IN(2)) { pg8::Gemm g{ACT, (const bf16*)(F.ws + WS_WD1), M, D, FF}; pg8::StaticOrder S; S.init(M, D, F.G, (int)blockIdx.x);
        pg8::PanelRms s1{(float*)(F.ws + WS_X), F.ctl + CW_SEAM, NORM_EPS}, s2{(float*)(F.ws + WS_X) + 65536, F.ctl + CW_SEAM + SEAM_BANK, NORM_EPS};
        pg8::EpiRmsResRms E{A.in[0], F.out, XN, D, PRM + 6144, 0.5f, PRM + 7168, s1, s2};
        pg8::gemm_phase<pg8::EpiRmsResRms, pg8::StaticOrder, false, true>(F.lds, g, S, E, F.wave); } SEAM(2);
    if (IN(4)) { pg8::Gemm g{XN, (const bf16*)(F.ws + WS_WIN), M, NPW, D}; pg8::StaticOrder S; S.init(M, NPW, F.G, (int)blockIdx.x);
        pg8::EpiP E{(bf16*)(F.ws + WS_PRW), PRW, (bf16*)(F.ws + WS_PDF), PDF}; pg8::gemm_phase<pg8::EpiP, pg8::StaticOrder, true, true>(F.lds, g, S, E, F.wave); } SEAM(4);
    if (IN(5)) { for (int rep = 0; rep < REP5; ++rep) for (int it = F.vcu; it < NITEM; it += F.G) rwkv_chunk_prep(F, it); } SEAM(5);
    if (IN(6)) for (int rep = 0; rep < REP6; ++rep) {
        if (F.vcu < BATCH * RW_H) rwkv_state_scan(F, F.vcu);
        LAS unsigned* misc = (LAS unsigned*)(F.lds + L_MISC);
        const attn_body::bf16* Pd = (const attn_body::bf16*)(F.ws + WS_PDF);
        for (;;) {
            if (F.wave == 0 && lane_id_asm() == 0) misc[0] = atomicAdd(F.ctl + CW_QUEUE + 64 * rep, 1u);
            __syncthreads(); const unsigned idx = misc[0]; __syncthreads();
            if (idx >= 1024u) break;
            const int qb = 15 - (int)(idx >> 6), bhv = (int)(idx & 63u);
            attn_body::attn_unit<8>(bhv >> 4, bhv & 15, qb, Pd, Pd, Pd, (attn_body::bf16*)(F.ws + WS_O), (char*)lds, F.wave);
        }
    } SEAM(6);
    if (IN(7)) { for (int rep = 0; rep < REP7; ++rep) { for (int it = F.vcu; it < NITEM; it += F.G) rwkv_chunk_out(F, it); diff_post_rows(F); } } SEAM(7);
    if (IN(8)) { pg8::Gemm g{(const bf16*)(F.ws + WS_YMIX), (const bf16*)(F.ws + WS_WO), M, D, D}; pg8::StaticOrder S; S.init(M, D, F.G, (int)blockIdx.x);
        pg8::PanelRms s1{(float*)(F.ws + WS_X) + 2 * 65536, F.ctl + CW_SEAM + 2 * SEAM_BANK, NORM_EPS}, s2{(float*)(F.ws + WS_X) + 3 * 65536, F.ctl + CW_SEAM + 3 * SEAM_BANK, NORM_EPS};
        pg8::EpiRmsResRms E{F.out, F.out, XN, D, PRM + 8192, 1.0f, PRM + 9216, s1, s2};
        pg8::gemm_phase<pg8::EpiRmsResRms, pg8::StaticOrder, false, true>(F.lds, g, S, E, F.wave); } SEAM(8);
    if (IN(10)) { pg8::Gemm g{XN, (const bf16*)(F.ws + WS_WGU2), M, NGU, D}; pg8::StaticOrder S; S.init(M, NGU, F.G, (int)blockIdx.x);
        pg8::EpiSwiGLU E{ACT, FF}; pg8::gemm_phase<pg8::EpiSwiGLU, pg8::StaticOrder, true, true>(F.lds, g, S, E, F.wave); } SEAM(10);
    if (IN(11)) { pg8::Gemm g{ACT, (const bf16*)(F.ws + WS_WD2), M, D, FF}; pg8::StaticOrder S; S.init(M, D, F.G, (int)blockIdx.x);
        pg8::PanelRms s1{(float*)(F.ws + WS_X) + 4 * 65536, F.ctl + CW_SEAM + 4 * SEAM_BANK, NORM_EPS};
        pg8::EpiRmsRes E{F.out, F.out, D, PRM + 10240, 0.5f, s1};
        pg8::gemm_phase<pg8::EpiRmsRes, pg8::StaticOrder, false, true>(F.lds, g, S, E, F.wave); }
#undef IN
#undef SEAM
}

extern "C" void kernel_launch(void* const* d_in, const int* in_sizes, int n_in, void* d_out, int out_size, void* d_ws, size_t ws_size, hipStream_t stream) {
    static int grid = 0;
    if (grid == 0) {
        if (n_in != 31 || in_sizes[0] != M * D || out_size != M * D || ws_size < WS_END) { fprintf(stderr, "kernel_launch: unexpected shapes (n_in %d, in0 %d, out %d, ws %zu); nothing launched\n", n_in, n_in > 0 ? in_sizes[0] : -1, out_size, ws_size); grid = -1; return; }
        int dev = 0, cus = 0, per_cu = 0;
        if (hipGetDevice(&dev) != hipSuccess || hipDeviceGetAttribute(&cus, hipDeviceAttributeMultiprocessorCount, dev) != hipSuccess) { grid = -1; return; }
        if (hipFuncSetAttribute((const void*)hybrid_fwd, hipFuncAttributeMaxDynamicSharedMemorySize, LDS_BYTES) != hipSuccess) { fprintf(stderr, "kernel_launch: hipFuncSetAttribute failed\n"); grid = -1; return; }
        if (hipOccupancyMaxActiveBlocksPerMultiprocessor(&per_cu, (const void*)hybrid_fwd, NWAVES * 64, LDS_BYTES) != hipSuccess || per_cu < 1) { fprintf(stderr, "kernel_launch: occupancy query reports %d workgroups per CU\n", per_cu); per_cu = 1; }
        (void)hipGetLastError();
        grid = cus;
    }
    if (grid < 0) return;
    (void)hipMemsetAsync((char*)d_ws + WS_CTL, 0, CTL_ZERO_BYTES, stream);
    Args a{};
    for (int i = 0; i < 31; ++i) a.in[i] = (const float*)d_in[i];
    a.out = (float*)d_out; a.ws = (unsigned char*)d_ws;
#if MK_PER_PHASE
    for (int p = 0; p < N_PHASES; ++p) { a.ph_lo = p; a.ph_hi = p + 1; hipLaunchKernelGGL(hybrid_fwd, dim3(grid), dim3(NWAVES * 64), LDS_BYTES, stream, a); }
#else
    a.ph_lo = 0; a.ph_hi = N_PHASES;
    void* kargs[] = {&a};
    const hipError_t e = hipLaunchCooperativeKernel((const void*)hybrid_fwd, dim3(grid), dim3(NWAVES * 64), kargs, LDS_BYTES, stream);
    if (e != hipSuccess) fprintf(stderr, "kernel_launch: cooperative launch failed: %s (grid %d)\n", hipGetErrorString(e), grid);
#endif
}
```

```cpp
#include <hip/hip_runtime.h>
#include <hip/hip_cooperative_groups.h>
#include <cstdio>
#include <cstdint>
namespace cg = cooperative_groups;
__device__ __forceinline__ int lane_id_asm() { int l; asm volatile("v_mbcnt_lo_u32_b32 %0, -1, 0\n\tv_mbcnt_hi_u32_b32 %0, -1, %0" : "=v"(l)); return l; }
namespace pg8 {
#define PG8_LAS __attribute__((address_space(3)))
typedef unsigned short bf16_t;
typedef short bf16x8 __attribute__((ext_vector_type(8)));
typedef float f32x4 __attribute__((ext_vector_type(4)));
typedef unsigned u32x4 __attribute__((ext_vector_type(4)));
constexpr int BM = 256, BK = 64, HALF = 128, HTB = HALF * BK * 2  , STAGE_BYTES = 8 * HTB, NXCD = 8, WGM = 8;

__host__ __device__ __forceinline__ int lds_byte(int r, int c) { const int st = (r >> 4) * 2 + (c >> 5), rr = r & 15, cc = c & 31, ob = rr * 64 + cc * 2; return st * 1024 + (ob ^ (((ob >> 9) & 1) << 5)); }
__host__ __device__ __forceinline__ void stage_rc(int b, int& R, int& C) { const int st = b / 1024, sb = b % 1024, swz = sb ^ (((sb >> 9) & 1) << 5); R = (st >> 1) * 16 + swz / 64; C = (st & 1) * 32 + (swz % 64) / 2; }
__host__ __device__ __forceinline__ int perm32(int rho) { const int n = rho >> 4, i = rho & 15; return 8 * (i >> 2) + 4 * n + (i & 3); }

struct Unit { int pm, pn; };
struct Gemm { const bf16_t* A; const bf16_t* Bt; int M, N, K; };

struct StaticOrder {
    int nM, nN, nwg, G, c;
    __host__ __device__ void init(int M, int N, int G_, int c_) { nM = M / BM; nN = N / BM; nwg = nM * nN; G = G_; c = c_; }
    __host__ __device__ bool next(int i, Unit& u) const {
        const long L = (long)i * G + c; if (L >= nwg) return false;
        int wgid = (int)L; { const int q = nwg / NXCD, r = nwg % NXCD, xcd = wgid % NXCD, off = wgid / NXCD; wgid = (xcd < r ? xcd * (q + 1) : r * (q + 1) + (xcd - r) * q) + off; }
        const int nig = WGM * nN, gid = wgid / nig, fm = gid * WGM, gsz = (nM - fm) < WGM ? (nM - fm) : WGM;
        u.pm = fm + ((wgid % nig) % gsz); u.pn = (wgid % nig) / gsz; return true;
    }
    __device__ __forceinline__ void a_ready(const Unit&) const {}
    __device__ __forceinline__ void done(const Unit&) const {}
};

__device__ __forceinline__ unsigned cvt_pk_bf16(float lo, float hi) { unsigned r; asm volatile("v_cvt_pk_bf16_f32 %0, %1, %2" : "=v"(r) : "v"(lo), "v"(hi)); return r; }
__device__ __forceinline__ float silu_mul(float g, float u) { return g * __builtin_amdgcn_rcpf(1.0f + __builtin_amdgcn_exp2f(-1.4426950408889634f * g)) * u; }
typedef float f32x2p __attribute__((ext_vector_type(2)));
__device__ __forceinline__ f32x2p silu_mul2(f32x2p g, f32x2p u) {
    const f32x2p t = g * (-1.4426950408889634f); f32x2p e; e.x = __builtin_amdgcn_exp2f(t.x); e.y = __builtin_amdgcn_exp2f(t.y);
    const f32x2p d = e + 1.0f; f32x2p r; r.x = __builtin_amdgcn_rcpf(d.x); r.y = __builtin_amdgcn_rcpf(d.y);
    return (g * u) * r;
}
struct EpiSwiGLU {
    static constexpr bool PERM = true, AFTER_DRAIN = false;
    bf16_t* O; int ldc;
    __device__ __forceinline__ void operator()(const f32x4 (&acc)[2][2][4][2], const Unit& u, int wr, int wc, int fr, int fq) const {
        const int row0 = u.pm * BM + wr * 64 + fr, col0 = u.pn * HALF + wc * 32 + 8 * fq;
#pragma unroll
        for (int ai = 0; ai < 2; ++ai)
#pragma unroll
            for (int m = 0; m < 4; ++m) { bf16_t* rowp = O + (size_t)(row0 + ai * HALF + m * 16) * ldc + col0;
                const f32x4 g0 = acc[ai][0][m][0], g1 = acc[ai][0][m][1], u0 = acc[ai][1][m][0], u1 = acc[ai][1][m][1];
                const f32x2p a = silu_mul2((f32x2p){g0[0], g0[1]}, (f32x2p){u0[0], u0[1]}), b = silu_mul2((f32x2p){g0[2], g0[3]}, (f32x2p){u0[2], u0[3]});
                const f32x2p c = silu_mul2((f32x2p){g1[0], g1[1]}, (f32x2p){u1[0], u1[1]}), d = silu_mul2((f32x2p){g1[2], g1[3]}, (f32x2p){u1[2], u1[3]});
                u32x4 w; w.x = cvt_pk_bf16(a.x, a.y); w.y = cvt_pk_bf16(b.x, b.y); w.z = cvt_pk_bf16(c.x, c.y); w.w = cvt_pk_bf16(d.x, d.y);
                *(u32x4*)rowp = w; }
    }
};
struct EpiF32 {
    static constexpr bool PERM = false, AFTER_DRAIN = false;
    float* O; int ldc;
    __device__ __forceinline__ void operator()(const f32x4 (&acc)[2][2][4][2], const Unit& u, int wr, int wc, int fr, int fq) const {
        const int row0 = u.pm * BM + wr * 64 + fr, col0 = u.pn * BM + wc * 32 + 4 * fq;
#pragma unroll
        for (int ai = 0; ai < 2; ++ai)
#pragma unroll
            for (int m = 0; m < 4; ++m) { float* rowp = O + (size_t)(row0 + ai * HALF + m * 16) * ldc + col0;
#pragma unroll
                for (int bj = 0; bj < 2; ++bj)
#pragma unroll
                    for (int n = 0; n < 2; ++n) *(f32x4*)(rowp + bj * HALF + n * 16) = acc[ai][bj][m][n]; }
    }
};
struct EpiP {
    static constexpr bool PERM = true, AFTER_DRAIN = false;
    bf16_t* O0; int ld0; bf16_t* O1; int ld1;
    __device__ __forceinline__ void operator()(const f32x4 (&acc)[2][2][4][2], const Unit& u, int wr, int wc, int fr, int fq) const {
        const int row0 = u.pm * BM + wr * 64 + fr; const bool first = u.pn < 8;
        bf16_t* base = first ? O0 : O1; const int ldc = first ? ld0 : ld1; const int col0 = (first ? u.pn : u.pn - 8) * BM + wc * 32 + 8 * fq;
#pragma unroll
        for (int ai = 0; ai < 2; ++ai)
#pragma unroll
            for (int m = 0; m < 4; ++m) { bf16_t* rowp = base + (size_t)(row0 + ai * HALF + m * 16) * ldc + col0;
#pragma unroll
                for (int bj = 0; bj < 2; ++bj) { const f32x4 v0 = acc[ai][bj][m][0], v1 = acc[ai][bj][m][1];
                    u32x4 w; w.x = cvt_pk_bf16(v0[0], v0[1]); w.y = cvt_pk_bf16(v0[2], v0[3]); w.z = cvt_pk_bf16(v1[0], v1[1]); w.w = cvt_pk_bf16(v1[2], v1[3]);
                    *(u32x4*)(rowp + bj * HALF) = w; } }
    }
};

struct PanelRms {
    float* xbuf;
    unsigned* cnt;
    float eps;
    __device__ __forceinline__ void run(const f32x4 (&v)[2][2][4][2], const Unit& u, int wr, int wc, int fr, int fq, PG8_LAS unsigned char* lds, int wid, int lane) const {
        PG8_LAS float* P = (PG8_LAS float*)lds;
        PG8_LAS float* S = (PG8_LAS float*)(lds + 8192);
#pragma unroll
        for (int ai = 0; ai < 2; ++ai)
#pragma unroll
            for (int m = 0; m < 4; ++m) {
                float s = 0.f;
#pragma unroll
                for (int bj = 0; bj < 2; ++bj)
#pragma unroll
                    for (int n = 0; n < 2; ++n) { const f32x4 x = v[ai][bj][m][n]; s += (x[0] * x[0] + x[1] * x[1]) + (x[2] * x[2] + x[3] * x[3]); }
                s += __shfl_xor(s, 16); s += __shfl_xor(s, 32);
                if (fq == 0) P[(ai * HALF + wr * 64 + m * 16 + fr) * 4 + wc] = s;
            }
        asm volatile("s_waitcnt lgkmcnt(0)" ::: "memory"); __builtin_amdgcn_s_barrier(); asm volatile("" ::: "memory");
        const int row = wid * 32 + (lane & 31);
        if (lane < 32) {
            const float t = (P[row * 4 + 0] + P[row * 4 + 1]) + (P[row * 4 + 2] + P[row * 4 + 3]);
            __hip_atomic_store(xbuf + ((size_t)(u.pm * BM + row) * 4 + u.pn), t, __ATOMIC_RELAXED, __HIP_MEMORY_SCOPE_AGENT);
        }
        asm volatile("s_waitcnt vmcnt(0)" ::: "memory");
        if (lane == 0) __hip_atomic_fetch_add(cnt + 64 * u.pm, 1u, __ATOMIC_RELAXED, __HIP_MEMORY_SCOPE_AGENT);
        if (wid == 0) {
            unsigned spins = 0;
            for (;;) {
                if ((unsigned)__builtin_amdgcn_readfirstlane(__hip_atomic_load(cnt + 64 * u.pm, __ATOMIC_RELAXED, __HIP_MEMORY_SCOPE_AGENT)) >= 32u) break;
                if (++spins > (1u << 22)) break;
                __builtin_amdgcn_s_sleep(2);
            }
            __builtin_amdgcn_fence(__ATOMIC_ACQUIRE, "agent");
        }
        asm volatile("s_waitcnt vmcnt(0) lgkmcnt(0)" ::: "memory"); __builtin_amdgcn_s_barrier(); asm volatile("" ::: "memory");
        if (lane < 32) {
            const float* slot = xbuf + (size_t)(u.pm * BM + row) * 4; float q = 0.f;
#pragma unroll
            for (int t = 0; t < 4; ++t) q += __hip_atomic_load(slot + t, __ATOMIC_RELAXED, __HIP_MEMORY_SCOPE_AGENT);
            S[row] = __builtin_amdgcn_rsqf(q * (1.0f / 1024.0f) + eps);
        }
        asm volatile("s_waitcnt lgkmcnt(0)" ::: "memory"); __builtin_amdgcn_s_barrier(); asm volatile("" ::: "memory");
    }
};
template <bool BF> __device__ __forceinline__ void ld_res8(const void* base, size_t off, f32x4& a, f32x4& b) {
    if constexpr (BF) { const u32x4 w = __builtin_nontemporal_load((const u32x4*)((const bf16_t*)base + off));
        a = (f32x4){__builtin_bit_cast(float, w.x << 16), __builtin_bit_cast(float, w.x & 0xffff0000u), __builtin_bit_cast(float, w.y << 16), __builtin_bit_cast(float, w.y & 0xffff0000u)};
        b = (f32x4){__builtin_bit_cast(float, w.z << 16), __builtin_bit_cast(float, w.z & 0xffff0000u), __builtin_bit_cast(float, w.w << 16), __builtin_bit_cast(float, w.w & 0xffff0000u)}; }
    else { a = __builtin_nontemporal_load((const f32x4*)((const float*)base + off)); b = __builtin_nontemporal_load((const f32x4*)((const float*)base + off + 4)); }
}
__device__ __forceinline__ u32x4 pack_bf8(f32x4 a, f32x4 b) { u32x4 w; w.x = cvt_pk_bf16(a[0], a[1]); w.y = cvt_pk_bf16(a[2], a[3]); w.z = cvt_pk_bf16(b[0], b[1]); w.w = cvt_pk_bf16(b[2], b[3]); return w; }
template <bool BF> struct EpiRmsRes {
    static constexpr bool PERM = true, AFTER_DRAIN = true;
    const void* base; float* out; int ldc; const float* g1; float coef; PanelRms st;
    __device__ __forceinline__ void fused(f32x4 (&acc)[2][2][4][2], const Unit& u, int wr, int wc, int fr, int fq, PG8_LAS unsigned char* lds, int wid, int lane) const {
        const PG8_LAS float* S = (const PG8_LAS float*)(lds + 8192);
        const int col0 = u.pn * BM + wc * 32 + 8 * fq;
        f32x4 pre[4][2][2];
#pragma unroll
        for (int m = 0; m < 4; ++m) { const size_t off = (size_t)(u.pm * BM + wr * 64 + m * 16 + fr) * ldc + col0;
#pragma unroll
            for (int bj = 0; bj < 2; ++bj) ld_res8<BF>(base, off + bj * HALF, pre[m][bj][0], pre[m][bj][1]); }
        st.run(acc, u, wr, wc, fr, fq, lds, wid, lane);
        f32x4 gv[2][2];
#pragma unroll
        for (int bj = 0; bj < 2; ++bj)
#pragma unroll
            for (int n = 0; n < 2; ++n) gv[bj][n] = *(const f32x4*)(g1 + col0 + bj * HALF + n * 4) * coef;
#pragma unroll
        for (int ai = 0; ai < 2; ++ai)
#pragma unroll
            for (int m = 0; m < 4; ++m) { const int r = ai * HALF + wr * 64 + m * 16 + fr; const float rs = S[r]; const size_t off = (size_t)(u.pm * BM + r) * ldc + col0;
#pragma unroll
                for (int bj = 0; bj < 2; ++bj) { f32x4 b0, b1; if (ai == 0) { b0 = pre[m][bj][0]; b1 = pre[m][bj][1]; } else ld_res8<BF>(base, off + bj * HALF, b0, b1);
                    __builtin_nontemporal_store(b0 + acc[ai][bj][m][0] * gv[bj][0] * rs, (f32x4*)(out + off + bj * HALF));
                    __builtin_nontemporal_store(b1 + acc[ai][bj][m][1] * gv[bj][1] * rs, (f32x4*)(out + off + bj * HALF + 4)); }
                if (m & 1) asm volatile("" ::: "memory"); }
    }
};
template <bool BF> struct EpiRmsResRms {
    static constexpr bool PERM = true, AFTER_DRAIN = true;
    const void* base; bf16_t* out; bf16_t* xn; int ldc; const float* g1; float coef; const float* g2; PanelRms st1, st2;
    __device__ __forceinline__ void fused(f32x4 (&acc)[2][2][4][2], const Unit& u, int wr, int wc, int fr, int fq, PG8_LAS unsigned char* lds, int wid, int lane) const {
        const PG8_LAS float* S = (const PG8_LAS float*)(lds + 8192);
        const int col0 = u.pn * BM + wc * 32 + 8 * fq;
        f32x4 pre[4][2][2];
#pragma unroll
        for (int m = 0; m < 4; ++m) { const size_t off = (size_t)(u.pm * BM + wr * 64 + m * 16 + fr) * ldc + col0;
#pragma unroll
            for (int bj = 0; bj < 2; ++bj) ld_res8<BF>(base, off + bj * HALF, pre[m][bj][0], pre[m][bj][1]); }
        st1.run(acc, u, wr, wc, fr, fq, lds, wid, lane);
        {
            f32x4 gv[2][2];
#pragma unroll
            for (int bj = 0; bj < 2; ++bj)
#pragma unroll
                for (int n = 0; n < 2; ++n) gv[bj][n] = *(const f32x4*)(g1 + col0 + bj * HALF + n * 4) * coef;
#pragma unroll
            for (int ai = 0; ai < 2; ++ai)
#pragma unroll
                for (int m = 0; m < 4; ++m) { const int r = ai * HALF + wr * 64 + m * 16 + fr; const float rs = S[r]; const size_t off = (size_t)(u.pm * BM + r) * ldc + col0;
#pragma unroll
                    for (int bj = 0; bj < 2; ++bj) { f32x4 b0, b1; if (ai == 0) { b0 = pre[m][bj][0]; b1 = pre[m][bj][1]; } else ld_res8<BF>(base, off + bj * HALF, b0, b1);
                        acc[ai][bj][m][0] = b0 + acc[ai][bj][m][0] * gv[bj][0] * rs; acc[ai][bj][m][1] = b1 + acc[ai][bj][m][1] * gv[bj][1] * rs; }
                    asm volatile("" : "+v"(acc[ai][0][m][0]), "+v"(acc[ai][0][m][1]), "+v"(acc[ai][1][m][0]), "+v"(acc[ai][1][m][1]));
                    if (m & 1) asm volatile("" ::: "memory"); }
        }
        st2.run(acc, u, wr, wc, fr, fq, lds, wid, lane);
        f32x4 gv[2][2];
#pragma unroll
        for (int bj = 0; bj < 2; ++bj)
#pragma unroll
            for (int n = 0; n < 2; ++n) gv[bj][n] = *(const f32x4*)(g2 + col0 + bj * HALF + n * 4);
#pragma unroll
        for (int ai = 0; ai < 2; ++ai)
#pragma unroll
            for (int m = 0; m < 4; ++m) { const int r = ai * HALF + wr * 64 + m * 16 + fr; const float rs = S[r]; const size_t off = (size_t)(u.pm * BM + r) * ldc + col0;
#pragma unroll
                for (int bj = 0; bj < 2; ++bj) { const f32x4 x0 = acc[ai][bj][m][0], x1 = acc[ai][bj][m][1];
                    __builtin_nontemporal_store(pack_bf8(x0, x1), (u32x4*)(out + off + bj * HALF));
                    *(u32x4*)(xn + off + bj * HALF) = pack_bf8(x0 * gv[bj][0] * rs, x1 * gv[bj][1] * rs); }
                asm volatile("" ::: "memory"); }
    }
};

template <class Epi, class Sched, bool ALIGN_EPI = false, bool SP2 = false>
__device__ __forceinline__ void gemm_phase(PG8_LAS unsigned char* lds, const Gemm g, const Sched& S, const Epi& E, const int wid) {
    const int lane = lane_id_asm(), tid = wid * 64 + lane, wr = wid >> 2, wc = wid & 3, fr = lane & 15, fq = lane >> 4;
    const int K = g.K, nt = K / BK;
    unsigned voffA[2], voffB[2];
#pragma unroll
    for (int i = 0; i < 2; ++i) { int R, C; stage_rc(tid * 16 + i * 8192, R, C); const int Rb = Epi::PERM ? ((R & ~31) + perm32(R & 31)) : R;
        voffA[i] = (unsigned)(R * K + C) * 2u; voffB[i] = (unsigned)(Rb * K + C) * 2u; }
    const size_t kstep = (size_t)(BK * 2);
    const size_t hstep = (size_t)HALF * K * 2;
    const size_t tstep = 2 * hstep;
    const unsigned ldsw = (unsigned)wid * 1024u;
    const int aoff = lds_byte(wr * 64 + fr, fq * 8), boff = lds_byte(wc * 32 + fr, fq * 8);
#define PG8_SA(b, h) (((b) * 2 + (h)) * HTB)
#define PG8_SB(b, h) ((4 + (b) * 2 + (h)) * HTB)
#define PG8_STAGE(bufoff, gbase, voff) do { _Pragma("unroll") for (int _i = 0; _i < 2; ++_i) \
        __builtin_amdgcn_global_load_lds((const unsigned*)((const char*)(gbase) + (voff)[_i]), (PG8_LAS unsigned*)(lds + (bufoff) + ldsw + _i * 8192), 16, 0, 0); } while (0)
#define PG8_LDA(dst, b, h) do { _Pragma("unroll") for (int m = 0; m < 4; ++m) _Pragma("unroll") for (int k = 0; k < 2; ++k) dst[m][k] = *(const PG8_LAS bf16x8*)(lds + PG8_SA(b, h) + aoff + m * 2048 + k * 1024); } while (0)
#define PG8_LDB(dst, b, h) do { _Pragma("unroll") for (int n = 0; n < 2; ++n) _Pragma("unroll") for (int k = 0; k < 2; ++k) dst[n][k] = *(const PG8_LAS bf16x8*)(lds + PG8_SB(b, h) + boff + n * 2048 + k * 1024); } while (0)
#define PG8_MMA(ai, bj, At, Bt) do { __builtin_amdgcn_s_setprio(1); _Pragma("unroll") for (int m = 0; m < 4; ++m) _Pragma("unroll") for (int n = 0; n < 2; ++n) _Pragma("unroll") for (int k = 0; k < 2; ++k) \
        acc[ai][bj][m][n] = __builtin_amdgcn_mfma_f32_16x16x32_bf16(Bt[n][k], At[m][k], acc[ai][bj][m][n], 0, 0, 0); __builtin_amdgcn_s_setprio(0); } while (0)
#define PG8_WAIT_V(n) asm volatile("s_waitcnt vmcnt(" #n ")" ::: "memory")
#define PG8_WAIT_L(n) asm volatile("s_waitcnt lgkmcnt(" #n ")" ::: "memory")
#define PG8_BAR __builtin_amdgcn_s_barrier()
#define PG8_SCHED __builtin_amdgcn_sched_barrier(0)
    Unit cur, nxt; int ui = 0;
    if (!S.next(0, cur)) return;
    f32x4 acc[2][2][4][2];
#pragma unroll
    for (int a = 0; a < 2; ++a)
#pragma unroll
        for (int b = 0; b < 2; ++b)
#pragma unroll
            for (int m = 0; m < 4; ++m)
#pragma unroll
                for (int n = 0; n < 2; ++n) acc[a][b][m][n] = (f32x4){0.f, 0.f, 0.f, 0.f};
    bf16x8 At[4][2], B0[2][2], B1[2][2];
    const char* cA = (const char*)g.A + (size_t)cur.pm * tstep; const char* cB = (const char*)g.Bt + (size_t)cur.pn * tstep;
    S.a_ready(cur);
    if constexpr (SP2) {
        PG8_STAGE(PG8_SB(0, 0), cB, voffB); PG8_STAGE(PG8_SB(0, 1), cB + hstep, voffB); PG8_STAGE(PG8_SA(0, 0), cA, voffA); PG8_STAGE(PG8_SA(0, 1), cA + hstep, voffA);
        if (wr == 1) PG8_BAR;
        PG8_WAIT_V(2); PG8_BAR;
        PG8_STAGE(PG8_SB(1, 0), cB + kstep, voffB); PG8_STAGE(PG8_SA(1, 0), cA + kstep, voffA); PG8_STAGE(PG8_SB(1, 1), cB + hstep + kstep, voffB);
        PG8_WAIT_V(6); PG8_BAR;
    } else {
        PG8_STAGE(PG8_SB(0, 0), cB, voffB); PG8_STAGE(PG8_SA(0, 0), cA, voffA); PG8_STAGE(PG8_SB(0, 1), cB + hstep, voffB); PG8_STAGE(PG8_SA(0, 1), cA + hstep, voffA);
        if (wr == 1) PG8_BAR;
        PG8_WAIT_V(4); PG8_BAR;
        PG8_STAGE(PG8_SB(1, 0), cB + kstep, voffB); PG8_STAGE(PG8_SA(1, 0), cA + kstep, voffA); PG8_STAGE(PG8_SB(1, 1), cB + hstep + kstep, voffB);
        PG8_WAIT_V(6); PG8_BAR;
    }
    for (;;) {
        const bool has_next = S.next(ui + 1, nxt);
        const char* nA = has_next ? (const char*)g.A + (size_t)nxt.pm * tstep : cA; const char* nB = has_next ? (const char*)g.Bt + (size_t)nxt.pn * tstep : cB;
        for (int t = 0; t < nt; t += 2) {
            const bool last = (t == nt - 2);
            const char* a1 = cA + (size_t)(t + 1) * kstep;
            const char* a2 = last ? nA : cA + (size_t)(t + 2) * kstep; const char* b2 = last ? nB : cB + (size_t)(t + 2) * kstep;
            const char* a3 = a2 + kstep; const char* b3 = b2 + kstep;
            if (last && has_next) S.a_ready(nxt);
            if constexpr (SP2) {
            PG8_LDB(B0, 0, 0); PG8_LDB(B1, 0, 1); PG8_SCHED; PG8_LDA(At, 0, 0); PG8_STAGE(PG8_SA(1, 1), a1 + hstep, voffA);
            PG8_WAIT_V(8); PG8_WAIT_L(0); PG8_BAR; PG8_MMA(0, 0, At, B0); PG8_MMA(0, 1, At, B1); PG8_BAR; PG8_SCHED;
            PG8_LDA(At, 0, 1); PG8_STAGE(PG8_SB(0, 0), b2, voffB); PG8_STAGE(PG8_SB(0, 1), b2 + hstep, voffB); PG8_STAGE(PG8_SA(0, 0), a2, voffA);
            PG8_WAIT_V(8); PG8_WAIT_L(0); PG8_BAR; PG8_MMA(1, 0, At, B0); PG8_MMA(1, 1, At, B1); PG8_BAR; PG8_SCHED;
            PG8_LDB(B0, 1, 0); PG8_LDB(B1, 1, 1); PG8_SCHED; PG8_LDA(At, 1, 0); PG8_STAGE(PG8_SA(0, 1), a2 + hstep, voffA);
            PG8_WAIT_V(8); PG8_WAIT_L(0); PG8_BAR; PG8_MMA(0, 0, At, B0); PG8_MMA(0, 1, At, B1); PG8_BAR; PG8_SCHED;
            PG8_LDA(At, 1, 1); PG8_STAGE(PG8_SB(1, 0), b3, voffB); PG8_STAGE(PG8_SB(1, 1), b3 + hstep, voffB); PG8_STAGE(PG8_SA(1, 0), a3, voffA);
            PG8_WAIT_V(8); PG8_WAIT_L(0); PG8_BAR; PG8_MMA(1, 0, At, B0); PG8_MMA(1, 1, At, B1); PG8_BAR; PG8_SCHED;
            } else {
            PG8_LDB(B0, 0, 0); PG8_SCHED; PG8_LDA(At, 0, 0); PG8_STAGE(PG8_SA(1, 1), a1 + hstep, voffA);
            PG8_WAIT_L(8); PG8_BAR; PG8_WAIT_L(0); PG8_MMA(0, 0, At, B0); PG8_BAR; PG8_SCHED;
            PG8_LDB(B1, 0, 1); PG8_STAGE(PG8_SB(0, 0), b2, voffB);
            PG8_BAR; PG8_WAIT_L(0); PG8_MMA(0, 1, At, B1); PG8_BAR;
            PG8_LDA(At, 0, 1); PG8_STAGE(PG8_SA(0, 0), a2, voffA);
            PG8_BAR; PG8_WAIT_L(0); PG8_MMA(1, 0, At, B0); PG8_BAR; PG8_SCHED;
            PG8_STAGE(PG8_SB(0, 1), b2 + hstep, voffB);
            PG8_WAIT_V(6); PG8_BAR; PG8_MMA(1, 1, At, B1); PG8_BAR;
            PG8_LDB(B0, 1, 0); PG8_SCHED; PG8_LDA(At, 1, 0); PG8_STAGE(PG8_SA(0, 1), a2 + hstep, voffA);
            PG8_WAIT_L(8); PG8_BAR; PG8_WAIT_L(0); PG8_MMA(0, 0, At, B0); PG8_BAR; PG8_SCHED;
            PG8_LDB(B1, 1, 1); PG8_STAGE(PG8_SB(1, 0), b3, voffB);
            PG8_BAR; PG8_WAIT_L(0); PG8_MMA(0, 1, At, B1); PG8_BAR;
            PG8_LDA(At, 1, 1); PG8_STAGE(PG8_SA(1, 0), a3, voffA);
            PG8_BAR; PG8_WAIT_L(0); PG8_MMA(1, 0, At, B0); PG8_BAR; PG8_SCHED;
            PG8_STAGE(PG8_SB(1, 1), b3 + hstep, voffB);
            PG8_WAIT_V(6); PG8_BAR; PG8_MMA(1, 1, At, B1); PG8_BAR;
            }
        }
        if constexpr (ALIGN_EPI) { if (wr == 0) PG8_BAR; }
        if constexpr (!Epi::AFTER_DRAIN) { E(acc, cur, wr, wc, fr, fq); S.done(cur); }
        if (!has_next) break;
#pragma unroll
        for (int a = 0; a < 2; ++a)
#pragma unroll
            for (int b = 0; b < 2; ++b)
#pragma unroll
                for (int m = 0; m < 4; ++m)
#pragma unroll
                    for (int n = 0; n < 2; ++n) acc[a][b][m][n] = (f32x4){0.f, 0.f, 0.f, 0.f};
        cur = nxt; cA = nA; cB = nB; ++ui;
        if constexpr (ALIGN_EPI) { if (wr == 1) PG8_BAR; }
    }
    PG8_WAIT_V(0);
    if constexpr (!ALIGN_EPI) { if (wr == 0) PG8_BAR; }
    PG8_BAR;
    if constexpr (Epi::AFTER_DRAIN) { E.fused(acc, cur, wr, wc, fr, fq, lds, wid, lane); S.done(cur); }
#undef PG8_SA
#undef PG8_SB
#undef PG8_STAGE
#undef PG8_LDA
#undef PG8_LDB
#undef PG8_MMA
#undef PG8_WAIT_V
#undef PG8_WAIT_L
#undef PG8_BAR
#undef PG8_SCHED
}
}
#include <hip/hip_bf16.h>
#include <cmath>
namespace attn_body {
using bf16=__hip_bfloat16;
using bf16x8=__attribute__((ext_vector_type(8)))short;
using s16x4=__attribute__((ext_vector_type(4)))short;
using f32x16=__attribute__((ext_vector_type(16)))float;
using u32x4=__attribute__((ext_vector_type(4)))unsigned;
constexpr int BATCH=4,NHEAD=16,SEQ=4096,D=64,PD=1536,PO=1024;
constexpr int NW=8,QBLK=32,QB=QBLK*NW,KVBLK=64,NQB=SEQ/QB;
constexpr int ATTN_UNIT_ROWS=QB;
__device__ __forceinline__ int crow(int r,int hi){return (r&3)+8*(r>>2)+4*hi;}
#define SBAR() __builtin_amdgcn_sched_barrier(0)
__device__ __forceinline__ void cmask(f32x16&p0,f32x16&p1,int jb,int qrel,int hi){
  const float NEG=-INFINITY; int kb=64*jb+4*hi;
  #pragma unroll
  for(int r=0;r<16;++r){int kv=kb+(r&3)+8*(r>>2); if(kv>qrel)p0[r]=NEG; if(kv+32>qrel)p1[r]=NEG;}
}

constexpr int NSLOT=3, SLOTB=8192;
constexpr int LDS_K=0, LDS_V=NSLOT*SLOTB, LDS_WS=2*NSLOT*SLOTB, LDS_OST=LDS_WS+NW*64*4, LDS_BYTES=LDS_OST+NW*4096;
constexpr float C2=0.125f*1.4426950408889634f;
__device__ __forceinline__ void glds16(const void*gsrc,unsigned lds_dst){unsigned keep;
  asm volatile("s_mov_b32 %0, m0\n\ts_mov_b32 m0, %2\n\ts_nop 0\n\tglobal_load_lds_dwordx4 %1, off\n\ts_mov_b32 m0, %0":"=&s"(keep):"v"(gsrc),"s"(lds_dst):"memory");}
__device__ __forceinline__ float max3f(float a,float b,float c){float r;asm("v_max3_f32 %0, %1, %2, %3":"=v"(r):"v"(a),"v"(b),"v"(c));return r;}
__device__ __forceinline__ float max2f(float a,float b){float r;asm("v_max_f32_e32 %0, %1, %2":"=v"(r):"v"(a),"v"(b));return r;}
__device__ __forceinline__ float fadd_s(float a,float b){float r;asm("v_add_f32_e32 %0, %1, %2":"=v"(r):"v"(a),"v"(b));return r;}
__device__ __forceinline__ float fsub_s(float a,float b){float r;asm("v_sub_f32_e32 %0, %1, %2":"=v"(r):"v"(a),"v"(b));return r;}
typedef float f32x2_t __attribute__((ext_vector_type(2))); typedef __bf16 bf16x2_t __attribute__((ext_vector_type(2)));
__device__ __forceinline__ unsigned cvtpk_s(float lo,float hi){f32x2_t v={lo,hi};bf16x2_t b=__builtin_convertvector(v,bf16x2_t);return __builtin_bit_cast(unsigned,b);}
#define WAIT_BAR(N) asm volatile("s_waitcnt vmcnt(" #N ") lgkmcnt(0)\n\ts_barrier":::"memory")

__device__ __forceinline__ void qkt(f32x16&p0,f32x16&p1,const char*Kslot,const bf16x8*qr,const f32x16&negm,int r32,int hi){
  const char*kb=Kslot+hi*1024+r32*16;
  #pragma unroll
  for(int d0=0;d0<4;++d0){
    const bf16x8 b0=*reinterpret_cast<const bf16x8*>(kb+d0*2048);
    const bf16x8 b1=*reinterpret_cast<const bf16x8*>(kb+d0*2048+512);
    if(d0==0){p0=__builtin_amdgcn_mfma_f32_32x32x16_bf16(b0,qr[0],negm,0,0,0);p1=__builtin_amdgcn_mfma_f32_32x32x16_bf16(b1,qr[0],negm,0,0,0);}
    else{p0=__builtin_amdgcn_mfma_f32_32x32x16_bf16(b0,qr[d0],p0,0,0,0);p1=__builtin_amdgcn_mfma_f32_32x32x16_bf16(b1,qr[d0],p1,0,0,0);}}
}
typedef __attribute__((address_space(3))) const char* lds_cptr;
typedef short v4i16_t __attribute__((ext_vector_type(4)));
__device__ __forceinline__ void kload8(bf16x8*kf,lds_cptr kp){
  kf[0]=*(const __attribute__((address_space(3))) bf16x8*)(kp);      kf[1]=*(const __attribute__((address_space(3))) bf16x8*)(kp+512);
  kf[2]=*(const __attribute__((address_space(3))) bf16x8*)(kp+2048); kf[3]=*(const __attribute__((address_space(3))) bf16x8*)(kp+2560);
  kf[4]=*(const __attribute__((address_space(3))) bf16x8*)(kp+4096); kf[5]=*(const __attribute__((address_space(3))) bf16x8*)(kp+4608);
  kf[6]=*(const __attribute__((address_space(3))) bf16x8*)(kp+6144); kf[7]=*(const __attribute__((address_space(3))) bf16x8*)(kp+6656);
}
__device__ __forceinline__ void kload2(bf16x8*kf,lds_cptr kp,int j){ kf[2*j]=*(const __attribute__((address_space(3))) bf16x8*)(kp+j*2048); kf[2*j+1]=*(const __attribute__((address_space(3))) bf16x8*)(kp+j*2048+512); }
__device__ __forceinline__ s16x4 vtr(lds_cptr p){ return __builtin_bit_cast(s16x4,__builtin_amdgcn_ds_read_tr16_b64_v4i16((__attribute__((address_space(3))) v4i16_t*)p)); }
__device__ __forceinline__ float rowmax(const f32x16&p0,const f32x16&p1){
  float a=max3f(p0[0],p0[1],p1[0]),b=max3f(p0[2],p0[3],p1[1]);a=max3f(a,p1[2],p1[3]);
  #pragma unroll
  for(int r=4;r<16;r+=4){a=max3f(a,p0[r],p0[r+1]);b=max3f(b,p0[r+2],p0[r+3]);a=max3f(a,p1[r],p1[r+1]);b=max3f(b,p1[r+2],p1[r+3]);}
  const float m=max2f(a,b);
  auto rr=__builtin_amdgcn_permlane32_swap(__float_as_uint(m),__float_as_uint(m),false,false);
  return max2f(__uint_as_float(rr[0]),__uint_as_float(rr[1]));
}
__device__ __forceinline__ void pv(f32x16*o,int vb,bf16x8 pa0,bf16x8 pa1,bf16x8 pa2,bf16x8 pa3){
  #pragma unroll
  for(int d0=0;d0<2;++d0){s16x4 lo[4],hi[4];
    #pragma unroll
    for(int ks=0;ks<4;++ks){
      asm volatile("ds_read_b64_tr_b16 %0,%1 offset:%c2":"=&v"(lo[ks]):"v"(vb),"i"(d0*4096+ks*1024):"memory");
      asm volatile("ds_read_b64_tr_b16 %0,%1 offset:%c2":"=&v"(hi[ks]):"v"(vb),"i"(d0*4096+ks*1024+512):"memory");}
    asm volatile("s_waitcnt lgkmcnt(0)":::"memory");SBAR();
    #define PK(k) (bf16x8){lo[k][0],lo[k][1],lo[k][2],lo[k][3],hi[k][0],hi[k][1],hi[k][2],hi[k][3]}
    o[d0]=__builtin_amdgcn_mfma_f32_32x32x16_bf16(pa0,PK(0),o[d0],0,0,0);
    o[d0]=__builtin_amdgcn_mfma_f32_32x32x16_bf16(pa1,PK(1),o[d0],0,0,0);
    o[d0]=__builtin_amdgcn_mfma_f32_32x32x16_bf16(pa2,PK(2),o[d0],0,0,0);
    o[d0]=__builtin_amdgcn_mfma_f32_32x32x16_bf16(pa3,PK(3),o[d0],0,0,0);
    #undef PK
  }
}

#ifndef ATTN_STORE16
#define ATTN_STORE16(p,v) (*(u32x4*)(p)=(v))
#endif
template<int THRL> __device__ __forceinline__ void attn_unit(int b,int h,int qb,const bf16*Q,const bf16*__restrict__ K,const bf16*__restrict__ V,bf16*O,char*shm,const int wid){
  const int lane=lane_id_asm(),tid=wid*64+lane,r32=lane&31,hi=lane>>5;
  const long rowbase=(long)b*SEQ; const int q0=qb*QB;
  const int qcol=(h>>1)*64, kcol=512+(h>>1)*64, vcol=1024+(h>>2)*128+(h&1)*64, ocol=h*64;
  const bf16*Qw=Q+(rowbase+q0+wid*QBLK)*PD+qcol;
  const bf16*Kh=K+rowbase*PD+kcol,*Vh=V+rowbase*PD+vcol;
  const unsigned lds0=(unsigned)(uintptr_t)shm;
  float*wsf=(float*)(shm+LDS_WS)+wid*64;
  const bf16*ksrc=Kh+(long)lane*PD+wid*8;
  const bf16*vsrc=Vh+(long)(16*(wid&3)+(lane>>2))*PD+(wid>>2)*32+(lane&3)*8;
  const unsigned kdst=lds0+LDS_K+wid*1024, vdst=lds0+LDS_V+wid*1024;
  #define DMA_K(t,slot) glds16(ksrc+(long)(t)*KVBLK*PD,(unsigned)__builtin_amdgcn_readfirstlane(kdst+(slot)))
  #define DMA_V(t,slot) glds16(vsrc+(long)(t)*KVBLK*PD,(unsigned)__builtin_amdgcn_readfirstlane(vdst+(slot)))
  const int vb0=(int)(lds0+LDS_V)+((lane>>4)&1)*32+(lane&3)*8+(4*hi+((lane&15)>>2))*64;
  const char*Kbase=shm+LDS_K; bf16x8 kf[8];
  const lds_cptr shm3=(lds_cptr)shm; const lds_cptr kp0=shm3+LDS_K+hi*1024+r32*16; const lds_cptr vp0=shm3+LDS_V+((lane>>4)&1)*32+(lane&3)*8+(4*hi+((lane&15)>>2))*64;
  const int NT=(q0+QB)/KVBLK;
  DMA_K(0,0);DMA_V(0,0);DMA_K(1,SLOTB);
  bf16x8 qr[4];
  #pragma unroll
  for(int d0=0;d0<4;++d0)qr[d0]=*reinterpret_cast<const bf16x8*>(&Qw[(long)r32*PD+d0*16+hi*8]);
  float mhat=0.f,l_reg=0.f;f32x16 o[2];o[0]=f32x16{};o[1]=f32x16{};f32x16 negm=f32x16{};asm volatile("":"+v"(negm));
  const int qrel=wid*QBLK+r32;
  #define CMASK(P0,P1,t) do{int jb_=(t)-(NT-4); if(jb_>=0)cmask(P0,P1,jb_,qrel,hi);}while(0)
  bool resc=false;
  #define START(P0,P1) do{ const float rm=rowmax(P0,P1); resc=false; \
    { const float dl=rm; mhat=fadd_s(mhat,dl); \
      _Pragma("unroll") for(int r=0;r<16;++r){P0[r]=fsub_s(P0[r],dl);P1[r]=fsub_s(P1[r],dl);} \
      _Pragma("unroll") for(int r=0;r<16;++r)negm[r]=-mhat; asm volatile("":"+v"(negm)); } \
    _Pragma("unroll") for(int r=0;r<16;++r)P0[r]=__builtin_amdgcn_exp2f(P0[r]); }while(0)
  #define RESC() do{ if(resc){ asm volatile("s_waitcnt lgkmcnt(0)":::"memory"); \
      _Pragma("unroll") for(int d_=0;d_<2;++d_) _Pragma("unroll") for(int r=0;r<16;++r)o[d_][r]*=wsf[crow(r,hi)]; } }while(0)
  f32x16 pA0,pA1,pB0,pB1;
  int sl_prev=0,sl_cur=0,sl_next=SLOTB;
  #define ROT() do{sl_prev=sl_cur;sl_cur=sl_next;sl_next=(sl_next==(NSLOT-1)*SLOTB)?0:sl_next+SLOTB;}while(0)
  DMA_K(2,2*SLOTB);
  WAIT_BAR(3);
  qkt(pA0,pA1,Kbase,qr,negm,r32,hi);asm volatile("s_nop 15\n\ts_nop 7":"+v"(pA0),"+v"(pA1));CMASK(pA0,pA1,0);
  START(pA0,pA1);
  _Pragma("unroll") for(int r=0;r<16;++r)pA1[r]=__builtin_amdgcn_exp2f(pA1[r]);
  WAIT_BAR(0);
  DMA_K(3,0);DMA_V(1,SLOTB);
  ROT();
  kload8(kf,kp0+sl_cur);
  WAIT_BAR(2);
  s16x4 vlo[8],vhi[8]; u32x4 pw0,pw1,pw2,pw3;
  #define PKW(P,B) cvtpk_s(P[B],P[B+1])
  #define PAF(k) __builtin_bit_cast(bf16x8,pw##k)
  #define VFR(i) (bf16x8){vlo[i][0],vlo[i][1],vlo[i][2],vlo[i][3],vhi[i][0],vhi[i][1],vhi[i][2],vhi[i][3]}
  #define PIN(x) asm volatile("":"+v"(x))
  #define MX3(a,b,c) __builtin_fmaxf(__builtin_fmaxf((a),(b)),(c))
  #define GAPA(MF,A0,A1,A2,A3,W0,W1,PW) do{ MF; sacc+=A0; sacc+=A1; sacc+=A2; sacc+=A3; PIN(sacc); W0; W1; PIN(PW); SBAR(); }while(0)
  #define EX(v) __builtin_amdgcn_exp2f(v)
  #define GAPB(MF,X,B) do{ MF; X[B]=EX(X[B]); X[B+1]=EX(X[B+1]); X[B+2]=EX(X[B+2]); X[B+3]=EX(X[B+3]); PIN(X); SBAR(); }while(0)
  #define VRD(i) do{ vlo[i]=vtr(vp_+(((i)>>2)*4096+((i)&3)*1024)); vhi[i]=vtr(vp_+(((i)>>2)*4096+((i)&3)*1024+512)); }while(0)
  #define KRD(G,j) do{ if(G){ kload2(kf,kp0+sl_next,j); SBAR(); } }while(0)
  #define STEP(C0,C1,P0,P1,t,GK,GV,GL) do{ SBAR(); \
    const lds_cptr vp_=vp0+sl_prev; \
    VRD(0); SBAR(); float sacc=(P0[0]+P0[1]); \
    GAPA(C0=__builtin_amdgcn_mfma_f32_32x32x16_bf16(kf[0],qr[0],negm,0,0,0), P0[2],P0[3],P0[4],P0[5],     pw0[0]=PKW(P0,0), pw0[1]=PKW(P0,2), pw0); \
    VRD(4); SBAR(); GAPA(C1=__builtin_amdgcn_mfma_f32_32x32x16_bf16(kf[1],qr[0],negm,0,0,0), P0[6],P0[7],P0[8],P0[9],     pw0[2]=PKW(P0,4), pw0[3]=PKW(P0,6), pw0); \
    VRD(1); SBAR(); GAPA(C0=__builtin_amdgcn_mfma_f32_32x32x16_bf16(kf[2],qr[1],C0,0,0,0),   P0[10],P0[11],P0[12],P0[13], pw1[0]=PKW(P0,8), pw1[1]=PKW(P0,10), pw1); \
    VRD(5); SBAR(); GAPA(C1=__builtin_amdgcn_mfma_f32_32x32x16_bf16(kf[3],qr[1],C1,0,0,0),   P0[14],P0[15],P1[0],P1[1],   pw1[2]=PKW(P0,12),pw1[3]=PKW(P0,14), pw1); \
    VRD(2); SBAR(); GAPA(C0=__builtin_amdgcn_mfma_f32_32x32x16_bf16(kf[4],qr[2],C0,0,0,0),   P1[2],P1[3],P1[4],P1[5],     pw2[0]=PKW(P1,0), pw2[1]=PKW(P1,2), pw2); \
    VRD(6); SBAR(); GAPA(C1=__builtin_amdgcn_mfma_f32_32x32x16_bf16(kf[5],qr[2],C1,0,0,0),   P1[6],P1[7],P1[8],P1[9],     pw2[2]=PKW(P1,4), pw2[3]=PKW(P1,6), pw2); \
    VRD(3); SBAR(); GAPA(C0=__builtin_amdgcn_mfma_f32_32x32x16_bf16(kf[6],qr[3],C0,0,0,0),   P1[10],P1[11],P1[12],P1[13], pw3[0]=PKW(P1,8), pw3[1]=PKW(P1,10), pw3); \
    VRD(7); SBAR(); GAPA(C1=__builtin_amdgcn_mfma_f32_32x32x16_bf16(kf[7],qr[3],C1,0,0,0),   P1[14],P1[15],0.f,0.f,       pw3[2]=PKW(P1,12),pw3[3]=PKW(P1,14), pw3); \
    l_reg+=sacc; \
    if(GK){DMA_K((t)+3,sl_cur);} if(GV){DMA_V((t)+1,sl_next);} \
    CMASK(C0,C1,t); \
    { float a=MX3(C0[0],C0[1],C1[0]),b=MX3(C0[2],C0[3],C1[1]); a=MX3(a,C1[2],C1[3]); \
      _Pragma("unroll") for(int r=4;r<16;r+=4){a=MX3(a,C0[r],C0[r+1]);b=MX3(b,C0[r+2],C0[r+3]);a=MX3(a,C1[r],C1[r+1]);b=MX3(b,C1[r+2],C1[r+3]);} \
      float rm=__builtin_fmaxf(a,b); { auto rr=__builtin_amdgcn_permlane32_swap(__float_as_uint(rm),__float_as_uint(rm),false,false); rm=__builtin_fmaxf(__uint_as_float(rr[0]),__uint_as_float(rr[1])); } \
      resc=false; \
      if(__builtin_expect(__any(rm>(float)THRL),0)){ const float dl=__builtin_fmaxf(rm,0.f); mhat+=dl; \
        _Pragma("unroll") for(int r=0;r<16;++r){C0[r]-=dl;C1[r]-=dl;} \
        _Pragma("unroll") for(int r=0;r<16;++r)negm[r]=-mhat; asm volatile("":"+v"(negm)); \
        const float f=__builtin_amdgcn_exp2f(-dl); l_reg*=f; if(hi==0)wsf[r32]=f; resc=true; } } \
    SBAR(); \
    GAPB(o[0]=__builtin_amdgcn_mfma_f32_32x32x16_bf16(PAF(0),VFR(0),o[0],0,0,0), C0,0); \
    GAPB(o[1]=__builtin_amdgcn_mfma_f32_32x32x16_bf16(PAF(0),VFR(4),o[1],0,0,0), C0,4); \
    KRD(GL,0); GAPB(o[0]=__builtin_amdgcn_mfma_f32_32x32x16_bf16(PAF(1),VFR(1),o[0],0,0,0), C0,8); \
    KRD(GL,1); GAPB(o[1]=__builtin_amdgcn_mfma_f32_32x32x16_bf16(PAF(1),VFR(5),o[1],0,0,0), C0,12); \
    KRD(GL,2); GAPB(o[0]=__builtin_amdgcn_mfma_f32_32x32x16_bf16(PAF(2),VFR(2),o[0],0,0,0), C1,0); \
    KRD(GL,3); GAPB(o[1]=__builtin_amdgcn_mfma_f32_32x32x16_bf16(PAF(2),VFR(6),o[1],0,0,0), C1,4); \
    GAPB(o[0]=__builtin_amdgcn_mfma_f32_32x32x16_bf16(PAF(3),VFR(3),o[0],0,0,0), C1,8); \
    GAPB(o[1]=__builtin_amdgcn_mfma_f32_32x32x16_bf16(PAF(3),VFR(7),o[1],0,0,0), C1,12); \
    }while(0)
  int t=1;
  #undef CMASK
  #define CMASK(P0,P1,t) do{}while(0)
  for(;t+5<NT;t+=2){
    STEP(pB0,pB1,pA0,pA1,t,true,true,true);     WAIT_BAR(2); RESC(); ROT();
    STEP(pA0,pA1,pB0,pB1,t+1,true,true,true);   WAIT_BAR(2); RESC(); ROT();
  }
  #undef CMASK
  #define CMASK(P0,P1,t) do{int jb_=(t)-(NT-4); if(jb_>=0)cmask(P0,P1,jb_,qrel,hi);}while(0)
  #define ENDW(tt) do{ if((tt)+3<NT){WAIT_BAR(2);} else if((tt)+2<NT){WAIT_BAR(1);} else {WAIT_BAR(0);} }while(0)
  for(;t+1<NT;t+=2){
    STEP(pB0,pB1,pA0,pA1,t,(t+3<NT),(t+1<NT),(t+1<NT));       ENDW(t);   RESC(); ROT();
    STEP(pA0,pA1,pB0,pB1,t+1,(t+4<NT),(t+2<NT),(t+2<NT));     ENDW(t+1); RESC(); ROT();
  }
  STEP(pB0,pB1,pA0,pA1,NT-1,false,false,false); RESC();
  { float sacc=pB0[0]+pB0[1]; _Pragma("unroll") for(int r=2;r<16;++r)sacc+=pB0[r]; _Pragma("unroll") for(int r=0;r<16;++r)sacc+=pB1[r]; l_reg+=sacc;
    pw0=(u32x4){PKW(pB0,0),PKW(pB0,2),PKW(pB0,4),PKW(pB0,6)};pw1=(u32x4){PKW(pB0,8),PKW(pB0,10),PKW(pB0,12),PKW(pB0,14)};pw2=(u32x4){PKW(pB1,0),PKW(pB1,2),PKW(pB1,4),PKW(pB1,6)};pw3=(u32x4){PKW(pB1,8),PKW(pB1,10),PKW(pB1,12),PKW(pB1,14)};
    SBAR(); pv(o,vb0+sl_cur,PAF(0),PAF(1),PAF(2),PAF(3)); }
  #undef PKW
  #undef PAF
  #undef VFR
  #undef PIN
  #undef MX3
  #undef GAPA
  #undef GAPB
  #undef EX
  #undef VRD
  #undef KRD
  #undef STEP
  #undef ENDW
  {auto rr=__builtin_amdgcn_permlane32_swap(__float_as_uint(l_reg),__float_as_uint(l_reg),false,false);l_reg=__uint_as_float(rr[0])+__uint_as_float(rr[1]);}
  if(hi==0)wsf[32+r32]=l_reg;asm volatile("s_waitcnt lgkmcnt(0)":::"memory");
  float rli[16];
  #pragma unroll
  for(int r=0;r<16;++r)rli[r]=__builtin_amdgcn_rcpf(wsf[32+crow(r,hi)]);
  bf16*Ow=O+(rowbase+q0+wid*QBLK)*PO+ocol;
  { bf16*stg=(bf16*)(shm+LDS_OST)+wid*2048;
    #pragma unroll
    for(int r=0;r<16;++r){const int orow=crow(r,hi);
      #pragma unroll
      for(int d0=0;d0<2;++d0)stg[orow*64+d0*32+r32]=__float2bfloat16(o[d0][r]*rli[r]);}
    asm volatile("s_waitcnt lgkmcnt(0)":::"memory");
    #pragma unroll
    for(int i=0;i<4;++i){const int row=i*8+(lane>>3),ch=lane&7; const u32x4 v=*(const u32x4*)(stg+row*64+ch*8); ATTN_STORE16(Ow+(long)row*PO+ch*8,v);} }
  asm volatile("s_waitcnt lgkmcnt(0)\n\ts_barrier":::"memory");
  #undef DMA_K
  #undef DMA_V
  #undef CMASK
  #undef START
  #undef RESC
  #undef ROT
}
constexpr int ATTN_LDS_BYTES=LDS_BYTES;
#undef SBAR
#undef WAIT_BAR
}
constexpr int NWAVES = 8;
constexpr int BATCH = 4, T = 4096, D = 1024, FF = 2816, M = BATCH * T;
constexpr int NGU = 2 * FF;
constexpr int RW_H = 8, RW_N = 64, RW_W = 512;
constexpr int SHIFT_COLS = 1824, PROJ_W = 3360;
constexpr int PRW = 2048, PDF = 1536, NPW = PRW + PDF;
constexpr int CH = 64, NCH = T / CH, NITEM = BATCH * RW_H * NCH;
constexpr float NORM_EPS = 1e-6f, GN_EPS = 64e-5f, SUBLN_EPS = 1e-5f, LAMBDA_INIT = 0.2f;
#ifndef MK_PER_PHASE
#define MK_PER_PHASE 0
#endif
constexpr int N_PHASES = 13;
#ifndef RS01
#define RS01 1
#endif
#ifndef RS2
#define RS2 1
#endif
#ifndef RA1
#define RA1 1
#endif
#ifndef RA3
#define RA3 1
#endif
#ifndef REP1
#define REP1 1
#endif
#ifndef REP4
#define REP4 1
#endif
#ifndef REPBAR
#define REPBAR 0
#endif
#ifndef REPSCAN
#define REPSCAN 1
#endif
#ifndef REPATT
#define REPATT 1
#endif
#ifndef REP2
#define REP2 1
#endif
#ifndef PROBE_PHASE
#define PROBE_PHASE -1
#endif
#ifndef PROBE_SUB
#define PROBE_SUB -1
#endif
#ifndef REP0
#define REP0 1
#endif
#ifndef REP5
#define REP5 1
#endif
#ifndef REP6
#define REP6 1
#endif
#ifndef REP7
#define REP7 1
#endif

constexpr size_t MiB = 1u << 20;
constexpr size_t WS_CTL = 0, CTL_ZERO_BYTES = 262144;
constexpr size_t WS_LORA = 1 * MiB;
constexpr size_t WS_WGU1 = 2 * MiB, WS_WD1 = 13 * MiB, WS_WIN = 19 * MiB, WS_WO = 26 * MiB, WS_WGU2 = 28 * MiB, WS_WD2 = 39 * MiB;
constexpr size_t WS_S = 2 * MiB;
constexpr size_t WS_XN = 48 * MiB;
constexpr size_t WS_PT = 48 * MiB, WS_QC = 64 * MiB;
constexpr size_t WS_ACT = 80 * MiB;
constexpr size_t WS_PRW = 80 * MiB, WS_PDF = 144 * MiB;
constexpr size_t WS_O = 80 * MiB, WS_YMIX = 112 * MiB;
constexpr size_t WS_VB = 192 * MiB, WS_G = 208 * MiB, WS_RP = 224 * MiB, WS_Y0 = 240 * MiB;
constexpr size_t WS_Y = 192 * MiB;
constexpr size_t WS_YM = 144 * MiB;
constexpr size_t WS_X = 45 * MiB;
constexpr int CW_SEAM = 32768, SEAM_BANK = 64 * 64;
constexpr size_t WS_END = 256 * MiB;
constexpr int CW_QUEUE = 64, CW_BAR = 4096;
constexpr size_t WS_PRM = 65536;

constexpr int ARR = 64 * 72 * 2;
constexpr int L_AT = 0, L_BT = ARR, L_KT = 2 * ARR, L_RT = 3 * ARR, L_ATT = 4 * ARR, L_VT = 5 * ARR, L_BH = 6 * ARR, L_KH = 7 * ARR;
constexpr int L_M = 8 * ARR, L_MT = 9 * ARR, L_TT = 10 * ARR, L_NAK = 11 * ARR, L_NRK = 12 * ARR, L_NRB = 13 * ARR;
constexpr int L_APT = L_AT, L_W1T = L_BT, L_U0T = L_KT;
constexpr int L_XW = L_M, L_XA = L_M + ARR, L_XG = L_M + 2 * ARR;
constexpr int FARR = 64 * 65 * 4;
constexpr int L_WL = L_M, L_AL = L_M + FARR, L_GL = L_M + 2 * FARR;
constexpr int L_GT = 14 * ARR;
constexpr int L_WC = L_GT + 2048;
constexpr int LDS_BYTES = 150 * 1024;
constexpr int L_MISC = LDS_BYTES - 256;
static_assert(L_GL + FARR <= L_GT && L_XG + 64 * 168 * 2 <= L_GT && L_WC + 256 <= L_MISC && 8 * 16640 <= L_MISC, "LDS map");
constexpr int L_LWA = L_M, L_LG = L_WC + 256;
static_assert(L_LG + 20480 <= L_MISC && 16384 <= 2 * ARR, "LoRA weight image");
constexpr int L_YL = 0;

#define GAS __attribute__((address_space(1)))
#define LAS __attribute__((address_space(3)))
typedef unsigned short bf16;
typedef unsigned v4u __attribute__((ext_vector_type(4)));
typedef unsigned v2u __attribute__((ext_vector_type(2)));
typedef float f32x4 __attribute__((ext_vector_type(4)));
typedef short bf16x8 __attribute__((ext_vector_type(8)));
#define LDS_WAIT() asm volatile("s_waitcnt lgkmcnt(0)" ::: "memory")
typedef float f32x2_k __attribute__((ext_vector_type(2))); typedef __bf16 bf16x2_k __attribute__((ext_vector_type(2)));
__device__ __forceinline__ unsigned pk2(float lo, float hi) { f32x2_k v = {lo, hi}; bf16x2_k b = __builtin_convertvector(v, bf16x2_k); return __builtin_bit_cast(unsigned, b); }
__device__ __forceinline__ unsigned f2bf(float f) { return pk2(f, 0.f) & 0xffffu; }
__device__ __forceinline__ float bf2f(unsigned short b) { return __builtin_bit_cast(float, (unsigned)b << 16); }
__device__ __forceinline__ float bflo(unsigned w) { return __builtin_bit_cast(float, w << 16); }
__device__ __forceinline__ float bfhi(unsigned w) { return __builtin_bit_cast(float, w & 0xffff0000u); }
__device__ __forceinline__ float dpp_add(float v, const int ctrl_sel) {
    const int x = __builtin_bit_cast(int, v); int y;
    if (ctrl_sel == 0) y = __builtin_amdgcn_update_dpp(0, x, 0xB1, 0xF, 0xF, true);
    else if (ctrl_sel == 1) y = __builtin_amdgcn_update_dpp(0, x, 0x4E, 0xF, 0xF, true);
    else if (ctrl_sel == 2) y = __builtin_amdgcn_update_dpp(0, x, 0x141, 0xF, 0xF, true);
    else y = __builtin_amdgcn_update_dpp(0, x, 0x140, 0xF, 0xF, true);
    return v + __builtin_bit_cast(float, y);
}
__device__ __forceinline__ float wave_sum(float v) {
    v = dpp_add(v, 0); v = dpp_add(v, 1); v = dpp_add(v, 2); v = dpp_add(v, 3);
    { auto rr = __builtin_amdgcn_permlane16_swap(__float_as_uint(v), __float_as_uint(v), false, false); v = __uint_as_float(rr[0]) + __uint_as_float(rr[1]); }
    { auto rr = __builtin_amdgcn_permlane32_swap(__float_as_uint(v), __float_as_uint(v), false, false); v = __uint_as_float(rr[0]) + __uint_as_float(rr[1]); }
    return v;
}
__device__ __forceinline__ float swap32_add(float a, float b) { auto rr = __builtin_amdgcn_permlane32_swap(__float_as_uint(a), __float_as_uint(b), false, false); return __uint_as_float(rr[0]) + __uint_as_float(rr[1]); }
__device__ __forceinline__ float swap16_add(float a, float b) { auto rr = __builtin_amdgcn_permlane16_swap(__float_as_uint(a), __float_as_uint(b), false, false); return __uint_as_float(rr[0]) + __uint_as_float(rr[1]); }
__device__ __forceinline__ void wave_sum8(float (&x)[8]) {
    const float y0 = swap32_add(x[0], x[4]), y1 = swap32_add(x[1], x[5]), y2 = swap32_add(x[2], x[6]), y3 = swap32_add(x[3], x[7]);
    float z0 = swap16_add(y0, y2), z1 = swap16_add(y1, y3);
    z0 = dpp_add(z0, 0); z1 = dpp_add(z1, 0); z0 = dpp_add(z0, 1); z1 = dpp_add(z1, 1); z0 = dpp_add(z0, 2); z1 = dpp_add(z1, 2); z0 = dpp_add(z0, 3); z1 = dpp_add(z1, 3);
    const int i0 = __builtin_bit_cast(int, z0), i1 = __builtin_bit_cast(int, z1);
    x[0] = __builtin_bit_cast(float, __builtin_amdgcn_readlane(i0, 0));  x[2] = __builtin_bit_cast(float, __builtin_amdgcn_readlane(i0, 16));
    x[4] = __builtin_bit_cast(float, __builtin_amdgcn_readlane(i0, 32)); x[6] = __builtin_bit_cast(float, __builtin_amdgcn_readlane(i0, 48));
    x[1] = __builtin_bit_cast(float, __builtin_amdgcn_readlane(i1, 0));  x[3] = __builtin_bit_cast(float, __builtin_amdgcn_readlane(i1, 16));
    x[5] = __builtin_bit_cast(float, __builtin_amdgcn_readlane(i1, 32)); x[7] = __builtin_bit_cast(float, __builtin_amdgcn_readlane(i1, 48));
}
__device__ __forceinline__ float sigmoidf_(float x) { return __builtin_amdgcn_rcpf(1.0f + __expf(-x)); }

typedef GAS unsigned gu32;
#define RLX_AGENT __ATOMIC_RELAXED, __HIP_MEMORY_SCOPE_AGENT
#define XB_TMO      128
#define XB_XCNT(j)  (256  + 64 * (j))
#define XB_XSUB(j)  (1280 + 64 * (j))
#define XB_XGEN(j)  (2304 + 64 * (j))
#define XB_TOP      3328
#define XB_TOPGEN   3392
#define XCD_BAR_WORDS 3456
#define XB_SPIN_CAP (1u << 18)

__device__ __forceinline__ unsigned xb_ld(unsigned* p)              { return __hip_atomic_load(p, __ATOMIC_RELAXED, __HIP_MEMORY_SCOPE_AGENT); }
__device__ __forceinline__ unsigned xb_add(unsigned* p, unsigned v) { return __hip_atomic_fetch_add(p, v, __ATOMIC_RELAXED, __HIP_MEMORY_SCOPE_AGENT); }
__device__ __forceinline__ unsigned xb_xcc_id() { return (unsigned)__builtin_amdgcn_s_getreg((3 << 11) | 20) & 0xFu; }
#define XB_SPIN(cond, bar) do { unsigned _sp = 0; while (cond) { __builtin_amdgcn_s_sleep(1); \
    if ((++_sp & 255u) == 0u) { if (xb_ld(&(bar)[XB_TMO])) break; if (_sp > XB_SPIN_CAP) { atomicAdd(&(bar)[XB_TMO], 1u); break; } } } } while (0)

struct XcdBarrier {
    unsigned* bar; unsigned x;
    volatile LAS unsigned* st;
};

__device__ __forceinline__ XcdBarrier xcd_barrier_post(unsigned* bar, volatile LAS unsigned* st, const int wid) {
    XcdBarrier b; b.bar = bar; b.x = xb_xcc_id(); b.st = st;
    if (wid == 0 && lane_id_asm() == 0) (void)xb_add(&bar[XB_XCNT(b.x)], 1u);
    return b;
}
__device__ __forceinline__ void xcd_barrier_complete(unsigned* bar, unsigned x, unsigned& nloc, unsigned& nx) {
    const unsigned G = gridDim.x * gridDim.y * gridDim.z;
    unsigned sum, cnt, mine, sp = 0u;
    for (;;) {
        sum = 0u; cnt = 0u; mine = 0u;
#pragma unroll
        for (unsigned j = 0; j < 16; ++j) { const unsigned c = xb_ld(&bar[XB_XCNT(j)]); sum += c; cnt += (c > 0u) ? 1u : 0u; mine = (j == x) ? c : mine; }
        if (sum == G) break;
        __builtin_amdgcn_s_sleep(1);
        if ((++sp & 255u) == 0u) { if (xb_ld(&bar[XB_TMO])) break; if (sp > XB_SPIN_CAP) { atomicAdd(&bar[XB_TMO], 1u); break; } }
    }
    nloc = mine > 0u ? mine : 1u; nx = cnt > 0u ? cnt : 1u;
}

__device__ __forceinline__ void xcd_barrier(const XcdBarrier& b, const int wid) {
    asm volatile("s_waitcnt vmcnt(0)" ::: "memory");
    __syncthreads();
    if (wid == 0 && lane_id_asm() == 0) {
        unsigned* bar = b.bar;
        __builtin_amdgcn_s_waitcnt(0);
        unsigned nloc = b.st[0], nx = b.st[1];
        if (nloc == 0u) { xcd_barrier_complete(bar, b.x, nloc, nx); b.st[0] = nloc; b.st[1] = nx; }
        const unsigned old = xb_add(&bar[XB_XSUB(b.x)], 1u);
        const unsigned gen = old / nloc;
        if (old + 1u == (gen + 1u) * nloc) {
            __builtin_amdgcn_fence(__ATOMIC_RELEASE, "agent");
            asm volatile("s_waitcnt vmcnt(0)" ::: "memory");
            const unsigned og = xb_add(&bar[XB_TOP], 1u);
            const unsigned tg = og / nx;
            if (og + 1u == (tg + 1u) * nx) xb_add(&bar[XB_TOPGEN], 1u);
            else XB_SPIN(xb_ld(&bar[XB_TOPGEN]) == tg, bar);
            __builtin_amdgcn_fence(__ATOMIC_ACQUIRE, "agent");
            xb_add(&bar[XB_XGEN(b.x)], 1u);
            asm volatile("s_waitcnt vmcnt(0)" ::: "memory");
        } else {
            XB_SPIN(xb_ld(&bar[XB_XGEN(b.x)]) == gen, bar);
            __builtin_amdgcn_fence(__ATOMIC_ACQUIRE, "agent");
            asm volatile("s_waitcnt vmcnt(0)" ::: "memory");
        }
    }
    __syncthreads();
}

struct Args { const float* in[31]; float* out; unsigned char* ws; int ph_lo, ph_hi; };
struct Frame {
    LAS unsigned char* lds;
    unsigned* ctl;
    int tid, lane, wave, vcu, G;
    float* out; unsigned char* ws;
};

struct P0Job { const float* W; bf16* WT; int K, N, ldk, kind, r; bool late; };
__device__ __forceinline__ void p0_load(const P0Job& j, f32x4 (&v)[16], int lane) {
    const int nblk = (j.N + 63) / 64, kb = j.r / nblk, nb = j.r % nblk, k0 = 64 * kb, n0 = 64 * nb;
    const int r = lane >> 4, c4 = lane & 15; const bool colok = n0 + 4 * c4 < j.N;
#pragma unroll
    for (int i = 0; i < 16; ++i) { const int kk = 4 * i + r; v[i] = (colok && k0 + kk < j.K) ? __builtin_nontemporal_load((const GAS f32x4*)(j.W + (size_t)(k0 + kk) * j.N + n0 + 4 * c4)) : (f32x4){0.f, 0.f, 0.f, 0.f}; }
}
__device__ __forceinline__ int p0_drow(int kind, int n0) {
    if (kind == 1) return 256 * (n0 >> 7) + (n0 & 127);
    if (kind == 2) return 256 * (n0 >> 7) + 128 + (n0 & 127);
    if (kind == 3) return (n0 >= SHIFT_COLS) ? n0 + (PRW - SHIFT_COLS) : n0;
    return n0;
}
__device__ __forceinline__ float p0_scale(int kind, int n0) { return (kind == 3 && n0 >= SHIFT_COLS && n0 < SHIFT_COLS + 512) ? attn_body::C2 : 1.f; }
__device__ __forceinline__ void p0_finish(const P0Job& j, const f32x4 (&v)[16], LAS float* scr, int lane) {
    const int nblk = (j.N + 63) / 64, kb = j.r / nblk, nb = j.r % nblk, k0 = 64 * kb, n0 = 64 * nb;
    const int r = lane >> 4, c4 = lane & 15; const float sc = (c4 < 8) ? p0_scale(j.kind, n0) : p0_scale(j.kind, n0 + 32);
#pragma unroll
    for (int i = 0; i < 16; ++i) { const int kk = 4 * i + r; LAS float* d = scr + kk * 65 + 4 * c4; d[0] = v[i][0] * sc; d[1] = v[i][1] * sc; d[2] = v[i][2] * sc; d[3] = v[i][3] * sc; }
    LDS_WAIT(); asm volatile("" ::: "memory");
    const int c = lane & 7;
#pragma unroll
    for (int hb = 0; hb < 2; ++hb) { const int drow0 = p0_drow(j.kind, n0 + 32 * hb);
        if (n0 + 32 * hb < j.N && k0 + 8 * c < j.K) {
#pragma unroll
            for (int jj = 0; jj < 4; ++jj) { const int n = (lane >> 3) + 8 * jj; const LAS float* sp = scr + (8 * c) * 65 + 32 * hb + n;
                v4u o; o.x = pk2(sp[0 * 65], sp[1 * 65]); o.y = pk2(sp[2 * 65], sp[3 * 65]); o.z = pk2(sp[4 * 65], sp[5 * 65]); o.w = pk2(sp[6 * 65], sp[7 * 65]);
                GAS v4u* dp = (GAS v4u*)(j.WT + (size_t)(drow0 + n) * j.ldk + k0 + 8 * c); if (j.late) __builtin_nontemporal_store(o, dp); else *dp = o; } } }
    LDS_WAIT(); asm volatile("" ::: "memory");
}
template <int MODE> __device__ __forceinline__ void norm_rows(Frame& F, const float* xin, const float* y, const float* g1, float coef, float* xo, const float* g2, bf16* xn) {
    const int gw = F.vcu * NWAVES + F.wave, NGW = F.G * NWAVES;
    f32x4 gg1[4], gg2[4];
#pragma unroll
    for (int j = 0; j < 4; ++j) { if (MODE != 0) gg1[j] = ((const f32x4*)g1)[F.lane + 64 * j]; if (MODE != 2) gg2[j] = ((const f32x4*)g2)[F.lane + 64 * j]; }
    for (int m = gw; m < M; m += NGW) {
        f32x4 v[4];
#pragma unroll
        for (int j = 0; j < 4; ++j) v[j] = (MODE == 0) ? __builtin_nontemporal_load((const f32x4*)(xin + (size_t)m * D) + F.lane + 64 * j) : ((const f32x4*)(xin + (size_t)m * D))[F.lane + 64 * j];
        if (MODE != 0) {
            f32x4 yy[4]; float s = 0.f;
#pragma unroll
            for (int j = 0; j < 4; ++j) { yy[j] = ((const f32x4*)(y + (size_t)m * D))[F.lane + 64 * j]; s += (yy[j].x * yy[j].x + yy[j].y * yy[j].y) + (yy[j].z * yy[j].z + yy[j].w * yy[j].w); }
            const float rs = coef * __builtin_amdgcn_rsqf(wave_sum(s) * (1.f / D) + NORM_EPS);
#pragma unroll
            for (int j = 0; j < 4; ++j) { v[j] = v[j] + yy[j] * gg1[j] * rs; ((f32x4*)(xo + (size_t)m * D))[F.lane + 64 * j] = v[j]; }
        }
        if (MODE != 2) {
            float s = 0.f;
#pragma unroll
            for (int j = 0; j < 4; ++j) s += (v[j].x * v[j].x + v[j].y * v[j].y) + (v[j].z * v[j].z + v[j].w * v[j].w);
            const float rs = __builtin_amdgcn_rsqf(wave_sum(s) * (1.f / D) + NORM_EPS);
            unsigned long long* o8 = (unsigned long long*)(xn + (size_t)m * D) + F.lane;
#pragma unroll
            for (int j = 0; j < 4; ++j) { const f32x4 o = v[j] * gg2[j] * rs; o8[64 * j] = (unsigned long long)pk2(o.x, o.y) | ((unsigned long long)pk2(o.z, o.w) << 32); }
        }
    }
}
constexpr int P0_I_GU = (D / 64) * (FF / 64), P0_I_DN = (FF / 64) * (D / 64), P0_I_IN = (D / 64) * ((PROJ_W + 63) / 64), P0_I_O = (D / 64) * (D / 64), P0_I_L = 512 / 64, P0_I_G = 3 * (512 / 64);
constexpr int P0_R0 = 2 * P0_I_GU, P0_R1 = P0_R0 + P0_I_DN + P0_I_IN + P0_I_O + 2 * P0_I_L + P0_I_G, P0_R2 = P0_R1 + 2 * P0_I_GU, P0_NITEMS = P0_R2 + P0_I_DN;
__device__ __forceinline__ void p0_convert_range(Frame& F, const Args& A, int first, int last, int gw, int NW) {
    LAS float* scr = (LAS float*)(F.lds + F.wave * 16640);
    bf16* lora = (bf16*)(F.ws + WS_LORA);
    constexpr int I_GU = P0_I_GU, I_DN = P0_I_DN, I_IN = P0_I_IN, I_O = P0_I_O, I_L = P0_I_L;
    auto resolve = [&](int it, P0Job& j) {
        int r = it; j.kind = 0; j.late = false;
        if (r < I_GU) { j.W = A.in[3]; j.WT = (bf16*)(F.ws + WS_WGU1); j.K = D; j.N = FF; j.ldk = D; j.kind = 1; j.r = r; return; } r -= I_GU;
        if (r < I_GU) { j.W = A.in[4]; j.WT = (bf16*)(F.ws + WS_WGU1); j.K = D; j.N = FF; j.ldk = D; j.kind = 2; j.r = r; return; } r -= I_GU;
        if (r < I_DN) { j.W = A.in[5]; j.WT = (bf16*)(F.ws + WS_WD1); j.K = FF; j.N = D; j.ldk = FF; j.r = r; return; } r -= I_DN;
        if (r < I_IN) { j.W = A.in[8]; j.WT = (bf16*)(F.ws + WS_WIN); j.K = D; j.N = PROJ_W; j.ldk = D; j.kind = 3; j.r = r; return; } r -= I_IN;
        if (r < I_O) { j.W = A.in[10]; j.WT = (bf16*)(F.ws + WS_WO); j.K = D; j.N = D; j.ldk = D; j.r = r; return; } r -= I_O;
        if (r < I_L) { j.W = A.in[12]; j.WT = lora; j.K = 64; j.N = 512; j.ldk = 64; j.r = r; return; } r -= I_L;
        if (r < I_L) { j.W = A.in[14]; j.WT = lora + 512 * 64; j.K = 64; j.N = 512; j.ldk = 64; j.r = r; return; } r -= I_L;
        if (r < P0_I_G) { j.W = A.in[15]; j.WT = lora + 2 * 512 * 64; j.K = 160; j.N = 512; j.ldk = 160; j.r = r; return; } r -= P0_I_G;
        if (r < I_GU) { j.W = A.in[28]; j.WT = (bf16*)(F.ws + WS_WGU2); j.K = D; j.N = FF; j.ldk = D; j.kind = 1; j.r = r; j.late = true; return; } r -= I_GU;
        if (r < I_GU) { j.W = A.in[29]; j.WT = (bf16*)(F.ws + WS_WGU2); j.K = D; j.N = FF; j.ldk = D; j.kind = 2; j.r = r; j.late = true; return; } r -= I_GU;
        j.W = A.in[30]; j.WT = (bf16*)(F.ws + WS_WD2); j.K = FF; j.N = D; j.ldk = FF; j.r = r; j.late = true;
    };
    for (int it = first + gw; it < last; it += 2 * NW) {
        P0Job ja, jb; f32x4 va[16], vb[16]; const bool hasb = it + NW < last;
        resolve(it, ja); p0_load(ja, va, F.lane);
        if (hasb) { resolve(it + NW, jb); p0_load(jb, vb, F.lane); }
        p0_finish(ja, va, scr, F.lane);
        if (hasb) p0_finish(jb, vb, scr, F.lane);
    }
}
__device__ __forceinline__ void p0_prologue(Frame& F, const Args& A) {
    p0_convert_range(F, A, 0, P0_R0, F.vcu * NWAVES + F.wave, F.G * NWAVES);
    {
        GAS v4u* z = (GAS v4u*)(F.ws + WS_WIN + (size_t)SHIFT_COLS * D * 2); const int nz = (PRW - SHIFT_COLS) * D * 2 / 16;
        for (int i = (F.vcu * NWAVES + F.wave) * 64 + F.lane; i < nz; i += F.G * NWAVES * 64) z[i] = (v4u){0u, 0u, 0u, 0u};
    }
    {
        float* PRMw = (float*)(F.ws + WS_PRM); const int gt = (F.vcu * NWAVES + F.wave) * 64 + F.lane, GT = F.G * NWAVES * 64;
        for (int i = gt; i < 1824; i += GT) PRMw[0 + i] = A.in[9][i];
        for (int i = gt; i < 512; i += GT) PRMw[2048 + i] = A.in[11][i];
        for (int i = gt; i < 512; i += GT) PRMw[2560 + i] = A.in[13][i];
        for (int i = gt; i < 512; i += GT) PRMw[3072 + i] = A.in[16][i];
        for (int i = gt; i < 512; i += GT) PRMw[3584 + i] = A.in[17][i];
        for (int i = gt; i < 512; i += GT) PRMw[4096 + i] = A.in[18][i];
        for (int i = gt; i < 512; i += GT) PRMw[4608 + i] = A.in[19][i];
        for (int i = gt; i < 512; i += GT) PRMw[5120 + i] = A.in[20][i];
        for (int i = gt; i < 64; i += GT) PRMw[5632 + i] = A.in[21][i];
        for (int i = gt; i < 64; i += GT) PRMw[5696 + i] = A.in[22][i];
        for (int i = gt; i < 64; i += GT) PRMw[5760 + i] = A.in[23][i];
        for (int i = gt; i < 64; i += GT) PRMw[5824 + i] = A.in[24][i];
        for (int i = gt; i < 128; i += GT) PRMw[5888 + i] = A.in[25][i];
        for (int i = gt; i < 1024; i += GT) PRMw[6144 + i] = A.in[2][i];
        for (int i = gt; i < 1024; i += GT) PRMw[7168 + i] = A.in[6][i];
        for (int i = gt; i < 1024; i += GT) PRMw[8192 + i] = A.in[7][i];
        for (int i = gt; i < 1024; i += GT) PRMw[9216 + i] = A.in[26][i];
        for (int i = gt; i < 1024; i += GT) PRMw[10240 + i] = A.in[27][i];
    }
    norm_rows<0>(F, A.in[0], nullptr, nullptr, 0.f, nullptr, A.in[1], (bf16*)(F.ws + WS_XN));
}

__device__ __forceinline__ f32x4 mm_tile(const LAS unsigned char* X, int ldx, int x0, const LAS unsigned char* Y, int ldy, int y0, int ksteps, f32x4 acc, int fr, int fq) {
    const LAS unsigned char* xp = X + (x0 + fr) * ldx + fq * 16; const LAS unsigned char* yp = Y + (y0 + fr) * ldy + fq * 16;
    for (int k = 0; k < ksteps; ++k) { const bf16x8 a = *(const LAS bf16x8*)(xp + k * 64), b = *(const LAS bf16x8*)(yp + k * 64); acc = __builtin_amdgcn_mfma_f32_16x16x32_bf16(a, b, acc, 0, 0, 0); }
    return acc;
}
__device__ __forceinline__ void st4_lds(LAS unsigned char* p, f32x4 v) { v2u w; w.x = pk2(v[0], v[1]); w.y = pk2(v[2], v[3]); *(LAS v2u*)p = w; }
__device__ __forceinline__ void st4_g(bf16* p, f32x4 v) { v2u w; w.x = pk2(v[0], v[1]); w.y = pk2(v[2], v[3]); *(GAS v2u*)p = w; }
__device__ __forceinline__ f32x4 ld4_lds(const LAS unsigned char* p) { const v2u w = *(const LAS v2u*)p; return (f32x4){bflo(w.x), bfhi(w.x), bflo(w.y), bfhi(w.y)}; }
__device__ __forceinline__ f32x4 ld4_g(const bf16* p) { const v2u w = *(const GAS v2u*)p; return (f32x4){bflo(w.x), bfhi(w.x), bflo(w.y), bfhi(w.y)}; }
constexpr int LD = 144;
__device__ __forceinline__ void st4t_lds(LAS unsigned char* base, int p, int q, f32x4 v) {
    const unsigned w0 = pk2(v[0], v[1]), w1 = pk2(v[2], v[3]);
    *(LAS bf16*)(base + (q + 0) * LD + p * 2) = (bf16)(w0 & 0xffffu); *(LAS bf16*)(base + (q + 1) * LD + p * 2) = (bf16)(w0 >> 16);
    *(LAS bf16*)(base + (q + 2) * LD + p * 2) = (bf16)(w1 & 0xffffu); *(LAS bf16*)(base + (q + 3) * LD + p * 2) = (bf16)(w1 >> 16);
}

#define LBAR() asm volatile("s_waitcnt lgkmcnt(0)\n\ts_barrier" ::: "memory")
__device__ __forceinline__ void lora_load(const bf16* lora, int h, bf16x8 (&wq)[2][9], int w, int fr, int fq) {
#pragma unroll
    for (int q = 0; q < 2; ++q) { const int n0 = 16 * ((2 * w + q) & 3);
        const bf16* wrow = lora + (size_t)(h * 64 + n0 + fr) * 64 + fq * 8; const bf16* arow = wrow + 512 * 64; const bf16* grow = lora + 2 * 512 * 64 + (size_t)(h * 64 + n0 + fr) * 160 + fq * 8;
#pragma unroll
        for (int k = 0; k < 2; ++k) { wq[q][k] = *(const GAS bf16x8*)(wrow + k * 32); wq[q][2 + k] = *(const GAS bf16x8*)(arow + k * 32); }
#pragma unroll
        for (int k = 0; k < 5; ++k) wq[q][4 + k] = *(const GAS bf16x8*)(grow + k * 32); }
}
__device__ __forceinline__ void lora_dma(const bf16* lora, int h, unsigned lds0, int w, int lane) {
    for (int p = w; p < 36; p += NWAVES) {
        const bf16* src; unsigned dst;
        if (p < 16) { const int row = 8 * (p & 7) + (lane >> 3); src = lora + (p >= 8 ? 512 * 64 : 0) + (size_t)(h * 64 + row) * 64 + (lane & 7) * 8; dst = lds0 + L_LWA + p * 1024; }
        else { const int q = p - 16, ks = q >> 2, row = 16 * (q & 3) + (lane >> 2); src = lora + 2 * 512 * 64 + (size_t)(h * 64 + row) * 160 + ks * 32 + (lane & 3) * 8; dst = lds0 + L_LG + q * 1024; }
        attn_body::glds16(src, (unsigned)__builtin_amdgcn_readfirstlane(dst));
    }
}
__device__ __forceinline__ void rwkv_chunk_group(Frame& F, int bc, unsigned long long& tsub) {
#define TSUB(k) do { } while (0)
    const float* PRM = (const float*)(F.ws + WS_PRM);
    LAS unsigned char* L = F.lds;
    const int tid = F.tid, lane = F.lane, w = F.wave, fr = lane & 15, fq = lane >> 4;
    const int b = bc / NCH, c = bc % NCH;
    const int row0 = b * T + c * CH;
    const bf16* P = (const bf16*)(F.ws + WS_PRW);
    const float* mu = (PRM + 0);
    const f32x4 Z4 = (f32x4){0.f, 0.f, 0.f, 0.f};
#pragma unroll 1
    for (int i = 0; i < 5; ++i) { const int qd = tid + 512 * i; const int t = qd / 36, l0 = 8 * (qd % 36);
        if (qd < CH * 36) {
            const size_t off = (size_t)(row0 + t) * PRW + 1536 + l0; const v4u cur = *(const GAS v4u*)(P + off); v4u prv = (v4u){0u, 0u, 0u, 0u}; if (c * CH + t > 0) prv = *(const GAS v4u*)(P + off - PRW);
            const f32x4 m0 = *(const f32x4*)(mu + 1536 + l0), m1 = *(const f32x4*)(mu + 1536 + l0 + 4);
            float x[8];
#pragma unroll
            for (int e = 0; e < 4; ++e) { const unsigned cw = cur[e], pw = prv[e]; const float c0 = bflo(cw), c1 = bfhi(cw), p0 = bflo(pw), p1 = bfhi(pw);
                const float ma = (e < 2) ? m0[2 * e] : m1[2 * e - 4], mb = (e < 2) ? m0[2 * e + 1] : m1[2 * e - 3];
                x[2 * e] = c0 + (p0 - c0) * ma; x[2 * e + 1] = c1 + (p1 - c1) * mb; }
            LAS unsigned char* dst;
            if (l0 < 64) { dst = L + L_XW + t * LD + l0 * 2;
#pragma unroll
                for (int e = 0; e < 8; ++e) x[e] = 1.f - 2.f * __builtin_amdgcn_rcpf(1.f + __expf(2.f * x[e])); }
            else if (l0 < 128) { dst = L + L_XA + t * LD + (l0 - 64) * 2; }
            else { dst = L + L_XG + t * 336 + (l0 - 128) * 2;
#pragma unroll
                for (int e = 0; e < 8; ++e) x[e] = __builtin_amdgcn_rcpf(1.f + __expf(-x[e])); }
            *(LAS v4u*)dst = (v4u){pk2(x[0], x[1]), pk2(x[2], x[3]), pk2(x[4], x[5]), pk2(x[6], x[7])};
        } }
    LBAR();
    bf16x8 xw[2], xa[2], xg[5];
    { const int m0 = 16 * (w >> 1);
#pragma unroll
      for (int k = 0; k < 2; ++k) { xw[k] = *(const LAS bf16x8*)(L + L_XW + (m0 + fr) * LD + fq * 16 + k * 64); xa[k] = *(const LAS bf16x8*)(L + L_XA + (m0 + fr) * LD + fq * 16 + k * 64); }
#pragma unroll
      for (int k = 0; k < 5; ++k) xg[k] = *(const LAS bf16x8*)(L + L_XG + (m0 + fr) * 336 + fq * 16 + k * 64); }
    const int ch = lane, tb = 8 * w;
    bf16 raw[9][3];
    { const bool has = (c * CH + tb > 0);
#pragma unroll
      for (int tt = 0; tt < 9; ++tt) { const size_t off = (size_t)(row0 + tb + tt - 1) * PRW + (F.vcu & (RW_H - 1)) * 64 + ch;
          if (tt > 0 || has) { raw[tt][0] = P[off]; raw[tt][1] = P[off + 512]; raw[tt][2] = P[off + 1024]; } else { raw[tt][0] = 0; raw[tt][1] = 0; raw[tt][2] = 0; } } }
    const bf16* lora = (const bf16*)(F.ws + WS_LORA);
    LBAR();
    const unsigned lds0 = (unsigned)(uintptr_t)L;
    lora_dma(lora, F.vcu & (RW_H - 1), lds0, w, lane);
    TSUB(0);
    for (int hh = 0; hh < RW_H; ++hh) {
    const int h = (hh + F.vcu) & (RW_H - 1), hnext = (hh + 1 + F.vcu) & (RW_H - 1);
    const int item = (b * RW_H + h) * NCH + c;
    {
        asm volatile("s_waitcnt vmcnt(0)" ::: "memory"); LBAR();
        f32x4 aw[2], aa[2], ag[2];
#pragma unroll
        for (int q = 0; q < 2; ++q) { const int n0 = 16 * ((2 * w + q) & 3); aw[q] = Z4; aa[q] = Z4; ag[q] = Z4;
            const LAS unsigned char* wp = L + L_LWA + (n0 + fr) * 128 + fq * 16; const LAS unsigned char* gp = L + L_LG + (n0 + fr) * 64 + fq * 16;
#pragma unroll
            for (int k = 0; k < 2; ++k) { aw[q] = __builtin_amdgcn_mfma_f32_16x16x32_bf16(xw[k], *(const LAS bf16x8*)(wp + k * 64), aw[q], 0, 0, 0); aa[q] = __builtin_amdgcn_mfma_f32_16x16x32_bf16(xa[k], *(const LAS bf16x8*)(wp + 8192 + k * 64), aa[q], 0, 0, 0); }
#pragma unroll
            for (int k = 0; k < 5; ++k) ag[q] = __builtin_amdgcn_mfma_f32_16x16x32_bf16(xg[k], *(const LAS bf16x8*)(gp + k * 4096), ag[q], 0, 0, 0);
        }
        LBAR();
#pragma unroll
        for (int q = 0; q < 2; ++q) { const int tw = 2 * w + q, m0 = 16 * (tw >> 2), n0 = 16 * (tw & 3);
#pragma unroll
            for (int v = 0; v < 4; ++v) { const int t = m0 + 4 * fq + v, cc = n0 + fr;
                *(LAS float*)(L + L_WL + (t * 65 + cc) * 4) = aw[q][v]; *(LAS float*)(L + L_AL + (t * 65 + cc) * 4) = aa[q][v]; *(LAS float*)(L + L_GL + (t * 65 + cc) * 4) = ag[q][v]; } }
        LBAR();
    }
    TSUB(1);
    {
        const int gc = h * 64 + ch;
        const float mur = mu[gc], muk = mu[512 + gc], muv = mu[1024 + gc];
        const float w0 = (PRM + 2048)[gc], a0 = (PRM + 2560)[gc], k_k = (PRM + 3072)[gc], k_a = (PRM + 3584)[gc], r_k = (PRM + 4096)[gc];
        float rr[8], kp[8], vv[8], aa[8], bb[8], ld[8], vbv[8], ggv[8];
        float pr = bf2f(raw[0][0]), pk = bf2f(raw[0][1]), pv = bf2f(raw[0][2]);
        bf16* VBp = (bf16*)(F.ws + WS_VB) + (size_t)item * 4096; bf16* Gp = (bf16*)(F.ws + WS_G) + (size_t)item * 4096;
        float run = 0.f; float kkv[8], icv[8], sq[8], bq[8];
#pragma unroll
        for (int tt = 0; tt < 8; ++tt) { const int t = tb + tt;
            const float cr = bf2f(raw[tt + 1][0]), ck = bf2f(raw[tt + 1][1]), cv = bf2f(raw[tt + 1][2]);
            const float r = cr + (pr - cr) * mur, k = ck + (pk - ck) * muk, v = cv + (pv - cv) * muv; pr = cr; pk = ck; pv = cv;
            const float wl = *(const LAS float*)(L + L_WL + (t * 65 + ch) * 4), al = *(const LAS float*)(L + L_AL + (t * 65 + ch) * 4), gl = *(const LAS float*)(L + L_GL + (t * 65 + ch) * 4);
            const float z = -(w0 + wl); const float sp = fmaxf(z, 0.f) + __logf(1.f + __expf(-fabsf(z)));
            const float lgd = -__expf(-sp - 0.5f);
            const float ic = sigmoidf_(a0 + al);
            const float kv = k * k_k; const float kq = k * (1.f + (ic - 1.f) * k_a);
            kkv[tt] = kv; icv[tt] = ic; sq[tt] = kv * kv; bq[tt] = r * kq * r_k;
            rr[tt] = r; kp[tt] = kq; vv[tt] = v; run += lgd; ld[tt] = run; ggv[tt] = gl;
        }
        wave_sum8(sq); wave_sum8(bq);
#pragma unroll
        for (int tt = 0; tt < 8; ++tt) { const float kn = kkv[tt] * __builtin_amdgcn_rsqf(fmaxf(sq[tt], 1e-24f));
            aa[tt] = -kn; bb[tt] = kn * icv[tt]; vbv[tt] = bq[tt] * vv[tt]; }
        *(LAS float*)(L + L_GT + (w * 64 + ch) * 4) = run;
        *(GAS v4u*)(VBp + ch * 64 + tb) = (v4u){pk2(vbv[0], vbv[1]), pk2(vbv[2], vbv[3]), pk2(vbv[4], vbv[5]), pk2(vbv[6], vbv[7])};
        *(GAS v4u*)(Gp + ch * 64 + tb) = (v4u){pk2(ggv[0], ggv[1]), pk2(ggv[2], ggv[3]), pk2(ggv[4], ggv[5]), pk2(ggv[6], ggv[7])};
        if (hh + 1 < RW_H) {
            const bool has = (c * CH + tb > 0);
#pragma unroll
            for (int tt = 0; tt < 9; ++tt) { const size_t off = (size_t)(row0 + tb + tt - 1) * PRW + hnext * 64 + ch;
                if (tt > 0 || has) { raw[tt][0] = P[off]; raw[tt][1] = P[off + 512]; raw[tt][2] = P[off + 1024]; } }
        }
        LBAR();
        float offs = 0.f, tot = 0.f;
#pragma unroll
        for (int g = 0; g < 8; ++g) { const float x = *(const LAS float*)(L + L_GT + (g * 64 + ch) * 4); if (g < w) offs += x; tot += x; }
        const float etot = __expf(tot);
        if (w == 0) *(LAS float*)(L + L_WC + ch * 4) = etot;
        unsigned patt[4], pvt[4], pbh[4], pkh[4]; float hAt = 0.f, hBh = 0.f, hKh = 0.f;
        float e_ex = __expf(offs);
#pragma unroll
        for (int tt = 0; tt < 8; ++tt) { const int t = tb + tt; const float cl = offs + ld[tt];
            const float e_in = __expf(cl), e_inv = __builtin_amdgcn_rcpf(e_in), e_hat = etot * e_inv;
            const float At = aa[tt] * e_ex, Bt = bb[tt] * e_inv, Kt = kp[tt] * e_inv, Rt = rr[tt] * e_in, Bh = bb[tt] * e_hat, Kh = kp[tt] * e_hat; e_ex = e_in;
            *(LAS bf16*)(L + L_AT + t * LD + ch * 2) = (bf16)f2bf(At); *(LAS bf16*)(L + L_BT + t * LD + ch * 2) = (bf16)f2bf(Bt);
            *(LAS bf16*)(L + L_KT + t * LD + ch * 2) = (bf16)f2bf(Kt); *(LAS bf16*)(L + L_RT + t * LD + ch * 2) = (bf16)f2bf(Rt);
            if (tt & 1) { patt[tt >> 1] = pk2(hAt, At); pvt[tt >> 1] = pk2(vv[tt - 1], vv[tt]); pbh[tt >> 1] = pk2(hBh, Bh); pkh[tt >> 1] = pk2(hKh, Kh); }
            hAt = At; hBh = Bh; hKh = Kh;
        }
        *(LAS v4u*)(L + L_ATT + ch * LD + tb * 2) = (v4u){patt[0], patt[1], patt[2], patt[3]};
        *(LAS v4u*)(L + L_VT + ch * LD + tb * 2) = (v4u){pvt[0], pvt[1], pvt[2], pvt[3]};
        *(LAS v4u*)(L + L_BH + ch * LD + tb * 2) = (v4u){pbh[0], pbh[1], pbh[2], pbh[3]};
        *(LAS v4u*)(L + L_KH + ch * LD + tb * 2) = (v4u){pkh[0], pkh[1], pkh[2], pkh[3]};
        LBAR();
    }
    TSUB(2);
#pragma unroll
    for (int q = 0; q < 2; ++q) { const int tw = 2 * w + q, p0 = 16 * (tw >> 2), q0 = 16 * (tw & 3);
        f32x4 m = mm_tile(L + L_AT, LD, q0, L + L_BT, LD, p0, 2, Z4, fr, fq);
        f32x4 nak = mm_tile(L + L_KT, LD, q0, L + L_AT, LD, p0, 2, Z4, fr, fq);
        f32x4 nrk = mm_tile(L + L_KT, LD, q0, L + L_RT, LD, p0, 2, Z4, fr, fq);
        f32x4 nrb = mm_tile(L + L_BT, LD, q0, L + L_RT, LD, p0, 2, Z4, fr, fq);
        f32x4 tt;
        const int p = p0 + fr;
#pragma unroll
        for (int v = 0; v < 4; ++v) { const int qq = q0 + 4 * fq + v;
            if (!(p < qq)) m[v] = 0.f;
            if (!(qq < p)) nak[v] = 0.f;
            if (!(qq <= p)) { nrk[v] = 0.f; nrb[v] = 0.f; }
            tt[v] = (p == qq) ? 1.f : 0.f; }
        const int o = p * LD + (q0 + 4 * fq) * 2;
        st4_lds(L + L_M + o, m); st4t_lds(L + L_MT, p, q0 + 4 * fq, m); st4_lds(L + L_NAK + o, nak); st4_lds(L + L_NRK + o, nrk); st4_lds(L + L_NRB + o, nrb); st4_lds(L + L_TT + o, tt);
    }
    LBAR();
    TSUB(3);
    for (int it = 0; it < 6; ++it) {
        const int rM = (it & 1) ? L_AT : L_M, rMT = (it & 1) ? L_BT : L_MT, rTT = (it & 1) ? L_KT : L_TT;
        const int wM = (it & 1) ? L_M : L_AT, wMT = (it & 1) ? L_MT : L_BT, wTT = (it & 1) ? L_TT : L_KT;
#pragma unroll
        for (int q = 0; q < 2; ++q) { const int tw = 2 * w + q, p0 = 16 * (tw >> 2), q0 = 16 * (tw & 3); const int o = (p0 + fr) * LD + (q0 + 4 * fq) * 2;
            f32x4 tn = Z4, mn = Z4;
            if (q0 <= p0) { tn = mm_tile(L + rM, LD, q0, L + rTT, LD, p0, 2, ld4_lds(L + rTT + o), fr, fq);
                          }
            if (q0 >= p0 && it < 5) mn = mm_tile(L + rMT, LD, q0, L + rM, LD, p0, 2, Z4, fr, fq);
            st4_lds(L + wTT + o, tn); if (it < 5) { st4_lds(L + wM + o, mn); st4t_lds(L + wMT, p0 + fr, q0 + 4 * fq, mn); } }
        LBAR();
    }
    if (hh + 1 < RW_H) lora_dma(lora, hnext, lds0, w, lane);
    TSUB(4);
#pragma unroll
    for (int q = 0; q < 2; ++q) { const int tw = 2 * w + q, p0 = 16 * (tw >> 2), q0 = 16 * (tw & 3); const int o = (p0 + fr) * LD + (q0 + 4 * fq) * 2;
        const f32x4 ap = mm_tile(L + L_TT, LD, q0, L + L_ATT, LD, p0, 2, Z4, fr, fq);
        const f32x4 w1 = mm_tile(L + L_NAK, LD, q0, L + L_VT, LD, p0, 2, Z4, fr, fq);
        st4_lds(L + L_APT + o, ap); st4_lds(L + L_W1T + o, w1); }
    LBAR();
    {
        bf16* RPp = (bf16*)(F.ws + WS_RP) + (size_t)item * 4096; bf16* PTp = (bf16*)(F.ws + WS_PT) + (size_t)item * 4096;
#pragma unroll
        for (int q = 0; q < 2; ++q) { const int tw = 2 * w + q, p0 = 16 * (tw >> 2), q0 = 16 * (tw & 3); const int p = p0 + fr; const int o = p * LD + (q0 + 4 * fq) * 2;
            const f32x4 u0 = mm_tile(L + L_TT, LD, q0, L + L_W1T, LD, p0, 2, Z4, fr, fq);
            const f32x4 rp = mm_tile(L + L_APT, LD, q0, L + L_NRB, LD, p0, 2, ld4_lds(L + L_RT + o), fr, fq);
            f32x4 pt = mm_tile(L + L_APT, LD, q0, L + L_BH, LD, p0, 2, Z4, fr, fq);
            const float wc = *(const LAS float*)(L + L_WC + p * 4);
#pragma unroll
            for (int v = 0; v < 4; ++v) if (p == q0 + 4 * fq + v) pt[v] += wc;
            st4_lds(L + L_U0T + o, u0);
            st4_g(RPp + p * 64 + q0 + 4 * fq, rp); st4_g(PTp + p * 64 + q0 + 4 * fq, pt); }
    }
    LBAR();
    {
        bf16* Y0p = (bf16*)(F.ws + WS_Y0) + (size_t)item * 4096; bf16* QCp = (bf16*)(F.ws + WS_QC) + (size_t)item * 4096;
#pragma unroll
        for (int q = 0; q < 2; ++q) { const int tw = 2 * w + q, p0 = 16 * (tw >> 2), q0 = 16 * (tw & 3); const int p = p0 + fr;
            f32x4 y0 = mm_tile(L + L_VT, LD, q0, L + L_NRK, LD, p0, 2, Z4, fr, fq);
            y0 = mm_tile(L + L_U0T, LD, q0, L + L_NRB, LD, p0, 2, y0, fr, fq);
            f32x4 qc = mm_tile(L + L_KH, LD, q0, L + L_VT, LD, p0, 2, Z4, fr, fq);
            qc = mm_tile(L + L_BH, LD, q0, L + L_U0T, LD, p0, 2, qc, fr, fq);
            st4_g(Y0p + p * 64 + q0 + 4 * fq, y0); st4_g(QCp + p * 64 + q0 + 4 * fq, qc); }
    }
    LBAR();
    TSUB(5);
    }
#undef TSUB
}
struct ScanOps { bf16x8 pf[2][2]; v2u qi[2]; };
__device__ __forceinline__ void scan_load(const bf16* PT, const bf16* QC, int c, ScanOps& o, int w, int fr, int fq) {
#pragma unroll
    for (int q = 0; q < 2; ++q) { const int tw = 2 * w + q, p0 = 16 * (tw >> 2), q0 = 16 * (tw & 3);
        o.pf[q][0] = *(const GAS bf16x8*)(PT + (size_t)c * 4096 + (q0 + fr) * 64 + fq * 8); o.pf[q][1] = *(const GAS bf16x8*)(PT + (size_t)c * 4096 + (q0 + fr) * 64 + 32 + fq * 8);
        o.qi[q] = *(const GAS v2u*)(QC + (size_t)c * 4096 + (p0 + fr) * 64 + q0 + 4 * fq); }
}
__device__ __forceinline__ void scan_step(LAS unsigned char* L, bf16* S, int c, const ScanOps& o, f32x4 (&acc)[2], int w, int fr, int fq) {
#pragma unroll
    for (int q = 0; q < 2; ++q) { const int tw = 2 * w + q, p0 = 16 * (tw >> 2), q0 = 16 * (tw & 3);
        st4_g(S + (size_t)c * 4096 + (p0 + fr) * 64 + q0 + 4 * fq, acc[q]);
        st4_lds(L + (c & 1) * ARR + (p0 + fr) * LD + (q0 + 4 * fq) * 2, acc[q]); }
    LBAR();
#pragma unroll
    for (int q = 0; q < 2; ++q) { const int tw = 2 * w + q, p0 = 16 * (tw >> 2);
        const LAS unsigned char* sp = L + (c & 1) * ARR + (p0 + fr) * LD + fq * 16;
        const bf16x8 s0 = *(const LAS bf16x8*)sp, s1 = *(const LAS bf16x8*)(sp + 64);
        f32x4 a = (f32x4){bflo(o.qi[q].x), bfhi(o.qi[q].x), bflo(o.qi[q].y), bfhi(o.qi[q].y)};
        a = __builtin_amdgcn_mfma_f32_16x16x32_bf16(o.pf[q][0], s0, a, 0, 0, 0);
        a = __builtin_amdgcn_mfma_f32_16x16x32_bf16(o.pf[q][1], s1, a, 0, 0, 0);
        acc[q] = a; }
}
__device__ __forceinline__ void rwkv_state_scan(Frame& F, int bh) {
    LAS unsigned char* L = F.lds;
    const int lane = F.lane, w = F.wave, fr = lane & 15, fq = lane >> 4;
    const bf16* PT = (const bf16*)(F.ws + WS_PT) + (size_t)bh * NCH * 4096; const bf16* QC = (const bf16*)(F.ws + WS_QC) + (size_t)bh * NCH * 4096;
    bf16* S = (bf16*)(F.ws + WS_S) + (size_t)bh * NCH * 4096;
    f32x4 acc[2]; acc[0] = (f32x4){0.f, 0.f, 0.f, 0.f}; acc[1] = acc[0];
    ScanOps o0, o1, o2, o3;
    scan_load(PT, QC, 0, o0, w, fr, fq); scan_load(PT, QC, 1, o1, w, fr, fq); scan_load(PT, QC, 2, o2, w, fr, fq); scan_load(PT, QC, 3, o3, w, fr, fq);
#pragma unroll 1
    for (int c = 0; c < NCH; c += 4) {
        const int n0 = (c + 4 < NCH) ? c + 4 : c, n1 = (c + 5 < NCH) ? c + 5 : c, n2 = (c + 6 < NCH) ? c + 6 : c, n3 = (c + 7 < NCH) ? c + 7 : c;
        scan_step(L, S, c, o0, acc, w, fr, fq);     scan_load(PT, QC, n0, o0, w, fr, fq);
        scan_step(L, S, c + 1, o1, acc, w, fr, fq); scan_load(PT, QC, n1, o1, w, fr, fq);
        scan_step(L, S, c + 2, o2, acc, w, fr, fq); scan_load(PT, QC, n2, o2, w, fr, fq);
        scan_step(L, S, c + 3, o3, acc, w, fr, fq); scan_load(PT, QC, n3, o3, w, fr, fq);
    }
    LBAR();
}
struct ChunkOutOps { v2u y0[2]; bf16x8 sf[2][2], rf[2][2]; };
__device__ __forceinline__ void chunk_out_load(Frame& F, int item, ChunkOutOps& o, int w, int fr, int fq) {
    const bf16* S = (const bf16*)(F.ws + WS_S) + (size_t)item * 4096; const bf16* RP = (const bf16*)(F.ws + WS_RP) + (size_t)item * 4096; const bf16* Y0 = (const bf16*)(F.ws + WS_Y0) + (size_t)item * 4096;
#pragma unroll
    for (int q = 0; q < 2; ++q) { const int tw = 2 * w + q, p0 = 16 * (tw >> 2), q0 = 16 * (tw & 3);
        o.y0[q] = *(const GAS v2u*)(Y0 + (p0 + fr) * 64 + q0 + 4 * fq);
#pragma unroll
        for (int k = 0; k < 2; ++k) { o.sf[q][k] = *(const GAS bf16x8*)(S + (q0 + fr) * 64 + k * 32 + fq * 8); o.rf[q][k] = *(const GAS bf16x8*)(RP + (p0 + fr) * 64 + k * 32 + fq * 8); } }
}
__device__ __forceinline__ void rwkv_chunk_out_all(Frame& F) {
    const float* PRM = (const float*)(F.ws + WS_PRM);
    LAS unsigned char* L = F.lds;
    const int lane = F.lane, w = F.wave, fr = lane & 15, fq = lane >> 4;
    ChunkOutOps cur, nxt;
    int item = F.vcu;
    if (item < NITEM) chunk_out_load(F, item, cur, w, fr, fq);
    for (; item < NITEM; item += F.G) {
        const int bh = item / NCH, c = item % NCH, b = bh / RW_H, h = bh % RW_H; const int row0 = b * T + c * CH;
        const int ch = lane, gc = h * 64 + ch;
        const bf16* VB = (const bf16*)(F.ws + WS_VB) + (size_t)item * 4096; const bf16* G = (const bf16*)(F.ws + WS_G) + (size_t)item * 4096;
        const v4u vbq = *(const GAS v4u*)(VB + ch * 64 + 8 * w), ggq = *(const GAS v4u*)(G + ch * 64 + 8 * w);
        const int inext = item + F.G;
        if (inext < NITEM) chunk_out_load(F, inext, nxt, w, fr, fq);
#pragma unroll
        for (int q = 0; q < 2; ++q) { const int tw = 2 * w + q, p0 = 16 * (tw >> 2), q0 = 16 * (tw & 3);
            f32x4 a = (f32x4){bflo(cur.y0[q].x), bfhi(cur.y0[q].x), bflo(cur.y0[q].y), bfhi(cur.y0[q].y)};
#pragma unroll
            for (int k = 0; k < 2; ++k) a = __builtin_amdgcn_mfma_f32_16x16x32_bf16(cur.sf[q][k], cur.rf[q][k], a, 0, 0, 0);
#pragma unroll
            for (int v = 0; v < 4; ++v) *(LAS float*)(L + L_YL + ((p0 + fr) * 65 + q0 + 4 * fq + v) * 4) = a[v];
        }
        LBAR();
        {
            const float gw = (PRM + 4608)[gc], gb = (PRM + 5120)[gc];
            bf16* YM = (bf16*)(F.ws + WS_YMIX);
            float yv[8], sm[8], sv[8];
#pragma unroll
            for (int tt = 0; tt < 8; ++tt) { yv[tt] = *(const LAS float*)(L + L_YL + ((8 * w + tt) * 65 + ch) * 4); sm[tt] = yv[tt]; }
            wave_sum8(sm);
#pragma unroll
            for (int tt = 0; tt < 8; ++tt) { yv[tt] -= sm[tt] * (1.f / 64.f); sv[tt] = yv[tt] * yv[tt]; }
            wave_sum8(sv);
#pragma unroll
            for (int tt = 0; tt < 8; ++tt) { const int t = 8 * w + tt;
                const float yn = yv[tt] * __builtin_amdgcn_rsqf(sv[tt] * (1.f / 64.f) + GN_EPS) * gw + gb;
                const float o = (yn + ((tt & 1) ? bfhi(vbq[tt >> 1]) : bflo(vbq[tt >> 1]))) * ((tt & 1) ? bfhi(ggq[tt >> 1]) : bflo(ggq[tt >> 1]));
                YM[(size_t)(row0 + t) * D + gc] = (bf16)f2bf(o); }
        }
        LBAR();
        cur = nxt;
    }
}
__device__ __forceinline__ void diff_post_rows(Frame& F) {
    const float* PRM = (const float*)(F.ws + WS_PRM);
    const int lane = F.lane; const int gw = F.vcu * NWAVES + F.wave, NGW = F.G * NWAVES;
    const float l1 = wave_sum((PRM + 5632)[lane] * (PRM + 5696)[lane]), l2 = wave_sum((PRM + 5760)[lane] * (PRM + 5824)[lane]);
    const float lam = __expf(l1) - __expf(l2) + LAMBDA_INIT;
    const int e0 = 2 * lane, vh = e0 >> 6, d = e0 & 63;
    const float sw0 = (PRM + 5888)[e0] * (1.f - LAMBDA_INIT), sw1 = (PRM + 5888)[e0 + 1] * (1.f - LAMBDA_INIT);
    const bf16* O = (const bf16*)(F.ws + WS_O); bf16* YM = (bf16*)(F.ws + WS_YMIX);
    unsigned c1[2][4], c2[2][4], n1[2][4], n2[2][4];
    int m = gw;
#pragma unroll
    for (int r = 0; r < 2; ++r)
#pragma unroll
        for (int hd = 0; hd < 4; ++hd) { const int mr = m + r * NGW; c1[r][hd] = 0u; c2[r][hd] = 0u;
            if (mr < M) { c1[r][hd] = *(const GAS unsigned*)(O + (size_t)mr * 1024 + (hd * 4 + vh) * 64 + d); c2[r][hd] = *(const GAS unsigned*)(O + (size_t)mr * 1024 + (hd * 4 + 2 + vh) * 64 + d); } }
    for (; m < M; m += 2 * NGW) {
#pragma unroll
        for (int r = 0; r < 2; ++r)
#pragma unroll
            for (int hd = 0; hd < 4; ++hd) { const int mr = m + (2 + r) * NGW; n1[r][hd] = 0u; n2[r][hd] = 0u;
                if (mr < M) { n1[r][hd] = *(const GAS unsigned*)(O + (size_t)mr * 1024 + (hd * 4 + vh) * 64 + d); n2[r][hd] = *(const GAS unsigned*)(O + (size_t)mr * 1024 + (hd * 4 + 2 + vh) * 64 + d); } }
        float o0[8], o1[8], ss[8];
#pragma unroll
        for (int r = 0; r < 2; ++r)
#pragma unroll
            for (int hd = 0; hd < 4; ++hd) { const unsigned w1 = c1[r][hd], w2 = c2[r][hd]; const int k = r * 4 + hd;
                o0[k] = bflo(w1) - lam * bflo(w2); o1[k] = bfhi(w1) - lam * bfhi(w2); ss[k] = o0[k] * o0[k] + o1[k] * o1[k]; }
        wave_sum8(ss);
#pragma unroll
        for (int r = 0; r < 2; ++r) { const int mr = m + r * NGW;
            if (mr < M) {
#pragma unroll
                for (int hd = 0; hd < 4; ++hd) { const int k = r * 4 + hd; const float rs = __builtin_amdgcn_rsqf(ss[k] * (1.f / 128.f) + SUBLN_EPS);
                    *(GAS unsigned*)(YM + (size_t)mr * D + 512 + hd * 128 + e0) = pk2(o0[k] * rs * sw0, o1[k] * rs * sw1); } } }
#pragma unroll
        for (int r = 0; r < 2; ++r)
#pragma unroll
            for (int hd = 0; hd < 4; ++hd) { c1[r][hd] = n1[r][hd]; c2[r][hd] = n2[r][hd]; }
    }
}
__global__ void __launch_bounds__(NWAVES * 64, 2) hybrid_fwd(const Args A) {
    extern __shared__ __attribute__((aligned(16))) unsigned char lds[];
    Frame F;
    F.lds = (LAS unsigned char*)lds;
    F.wave = __builtin_amdgcn_readfirstlane((int)threadIdx.x >> 6); F.lane = lane_id_asm(); F.tid = F.wave * 64 + F.lane;
    F.G = gridDim.x; { const int bx = blockIdx.x; F.vcu = (F.G % 8 == 0) ? (bx % 8) * (F.G / 8) + bx / 8 : bx; }
    F.ws = A.ws; F.ctl = (unsigned*)(A.ws + WS_CTL); F.out = A.out;
    const int lo = A.ph_lo, hi = A.ph_hi;
    cg::grid_group grid = cg::this_grid();
    volatile LAS unsigned* MISC = (volatile LAS unsigned*)(F.lds + L_MISC);
    if (F.tid < 16) MISC[F.tid] = 0u;
    __syncthreads();
    XcdBarrier bar; bar.bar = F.ctl + CW_BAR; bar.x = 0; bar.st = nullptr;
    if (hi - lo > 1) {
        if (blockIdx.x == 0) { GAS v4u* z = (GAS v4u*)(F.ws + WS_CTL); for (int i = F.tid; i < (int)(CTL_ZERO_BYTES / 16); i += NWAVES * 64) if (i < (int)(WS_PRM / 16) || i >= (int)((CW_SEAM * 4) / 16)) z[i] = (v4u){0u, 0u, 0u, 0u}; }
        grid.sync();
        bar = xcd_barrier_post(F.ctl + CW_BAR, MISC + 8, F.wave);
    }
    const float* PRM = (const float*)(F.ws + WS_PRM);
#define IN(k) (lo <= (k) && (k) < hi)
    unsigned long long pt0 = 0;
#define PSTART(k) do { if ((k) == PROBE_PHASE) pt0 = __builtin_amdgcn_s_memrealtime(); } while (0)
#define PEND(k) do { if ((k) == PROBE_PHASE) { const unsigned long long pt1 = __builtin_amdgcn_s_memrealtime(); while (__builtin_amdgcn_s_memrealtime() - pt1 < pt1 - pt0) __builtin_amdgcn_s_sleep(8); xcd_barrier(bar, F.wave); } } while (0)
#define SEAM(k) do { if (hi - lo > 1) { xcd_barrier(bar, F.wave); F.lane = lane_id_asm(); F.tid = F.wave * 64 + F.lane; } } while (0)
    bf16* XN = (bf16*)(F.ws + WS_XN); bf16* ACT = (bf16*)(F.ws + WS_ACT); float* Y = (float*)(F.ws + WS_Y); float* YMo = (float*)(F.ws + WS_YM);

    PSTART(0); if (IN(0)) { for (int rep = 0; rep < REP0; ++rep) p0_prologue(F, A); } SEAM(0); PEND(0);
    PSTART(1); if (IN(1)) for (int rep = 0; rep < REP1; ++rep) { pg8::Gemm g{XN, (const bf16*)(F.ws + WS_WGU1), M, NGU, D}; pg8::StaticOrder S; S.init(M, NGU, F.G, (int)blockIdx.x);
        pg8::EpiSwiGLU E{ACT, FF}; pg8::gemm_phase<pg8::EpiSwiGLU, pg8::StaticOrder, true, true>(F.lds, g, S, E, F.wave);
        if (F.G == 256 && (int)blockIdx.x >= 128) p0_convert_range(F, A, P0_R0, P0_R1, ((int)blockIdx.x - 128) * NWAVES + F.wave, 128 * NWAVES);
        else if (F.G != 256) p0_convert_range(F, A, P0_R0, P0_R1, F.vcu * NWAVES + F.wave, F.G * NWAVES); } SEAM(1); PEND(1);
    PSTART(2); if (IN(2)) for (int rep = 0; rep < REP2; ++rep) { pg8::Gemm g{ACT, (const bf16*)(F.ws + WS_WD1), M, D, FF}; pg8::StaticOrder S; S.init(M, D, F.G, (int)blockIdx.x);
        pg8::PanelRms s1{(float*)(F.ws + WS_X), F.ctl + CW_SEAM, NORM_EPS}, s2{(float*)(F.ws + WS_X) + 65536, F.ctl + CW_SEAM + SEAM_BANK, NORM_EPS};
        pg8::EpiRmsResRms<false> E{A.in[0], (bf16*)F.out, XN, D, PRM + 6144, 0.5f, PRM + 7168, s1, s2};
        pg8::gemm_phase<pg8::EpiRmsResRms<false>, pg8::StaticOrder, false, true>(F.lds, g, S, E, F.wave); } SEAM(2); PEND(2);
    PSTART(4); if (IN(4)) for (int rep = 0; rep < REP4; ++rep) { pg8::Gemm g{XN, (const bf16*)(F.ws + WS_WIN), M, NPW, D}; pg8::StaticOrder S; S.init(M, NPW, F.G, (int)blockIdx.x);
        pg8::EpiP E{(bf16*)(F.ws + WS_PRW), PRW, (bf16*)(F.ws + WS_PDF), PDF}; pg8::gemm_phase<pg8::EpiP, pg8::StaticOrder, true, true>(F.lds, g, S, E, F.wave);
        if (F.G == 256 && (int)blockIdx.x >= 128) p0_convert_range(F, A, P0_R1, P0_R2, ((int)blockIdx.x - 128) * NWAVES + F.wave, 128 * NWAVES);
        else if (F.G != 256) p0_convert_range(F, A, P0_R1, P0_R2, F.vcu * NWAVES + F.wave, F.G * NWAVES); } SEAM(4); PEND(4); for (int rep = 0; rep < REPBAR; ++rep) xcd_barrier(bar, F.wave);
    PSTART(5); if (IN(5)) { for (int rep = 0; rep < REP5; ++rep) { unsigned long long tsub = 0; for (int bc = F.vcu; bc < BATCH * NCH; bc += F.G) rwkv_chunk_group(F, bc, tsub); if (PROBE_SUB >= 0) { const unsigned long long t1 = __builtin_amdgcn_s_memrealtime(); while (__builtin_amdgcn_s_memrealtime() - t1 < tsub) __builtin_amdgcn_s_sleep(8); } } } SEAM(5); PEND(5);
    PSTART(6); if (IN(6)) for (int rep = 0; rep < REP6; ++rep) {
        if ((F.vcu & 7) == 0) for (int rs = 0; rs < REPSCAN; ++rs) rwkv_state_scan(F, F.vcu >> 3);
        LAS unsigned* misc = (LAS unsigned*)(F.lds + L_MISC);
        const attn_body::bf16* Pd = (const attn_body::bf16*)(F.ws + WS_PDF);
        for (;;) {
            if (F.wave == 0 && lane_id_asm() == 0) misc[0] = atomicAdd(F.ctl + CW_QUEUE + 64 * rep, 1u);
            __syncthreads(); const unsigned idx = misc[0]; __syncthreads();
            if (idx >= 1024u) break;
            const int qb = 15 - (int)(idx >> 6), bhv = (int)(idx & 63u);
            attn_body::attn_unit<8>(bhv >> 4, bhv & 15, qb, Pd, Pd, Pd, (attn_body::bf16*)(F.ws + WS_O), (char*)lds, F.wave);
#if REPATT > 1
            attn_body::attn_unit<8>(bhv >> 4, bhv & 15, qb, Pd, Pd, Pd, (attn_body::bf16*)(F.ws + WS_O), (char*)lds, F.wave);
#endif
        }
    } SEAM(6); PEND(6);
    PSTART(7); if (IN(7)) { for (int rep = 0; rep < REP7; ++rep) { rwkv_chunk_out_all(F); diff_post_rows(F); } } SEAM(7); PEND(7);
    PSTART(8); if (IN(8)) { pg8::Gemm g{(const bf16*)(F.ws + WS_YMIX), (const bf16*)(F.ws + WS_WO), M, D, D}; pg8::StaticOrder S; S.init(M, D, F.G, (int)blockIdx.x);
        pg8::PanelRms s1{(float*)(F.ws + WS_X) + 2 * 65536, F.ctl + CW_SEAM + 2 * SEAM_BANK, NORM_EPS}, s2{(float*)(F.ws + WS_X) + 3 * 65536, F.ctl + CW_SEAM + 3 * SEAM_BANK, NORM_EPS};
        pg8::EpiRmsResRms<true> E{(const bf16*)F.out, (bf16*)(F.ws + WS_Y), XN, D, PRM + 8192, 1.0f, PRM + 9216, s1, s2};
        pg8::gemm_phase<pg8::EpiRmsResRms<true>, pg8::StaticOrder, false, true>(F.lds, g, S, E, F.wave); } SEAM(8); PEND(8);
    PSTART(10); if (IN(10)) { pg8::Gemm g{XN, (const bf16*)(F.ws + WS_WGU2), M, NGU, D}; pg8::StaticOrder S; S.init(M, NGU, F.G, (int)blockIdx.x);
        pg8::EpiSwiGLU E{ACT, FF}; pg8::gemm_phase<pg8::EpiSwiGLU, pg8::StaticOrder, true, true>(F.lds, g, S, E, F.wave);
        if (F.G == 256 && (int)blockIdx.x >= 128) p0_convert_range(F, A, P0_R2, P0_NITEMS, ((int)blockIdx.x - 128) * NWAVES + F.wave, 128 * NWAVES);
        else if (F.G != 256) p0_convert_range(F, A, P0_R2, P0_NITEMS, F.vcu * NWAVES + F.wave, F.G * NWAVES); } SEAM(10); PEND(10);
    if (IN(11)) { pg8::Gemm g{ACT, (const bf16*)(F.ws + WS_WD2), M, D, FF}; pg8::StaticOrder S; S.init(M, D, F.G, (int)blockIdx.x);
        pg8::PanelRms s1{(float*)(F.ws + WS_X) + 4 * 65536, F.ctl + CW_SEAM + 4 * SEAM_BANK, NORM_EPS};
        pg8::EpiRmsRes<true> E{(const bf16*)(F.ws + WS_Y), F.out, D, PRM + 10240, 0.5f, s1};
        pg8::gemm_phase<pg8::EpiRmsRes<true>, pg8::StaticOrder, false, true>(F.lds, g, S, E, F.wave); }
#undef IN
#undef SEAM
}

extern "C" void kernel_launch(void* const* d_in, const int* in_sizes, int n_in, void* d_out, int out_size, void* d_ws, size_t ws_size, hipStream_t stream) {
    static int grid = 0;
    if (grid == 0) {
        if (n_in != 31 || in_sizes[0] != M * D || out_size != M * D || ws_size < WS_END) { fprintf(stderr, "kernel_launch: unexpected shapes (n_in %d, in0 %d, out %d, ws %zu); nothing launched\n", n_in, n_in > 0 ? in_sizes[0] : -1, out_size, ws_size); grid = -1; return; }
        int dev = 0, cus = 0, per_cu = 0;
        if (hipGetDevice(&dev) != hipSuccess || hipDeviceGetAttribute(&cus, hipDeviceAttributeMultiprocessorCount, dev) != hipSuccess) { grid = -1; return; }
        if (hipFuncSetAttribute((const void*)hybrid_fwd, hipFuncAttributeMaxDynamicSharedMemorySize, LDS_BYTES) != hipSuccess) { fprintf(stderr, "kernel_launch: hipFuncSetAttribute failed\n"); grid = -1; return; }
        if (hipOccupancyMaxActiveBlocksPerMultiprocessor(&per_cu, (const void*)hybrid_fwd, NWAVES * 64, LDS_BYTES) != hipSuccess || per_cu < 1) { fprintf(stderr, "kernel_launch: occupancy query reports %d workgroups per CU\n", per_cu); per_cu = 1; }
        (void)hipGetLastError();
        grid = cus;
    }
    if (grid < 0) return;
#if MK_PER_PHASE
    (void)hipMemsetAsync((char*)d_ws + WS_CTL, 0, CTL_ZERO_BYTES, stream);
#endif
    Args a{};
    for (int i = 0; i < 31; ++i) a.in[i] = (const float*)d_in[i];
    a.out = (float*)d_out; a.ws = (unsigned char*)d_ws;
#if MK_PER_PHASE
    for (int p = 0; p < N_PHASES; ++p) { a.ph_lo = p; a.ph_hi = p + 1; hipLaunchKernelGGL(hybrid_fwd, dim3(grid), dim3(NWAVES * 64), LDS_BYTES, stream, a); }
#else
    a.ph_lo = 0; a.ph_hi = N_PHASES;
    void* kargs[] = {&a};
    const hipError_t e = hipLaunchCooperativeKernel((const void*)hybrid_fwd, dim3(grid), dim3(NWAVES * 64), kargs, LDS_BYTES, stream);
    if (e != hipSuccess) fprintf(stderr, "kernel_launch: cooperative launch failed: %s (grid %d)\n", hipGetErrorString(e), grid);
#endif
}
```

```cpp
#include <hip/hip_runtime.h>
#include <hip/hip_cooperative_groups.h>
#include <cstdio>
#include <cstdint>
namespace cg = cooperative_groups;
__device__ __forceinline__ int lane_id_asm() { int l; asm volatile("v_mbcnt_lo_u32_b32 %0, -1, 0\n\tv_mbcnt_hi_u32_b32 %0, -1, %0" : "=v"(l)); return l; }
namespace pg8 {
#define PG8_LAS __attribute__((address_space(3)))
typedef unsigned short bf16_t;
typedef short bf16x8 __attribute__((ext_vector_type(8)));
typedef float f32x4 __attribute__((ext_vector_type(4)));
typedef unsigned u32x4 __attribute__((ext_vector_type(4)));
constexpr int BM = 256, BK = 64, HALF = 128, HTB = HALF * BK * 2  , STAGE_BYTES = 8 * HTB, NXCD = 8, WGM = 8;

__host__ __device__ __forceinline__ int lds_byte(int r, int c) { const int st = (r >> 4) * 2 + (c >> 5), rr = r & 15, cc = c & 31, ob = rr * 64 + cc * 2; return st * 1024 + (ob ^ (((ob >> 9) & 1) << 5)); }
__host__ __device__ __forceinline__ void stage_rc(int b, int& R, int& C) { const int st = b / 1024, sb = b % 1024, swz = sb ^ (((sb >> 9) & 1) << 5); R = (st >> 1) * 16 + swz / 64; C = (st & 1) * 32 + (swz % 64) / 2; }
__host__ __device__ __forceinline__ int perm32(int rho) { const int n = rho >> 4, i = rho & 15; return 8 * (i >> 2) + 4 * n + (i & 3); }

struct Unit { int pm, pn; };
struct Gemm { const bf16_t* A; const bf16_t* Bt; int M, N, K; };

struct StaticOrder {
    int nM, nN, nwg, G, c;
    __host__ __device__ void init(int M, int N, int G_, int c_) { nM = M / BM; nN = N / BM; nwg = nM * nN; G = G_; c = c_; }
    __host__ __device__ bool next(int i, Unit& u) const {
        const long L = (long)i * G + c; if (L >= nwg) return false;
        int wgid = (int)L; { const int q = nwg / NXCD, r = nwg % NXCD, xcd = wgid % NXCD, off = wgid / NXCD; wgid = (xcd < r ? xcd * (q + 1) : r * (q + 1) + (xcd - r) * q) + off; }
        const int nig = WGM * nN, gid = wgid / nig, fm = gid * WGM, gsz = (nM - fm) < WGM ? (nM - fm) : WGM;
        u.pm = fm + ((wgid % nig) % gsz); u.pn = (wgid % nig) / gsz; return true;
    }
    __device__ __forceinline__ void a_ready(const Unit&) const {}
    __device__ __forceinline__ void done(const Unit&) const {}
};

__device__ __forceinline__ unsigned cvt_pk_bf16(float lo, float hi) { unsigned r; asm volatile("v_cvt_pk_bf16_f32 %0, %1, %2" : "=v"(r) : "v"(lo), "v"(hi)); return r; }
__device__ __forceinline__ float silu_mul(float g, float u) { return g * __builtin_amdgcn_rcpf(1.0f + __builtin_amdgcn_exp2f(-1.4426950408889634f * g)) * u; }
typedef float f32x2p __attribute__((ext_vector_type(2)));
__device__ __forceinline__ f32x2p silu_mul2(f32x2p g, f32x2p u) {
    const f32x2p t = g * (-1.4426950408889634f); f32x2p e; e.x = __builtin_amdgcn_exp2f(t.x); e.y = __builtin_amdgcn_exp2f(t.y);
    const f32x2p d = e + 1.0f; f32x2p r; r.x = __builtin_amdgcn_rcpf(d.x); r.y = __builtin_amdgcn_rcpf(d.y);
    return (g * u) * r;
}
struct EpiSwiGLU {
    static constexpr bool PERM = true, AFTER_DRAIN = false;
    bf16_t* O; int ldc;
    __device__ __forceinline__ void operator()(const f32x4 (&acc)[2][2][4][2], const Unit& u, int wr, int wc, int fr, int fq) const {
        const int row0 = u.pm * BM + wr * 64 + fr, col0 = u.pn * HALF + wc * 32 + 8 * fq;
#pragma unroll
        for (int ai = 0; ai < 2; ++ai)
#pragma unroll
            for (int m = 0; m < 4; ++m) { bf16_t* rowp = O + (size_t)(row0 + ai * HALF + m * 16) * ldc + col0;
                const f32x4 g0 = acc[ai][0][m][0], g1 = acc[ai][0][m][1], u0 = acc[ai][1][m][0], u1 = acc[ai][1][m][1];
                const f32x2p a = silu_mul2((f32x2p){g0[0], g0[1]}, (f32x2p){u0[0], u0[1]}), b = silu_mul2((f32x2p){g0[2], g0[3]}, (f32x2p){u0[2], u0[3]});
                const f32x2p c = silu_mul2((f32x2p){g1[0], g1[1]}, (f32x2p){u1[0], u1[1]}), d = silu_mul2((f32x2p){g1[2], g1[3]}, (f32x2p){u1[2], u1[3]});
                u32x4 w; w.x = cvt_pk_bf16(a.x, a.y); w.y = cvt_pk_bf16(b.x, b.y); w.z = cvt_pk_bf16(c.x, c.y); w.w = cvt_pk_bf16(d.x, d.y);
                *(u32x4*)rowp = w; }
    }
};
struct EpiF32 {
    static constexpr bool PERM = false, AFTER_DRAIN = false;
    float* O; int ldc;
    __device__ __forceinline__ void operator()(const f32x4 (&acc)[2][2][4][2], const Unit& u, int wr, int wc, int fr, int fq) const {
        const int row0 = u.pm * BM + wr * 64 + fr, col0 = u.pn * BM + wc * 32 + 4 * fq;
#pragma unroll
        for (int ai = 0; ai < 2; ++ai)
#pragma unroll
            for (int m = 0; m < 4; ++m) { float* rowp = O + (size_t)(row0 + ai * HALF + m * 16) * ldc + col0;
#pragma unroll
                for (int bj = 0; bj < 2; ++bj)
#pragma unroll
                    for (int n = 0; n < 2; ++n) *(f32x4*)(rowp + bj * HALF + n * 16) = acc[ai][bj][m][n]; }
    }
};
struct EpiP {
    static constexpr bool PERM = true, AFTER_DRAIN = false;
    bf16_t* O0; int ld0; bf16_t* O1; int ld1;
    __device__ __forceinline__ void operator()(const f32x4 (&acc)[2][2][4][2], const Unit& u, int wr, int wc, int fr, int fq) const {
        const int row0 = u.pm * BM + wr * 64 + fr; const bool first = u.pn < 8;
        bf16_t* base = first ? O0 : O1; const int ldc = first ? ld0 : ld1; const int col0 = (first ? u.pn : u.pn - 8) * BM + wc * 32 + 8 * fq;
#pragma unroll
        for (int ai = 0; ai < 2; ++ai)
#pragma unroll
            for (int m = 0; m < 4; ++m) { bf16_t* rowp = base + (size_t)(row0 + ai * HALF + m * 16) * ldc + col0;
#pragma unroll
                for (int bj = 0; bj < 2; ++bj) { const f32x4 v0 = acc[ai][bj][m][0], v1 = acc[ai][bj][m][1];
                    u32x4 w; w.x = cvt_pk_bf16(v0[0], v0[1]); w.y = cvt_pk_bf16(v0[2], v0[3]); w.z = cvt_pk_bf16(v1[0], v1[1]); w.w = cvt_pk_bf16(v1[2], v1[3]);
                    *(u32x4*)(rowp + bj * HALF) = w; } }
    }
};

struct PanelRms {
    float* xbuf;
    unsigned* cnt;
    float eps;
    __device__ __forceinline__ void run(const f32x4 (&v)[2][2][4][2], const Unit& u, int wr, int wc, int fr, int fq, PG8_LAS unsigned char* lds, int wid, int lane) const {
        PG8_LAS float* P = (PG8_LAS float*)lds;
        PG8_LAS float* S = (PG8_LAS float*)(lds + 8192);
#pragma unroll
        for (int ai = 0; ai < 2; ++ai)
#pragma unroll
            for (int m = 0; m < 4; ++m) {
                float s = 0.f;
#pragma unroll
                for (int bj = 0; bj < 2; ++bj)
#pragma unroll
                    for (int n = 0; n < 2; ++n) { const f32x4 x = v[ai][bj][m][n]; s += (x[0] * x[0] + x[1] * x[1]) + (x[2] * x[2] + x[3] * x[3]); }
                s += __shfl_xor(s, 16); s += __shfl_xor(s, 32);
                if (fq == 0) P[(ai * HALF + wr * 64 + m * 16 + fr) * 4 + wc] = s;
            }
        asm volatile("s_waitcnt lgkmcnt(0)" ::: "memory"); __builtin_amdgcn_s_barrier(); asm volatile("" ::: "memory");
        const int row = wid * 32 + (lane & 31);
        if (lane < 32) {
            const float t = (P[row * 4 + 0] + P[row * 4 + 1]) + (P[row * 4 + 2] + P[row * 4 + 3]);
            __hip_atomic_store(xbuf + ((size_t)(u.pm * BM + row) * 4 + u.pn), t, __ATOMIC_RELAXED, __HIP_MEMORY_SCOPE_AGENT);
        }
        asm volatile("s_waitcnt vmcnt(0)" ::: "memory");
        if (lane == 0) __hip_atomic_fetch_add(cnt + 64 * u.pm, 1u, __ATOMIC_RELAXED, __HIP_MEMORY_SCOPE_AGENT);
        if (wid == 0) {
            unsigned spins = 0;
            for (;;) {
                if ((unsigned)__builtin_amdgcn_readfirstlane(__hip_atomic_load(cnt + 64 * u.pm, __ATOMIC_RELAXED, __HIP_MEMORY_SCOPE_AGENT)) >= 32u) break;
                if (++spins > (1u << 22)) break;
                __builtin_amdgcn_s_sleep(2);
            }
            __builtin_amdgcn_fence(__ATOMIC_ACQUIRE, "agent");
        }
        asm volatile("s_waitcnt vmcnt(0) lgkmcnt(0)" ::: "memory"); __builtin_amdgcn_s_barrier(); asm volatile("" ::: "memory");
        if (lane < 32) {
            const float* slot = xbuf + (size_t)(u.pm * BM + row) * 4; float q = 0.f;
#pragma unroll
            for (int t = 0; t < 4; ++t) q += __hip_atomic_load(slot + t, __ATOMIC_RELAXED, __HIP_MEMORY_SCOPE_AGENT);
            S[row] = __builtin_amdgcn_rsqf(q * (1.0f / 1024.0f) + eps);
        }
        asm volatile("s_waitcnt lgkmcnt(0)" ::: "memory"); __builtin_amdgcn_s_barrier(); asm volatile("" ::: "memory");
    }
};
template <bool BF> __device__ __forceinline__ void ld_res8(const void* base, size_t off, f32x4& a, f32x4& b) {
    if constexpr (BF) { const u32x4 w = __builtin_nontemporal_load((const u32x4*)((const bf16_t*)base + off));
        a = (f32x4){__builtin_bit_cast(float, w.x << 16), __builtin_bit_cast(float, w.x & 0xffff0000u), __builtin_bit_cast(float, w.y << 16), __builtin_bit_cast(float, w.y & 0xffff0000u)};
        b = (f32x4){__builtin_bit_cast(float, w.z << 16), __builtin_bit_cast(float, w.z & 0xffff0000u), __builtin_bit_cast(float, w.w << 16), __builtin_bit_cast(float, w.w & 0xffff0000u)}; }
    else { a = __builtin_nontemporal_load((const f32x4*)((const float*)base + off)); b = __builtin_nontemporal_load((const f32x4*)((const float*)base + off + 4)); }
}
__device__ __forceinline__ u32x4 pack_bf8(f32x4 a, f32x4 b) { u32x4 w; w.x = cvt_pk_bf16(a[0], a[1]); w.y = cvt_pk_bf16(a[2], a[3]); w.z = cvt_pk_bf16(b[0], b[1]); w.w = cvt_pk_bf16(b[2], b[3]); return w; }
template <bool BF> struct EpiRmsRes {
    static constexpr bool PERM = true, AFTER_DRAIN = true;
    const void* base; float* out; int ldc; const float* g1; float coef; PanelRms st;
    __device__ __forceinline__ void fused(f32x4 (&acc)[2][2][4][2], const Unit& u, int wr, int wc, int fr, int fq, PG8_LAS unsigned char* lds, int wid, int lane) const {
        const PG8_LAS float* S = (const PG8_LAS float*)(lds + 8192);
        const int col0 = u.pn * BM + wc * 32 + 8 * fq;
        f32x4 pre[4][2][2];
#pragma unroll
        for (int m = 0; m < 4; ++m) { const size_t off = (size_t)(u.pm * BM + wr * 64 + m * 16 + fr) * ldc + col0;
#pragma unroll
            for (int bj = 0; bj < 2; ++bj) ld_res8<BF>(base, off + bj * HALF, pre[m][bj][0], pre[m][bj][1]); }
        st.run(acc, u, wr, wc, fr, fq, lds, wid, lane);
        f32x4 gv[2][2];
#pragma unroll
        for (int bj = 0; bj < 2; ++bj)
#pragma unroll
            for (int n = 0; n < 2; ++n) gv[bj][n] = *(const f32x4*)(g1 + col0 + bj * HALF + n * 4) * coef;
#pragma unroll
        for (int ai = 0; ai < 2; ++ai)
#pragma unroll
            for (int m = 0; m < 4; ++m) { const int r = ai * HALF + wr * 64 + m * 16 + fr; const float rs = S[r]; const size_t off = (size_t)(u.pm * BM + r) * ldc + col0;
#pragma unroll
                for (int bj = 0; bj < 2; ++bj) { f32x4 b0, b1; if (ai == 0) { b0 = pre[m][bj][0]; b1 = pre[m][bj][1]; } else ld_res8<BF>(base, off + bj * HALF, b0, b1);
                    __builtin_nontemporal_store(b0 + acc[ai][bj][m][0] * gv[bj][0] * rs, (f32x4*)(out + off + bj * HALF));
                    __builtin_nontemporal_store(b1 + acc[ai][bj][m][1] * gv[bj][1] * rs, (f32x4*)(out + off + bj * HALF + 4)); }
                if (m & 1) asm volatile("" ::: "memory"); }
    }
};
template <bool BF> struct EpiRmsResRms {
    static constexpr bool PERM = true, AFTER_DRAIN = true;
    const void* base; bf16_t* out; bf16_t* xn; int ldc; const float* g1; float coef; const float* g2; PanelRms st1, st2;
    __device__ __forceinline__ void fused(f32x4 (&acc)[2][2][4][2], const Unit& u, int wr, int wc, int fr, int fq, PG8_LAS unsigned char* lds, int wid, int lane) const {
        const PG8_LAS float* S = (const PG8_LAS float*)(lds + 8192);
        const int col0 = u.pn * BM + wc * 32 + 8 * fq;
        f32x4 pre[4][2][2];
#pragma unroll
        for (int m = 0; m < 4; ++m) { const size_t off = (size_t)(u.pm * BM + wr * 64 + m * 16 + fr) * ldc + col0;
#pragma unroll
            for (int bj = 0; bj < 2; ++bj) ld_res8<BF>(base, off + bj * HALF, pre[m][bj][0], pre[m][bj][1]); }
        st1.run(acc, u, wr, wc, fr, fq, lds, wid, lane);
        {
            f32x4 gv[2][2];
#pragma unroll
            for (int bj = 0; bj < 2; ++bj)
#pragma unroll
                for (int n = 0; n < 2; ++n) gv[bj][n] = *(const f32x4*)(g1 + col0 + bj * HALF + n * 4) * coef;
#pragma unroll
            for (int ai = 0; ai < 2; ++ai)
#pragma unroll
                for (int m = 0; m < 4; ++m) { const int r = ai * HALF + wr * 64 + m * 16 + fr; const float rs = S[r]; const size_t off = (size_t)(u.pm * BM + r) * ldc + col0;
#pragma unroll
                    for (int bj = 0; bj < 2; ++bj) { f32x4 b0, b1; if (ai == 0) { b0 = pre[m][bj][0]; b1 = pre[m][bj][1]; } else ld_res8<BF>(base, off + bj * HALF, b0, b1);
                        acc[ai][bj][m][0] = b0 + acc[ai][bj][m][0] * gv[bj][0] * rs; acc[ai][bj][m][1] = b1 + acc[ai][bj][m][1] * gv[bj][1] * rs; }
                    asm volatile("" : "+v"(acc[ai][0][m][0]), "+v"(acc[ai][0][m][1]), "+v"(acc[ai][1][m][0]), "+v"(acc[ai][1][m][1]));
                    if (m & 1) asm volatile("" ::: "memory"); }
        }
        st2.run(acc, u, wr, wc, fr, fq, lds, wid, lane);
        f32x4 gv[2][2];
#pragma unroll
        for (int bj = 0; bj < 2; ++bj)
#pragma unroll
            for (int n = 0; n < 2; ++n) gv[bj][n] = *(const f32x4*)(g2 + col0 + bj * HALF + n * 4);
#pragma unroll
        for (int ai = 0; ai < 2; ++ai)
#pragma unroll
            for (int m = 0; m < 4; ++m) { const int r = ai * HALF + wr * 64 + m * 16 + fr; const float rs = S[r]; const size_t off = (size_t)(u.pm * BM + r) * ldc + col0;
#pragma unroll
                for (int bj = 0; bj < 2; ++bj) { const f32x4 x0 = acc[ai][bj][m][0], x1 = acc[ai][bj][m][1];
                    __builtin_nontemporal_store(pack_bf8(x0, x1), (u32x4*)(out + off + bj * HALF));
                    *(u32x4*)(xn + off + bj * HALF) = pack_bf8(x0 * gv[bj][0] * rs, x1 * gv[bj][1] * rs); }
                asm volatile("" ::: "memory"); }
    }
};

template <class Epi, class Sched, bool ALIGN_EPI = false, bool SP2 = false>
__device__ __forceinline__ void gemm_phase(PG8_LAS unsigned char* lds, const Gemm g, const Sched& S, const Epi& E, const int wid) {
    const int lane = lane_id_asm(), tid = wid * 64 + lane, wr = wid >> 2, wc = wid & 3, fr = lane & 15, fq = lane >> 4;
    const int K = g.K, nt = K / BK;
    unsigned voffA[2], voffB[2];
#pragma unroll
    for (int i = 0; i < 2; ++i) { int R, C; stage_rc(tid * 16 + i * 8192, R, C); const int Rb = Epi::PERM ? ((R & ~31) + perm32(R & 31)) : R;
        voffA[i] = (unsigned)(R * K + C) * 2u; voffB[i] = (unsigned)(Rb * K + C) * 2u; }
    const size_t kstep = (size_t)(BK * 2);
    const size_t hstep = (size_t)HALF * K * 2;
    const size_t tstep = 2 * hstep;
    const unsigned ldsw = (unsigned)wid * 1024u;
    const int aoff = lds_byte(wr * 64 + fr, fq * 8), boff = lds_byte(wc * 32 + fr, fq * 8);
#define PG8_SA(b, h) (((b) * 2 + (h)) * HTB)
#define PG8_SB(b, h) ((4 + (b) * 2 + (h)) * HTB)
#define PG8_STAGE(bufoff, gbase, voff) do { _Pragma("unroll") for (int _i = 0; _i < 2; ++_i) \
        __builtin_amdgcn_global_load_lds((const unsigned*)((const char*)(gbase) + (voff)[_i]), (PG8_LAS unsigned*)(lds + (bufoff) + ldsw + _i * 8192), 16, 0, 0); } while (0)
#define PG8_LDA(dst, b, h) do { _Pragma("unroll") for (int m = 0; m < 4; ++m) _Pragma("unroll") for (int k = 0; k < 2; ++k) dst[m][k] = *(const PG8_LAS bf16x8*)(lds + PG8_SA(b, h) + aoff + m * 2048 + k * 1024); } while (0)
#define PG8_LDB(dst, b, h) do { _Pragma("unroll") for (int n = 0; n < 2; ++n) _Pragma("unroll") for (int k = 0; k < 2; ++k) dst[n][k] = *(const PG8_LAS bf16x8*)(lds + PG8_SB(b, h) + boff + n * 2048 + k * 1024); } while (0)
#define PG8_MMA(ai, bj, At, Bt) do { __builtin_amdgcn_s_setprio(1); _Pragma("unroll") for (int m = 0; m < 4; ++m) _Pragma("unroll") for (int n = 0; n < 2; ++n) _Pragma("unroll") for (int k = 0; k < 2; ++k) \
        acc[ai][bj][m][n] = __builtin_amdgcn_mfma_f32_16x16x32_bf16(Bt[n][k], At[m][k], acc[ai][bj][m][n], 0, 0, 0); __builtin_amdgcn_s_setprio(0); } while (0)
#define PG8_WAIT_V(n) asm volatile("s_waitcnt vmcnt(" #n ")" ::: "memory")
#define PG8_WAIT_L(n) asm volatile("s_waitcnt lgkmcnt(" #n ")" ::: "memory")
#define PG8_BAR __builtin_amdgcn_s_barrier()
#define PG8_SCHED __builtin_amdgcn_sched_barrier(0)
    Unit cur, nxt; int ui = 0;
    if (!S.next(0, cur)) return;
    f32x4 acc[2][2][4][2];
#pragma unroll
    for (int a = 0; a < 2; ++a)
#pragma unroll
        for (int b = 0; b < 2; ++b)
#pragma unroll
            for (int m = 0; m < 4; ++m)
#pragma unroll
                for (int n = 0; n < 2; ++n) acc[a][b][m][n] = (f32x4){0.f, 0.f, 0.f, 0.f};
    bf16x8 At[4][2], B0[2][2], B1[2][2];
    const char* cA = (const char*)g.A + (size_t)cur.pm * tstep; const char* cB = (const char*)g.Bt + (size_t)cur.pn * tstep;
    S.a_ready(cur);
    if constexpr (SP2) {
        PG8_STAGE(PG8_SB(0, 0), cB, voffB); PG8_STAGE(PG8_SB(0, 1), cB + hstep, voffB); PG8_STAGE(PG8_SA(0, 0), cA, voffA); PG8_STAGE(PG8_SA(0, 1), cA + hstep, voffA);
        if (wr == 1) PG8_BAR;
        PG8_WAIT_V(2); PG8_BAR;
        PG8_STAGE(PG8_SB(1, 0), cB + kstep, voffB); PG8_STAGE(PG8_SA(1, 0), cA + kstep, voffA); PG8_STAGE(PG8_SB(1, 1), cB + hstep + kstep, voffB);
        PG8_WAIT_V(6); PG8_BAR;
    } else {
        PG8_STAGE(PG8_SB(0, 0), cB, voffB); PG8_STAGE(PG8_SA(0, 0), cA, voffA); PG8_STAGE(PG8_SB(0, 1), cB + hstep, voffB); PG8_STAGE(PG8_SA(0, 1), cA + hstep, voffA);
        if (wr == 1) PG8_BAR;
        PG8_WAIT_V(4); PG8_BAR;
        PG8_STAGE(PG8_SB(1, 0), cB + kstep, voffB); PG8_STAGE(PG8_SA(1, 0), cA + kstep, voffA); PG8_STAGE(PG8_SB(1, 1), cB + hstep + kstep, voffB);
        PG8_WAIT_V(6); PG8_BAR;
    }
    for (;;) {
        const bool has_next = S.next(ui + 1, nxt);
        const char* nA = has_next ? (const char*)g.A + (size_t)nxt.pm * tstep : cA; const char* nB = has_next ? (const char*)g.Bt + (size_t)nxt.pn * tstep : cB;
        for (int t = 0; t < nt; t += 2) {
            const bool last = (t == nt - 2);
            const char* a1 = cA + (size_t)(t + 1) * kstep;
            const char* a2 = last ? nA : cA + (size_t)(t + 2) * kstep; const char* b2 = last ? nB : cB + (size_t)(t + 2) * kstep;
            const char* a3 = a2 + kstep; const char* b3 = b2 + kstep;
            if (last && has_next) S.a_ready(nxt);
            if constexpr (SP2) {
            PG8_LDB(B0, 0, 0); PG8_LDB(B1, 0, 1); PG8_SCHED; PG8_LDA(At, 0, 0); PG8_STAGE(PG8_SA(1, 1), a1 + hstep, voffA);
            PG8_WAIT_V(8); PG8_WAIT_L(0); PG8_BAR; PG8_MMA(0, 0, At, B0); PG8_MMA(0, 1, At, B1); PG8_BAR; PG8_SCHED;
            PG8_LDA(At, 0, 1); PG8_STAGE(PG8_SB(0, 0), b2, voffB); PG8_STAGE(PG8_SB(0, 1), b2 + hstep, voffB); PG8_STAGE(PG8_SA(0, 0), a2, voffA);
            PG8_WAIT_V(8); PG8_WAIT_L(0); PG8_BAR; PG8_MMA(1, 0, At, B0); PG8_MMA(1, 1, At, B1); PG8_BAR; PG8_SCHED;
            PG8_LDB(B0, 1, 0); PG8_LDB(B1, 1, 1); PG8_SCHED; PG8_LDA(At, 1, 0); PG8_STAGE(PG8_SA(0, 1), a2 + hstep, voffA);
            PG8_WAIT_V(8); PG8_WAIT_L(0); PG8_BAR; PG8_MMA(0, 0, At, B0); PG8_MMA(0, 1, At, B1); PG8_BAR; PG8_SCHED;
            PG8_LDA(At, 1, 1); PG8_STAGE(PG8_SB(1, 0), b3, voffB); PG8_STAGE(PG8_SB(1, 1), b3 + hstep, voffB); PG8_STAGE(PG8_SA(1, 0), a3, voffA);
            PG8_WAIT_V(8); PG8_WAIT_L(0); PG8_BAR; PG8_MMA(1, 0, At, B0); PG8_MMA(1, 1, At, B1); PG8_BAR; PG8_SCHED;
            } else {
            PG8_LDB(B0, 0, 0); PG8_SCHED; PG8_LDA(At, 0, 0); PG8_STAGE(PG8_SA(1, 1), a1 + hstep, voffA);
            PG8_WAIT_L(8); PG8_BAR; PG8_WAIT_L(0); PG8_MMA(0, 0, At, B0); PG8_BAR; PG8_SCHED;
            PG8_LDB(B1, 0, 1); PG8_STAGE(PG8_SB(0, 0), b2, voffB);
            PG8_BAR; PG8_WAIT_L(0); PG8_MMA(0, 1, At, B1); PG8_BAR;
            PG8_LDA(At, 0, 1); PG8_STAGE(PG8_SA(0, 0), a2, voffA);
            PG8_BAR; PG8_WAIT_L(0); PG8_MMA(1, 0, At, B0); PG8_BAR; PG8_SCHED;
            PG8_STAGE(PG8_SB(0, 1), b2 + hstep, voffB);
            PG8_WAIT_V(6); PG8_BAR; PG8_MMA(1, 1, At, B1); PG8_BAR;
            PG8_LDB(B0, 1, 0); PG8_SCHED; PG8_LDA(At, 1, 0); PG8_STAGE(PG8_SA(0, 1), a2 + hstep, voffA);
            PG8_WAIT_L(8); PG8_BAR; PG8_WAIT_L(0); PG8_MMA(0, 0, At, B0); PG8_BAR; PG8_SCHED;
            PG8_LDB(B1, 1, 1); PG8_STAGE(PG8_SB(1, 0), b3, voffB);
            PG8_BAR; PG8_WAIT_L(0); PG8_MMA(0, 1, At, B1); PG8_BAR;
            PG8_LDA(At, 1, 1); PG8_STAGE(PG8_SA(1, 0), a3, voffA);
            PG8_BAR; PG8_WAIT_L(0); PG8_MMA(1, 0, At, B0); PG8_BAR; PG8_SCHED;
            PG8_STAGE(PG8_SB(1, 1), b3 + hstep, voffB);
            PG8_WAIT_V(6); PG8_BAR; PG8_MMA(1, 1, At, B1); PG8_BAR;
            }
        }
        if constexpr (ALIGN_EPI) { if (wr == 0) PG8_BAR; }
        if constexpr (!Epi::AFTER_DRAIN) { E(acc, cur, wr, wc, fr, fq); S.done(cur); }
        if (!has_next) break;
#pragma unroll
        for (int a = 0; a < 2; ++a)
#pragma unroll
            for (int b = 0; b < 2; ++b)
#pragma unroll
                for (int m = 0; m < 4; ++m)
#pragma unroll
                    for (int n = 0; n < 2; ++n) acc[a][b][m][n] = (f32x4){0.f, 0.f, 0.f, 0.f};
        cur = nxt; cA = nA; cB = nB; ++ui;
        if constexpr (ALIGN_EPI) { if (wr == 1) PG8_BAR; }
    }
    PG8_WAIT_V(0);
    if constexpr (!ALIGN_EPI) { if (wr == 0) PG8_BAR; }
    PG8_BAR;
    if constexpr (Epi::AFTER_DRAIN) { E.fused(acc, cur, wr, wc, fr, fq, lds, wid, lane); S.done(cur); }
#undef PG8_SA
#undef PG8_SB
#undef PG8_STAGE
#undef PG8_LDA
#undef PG8_LDB
#undef PG8_MMA
#undef PG8_WAIT_V
#undef PG8_WAIT_L
#undef PG8_BAR
#undef PG8_SCHED
}
}
#include <hip/hip_bf16.h>
#include <cmath>
namespace attn_body {
using bf16=__hip_bfloat16;
using bf16x8=__attribute__((ext_vector_type(8)))short;
using s16x4=__attribute__((ext_vector_type(4)))short;
using f32x16=__attribute__((ext_vector_type(16)))float;
using u32x4=__attribute__((ext_vector_type(4)))unsigned;
constexpr int BATCH=4,NHEAD=16,SEQ=4096,D=64,PD=1536,PO=1024;
constexpr int NW=8,QBLK=32,QB=QBLK*NW,KVBLK=64,NQB=SEQ/QB;
constexpr int ATTN_UNIT_ROWS=QB;
__device__ __forceinline__ int crow(int r,int hi){return (r&3)+8*(r>>2)+4*hi;}
#define SBAR() __builtin_amdgcn_sched_barrier(0)
__device__ __forceinline__ void cmask(f32x16&p0,f32x16&p1,int jb,int qrel,int hi){
  const float NEG=-INFINITY; int kb=64*jb+4*hi;
  #pragma unroll
  for(int r=0;r<16;++r){int kv=kb+(r&3)+8*(r>>2); if(kv>qrel)p0[r]=NEG; if(kv+32>qrel)p1[r]=NEG;}
}

constexpr int NSLOT=3, SLOTB=8192;
constexpr int LDS_K=0, LDS_V=NSLOT*SLOTB, LDS_WS=2*NSLOT*SLOTB, LDS_OST=LDS_WS+NW*64*4, LDS_BYTES=LDS_OST+NW*4096;
constexpr float C2=0.125f*1.4426950408889634f;
__device__ __forceinline__ void glds16(const void*gsrc,unsigned lds_dst){unsigned keep;
  asm volatile("s_mov_b32 %0, m0\n\ts_mov_b32 m0, %2\n\ts_nop 0\n\tglobal_load_lds_dwordx4 %1, off\n\ts_mov_b32 m0, %0":"=&s"(keep):"v"(gsrc),"s"(lds_dst):"memory");}
__device__ __forceinline__ float max3f(float a,float b,float c){float r;asm("v_max3_f32 %0, %1, %2, %3":"=v"(r):"v"(a),"v"(b),"v"(c));return r;}
__device__ __forceinline__ float max2f(float a,float b){float r;asm("v_max_f32_e32 %0, %1, %2":"=v"(r):"v"(a),"v"(b));return r;}
__device__ __forceinline__ float fadd_s(float a,float b){float r;asm("v_add_f32_e32 %0, %1, %2":"=v"(r):"v"(a),"v"(b));return r;}
__device__ __forceinline__ float fsub_s(float a,float b){float r;asm("v_sub_f32_e32 %0, %1, %2":"=v"(r):"v"(a),"v"(b));return r;}
typedef float f32x2_t __attribute__((ext_vector_type(2))); typedef __bf16 bf16x2_t __attribute__((ext_vector_type(2)));
__device__ __forceinline__ unsigned cvtpk_s(float lo,float hi){f32x2_t v={lo,hi};bf16x2_t b=__builtin_convertvector(v,bf16x2_t);return __builtin_bit_cast(unsigned,b);}
#define WAIT_BAR(N) asm volatile("s_waitcnt vmcnt(" #N ") lgkmcnt(0)\n\ts_barrier":::"memory")

__device__ __forceinline__ void qkt(f32x16&p0,f32x16&p1,const char*Kslot,const bf16x8*qr,const f32x16&negm,int r32,int hi){
  const char*kb=Kslot+hi*1024+r32*16;
  #pragma unroll
  for(int d0=0;d0<4;++d0){
    const bf16x8 b0=*reinterpret_cast<const bf16x8*>(kb+d0*2048);
    const bf16x8 b1=*reinterpret_cast<const bf16x8*>(kb+d0*2048+512);
    if(d0==0){p0=__builtin_amdgcn_mfma_f32_32x32x16_bf16(b0,qr[0],negm,0,0,0);p1=__builtin_amdgcn_mfma_f32_32x32x16_bf16(b1,qr[0],negm,0,0,0);}
    else{p0=__builtin_amdgcn_mfma_f32_32x32x16_bf16(b0,qr[d0],p0,0,0,0);p1=__builtin_amdgcn_mfma_f32_32x32x16_bf16(b1,qr[d0],p1,0,0,0);}}
}
typedef __attribute__((address_space(3))) const char* lds_cptr;
typedef short v4i16_t __attribute__((ext_vector_type(4)));
__device__ __forceinline__ void kload8(bf16x8*kf,lds_cptr kp){
  kf[0]=*(const __attribute__((address_space(3))) bf16x8*)(kp);      kf[1]=*(const __attribute__((address_space(3))) bf16x8*)(kp+512);
  kf[2]=*(const __attribute__((address_space(3))) bf16x8*)(kp+2048); kf[3]=*(const __attribute__((address_space(3))) bf16x8*)(kp+2560);
  kf[4]=*(const __attribute__((address_space(3))) bf16x8*)(kp+4096); kf[5]=*(const __attribute__((address_space(3))) bf16x8*)(kp+4608);
  kf[6]=*(const __attribute__((address_space(3))) bf16x8*)(kp+6144); kf[7]=*(const __attribute__((address_space(3))) bf16x8*)(kp+6656);
}
__device__ __forceinline__ void kload2(bf16x8*kf,lds_cptr kp,int j){ kf[2*j]=*(const __attribute__((address_space(3))) bf16x8*)(kp+j*2048); kf[2*j+1]=*(const __attribute__((address_space(3))) bf16x8*)(kp+j*2048+512); }
__device__ __forceinline__ s16x4 vtr(lds_cptr p){ return __builtin_bit_cast(s16x4,__builtin_amdgcn_ds_read_tr16_b64_v4i16((__attribute__((address_space(3))) v4i16_t*)p)); }
__device__ __forceinline__ float rowmax(const f32x16&p0,const f32x16&p1){
  float a=max3f(p0[0],p0[1],p1[0]),b=max3f(p0[2],p0[3],p1[1]);a=max3f(a,p1[2],p1[3]);
  #pragma unroll
  for(int r=4;r<16;r+=4){a=max3f(a,p0[r],p0[r+1]);b=max3f(b,p0[r+2],p0[r+3]);a=max3f(a,p1[r],p1[r+1]);b=max3f(b,p1[r+2],p1[r+3]);}
  const float m=max2f(a,b);
  auto rr=__builtin_amdgcn_permlane32_swap(__float_as_uint(m),__float_as_uint(m),false,false);
  return max2f(__uint_as_float(rr[0]),__uint_as_float(rr[1]));
}
__device__ __forceinline__ void pv(f32x16*o,int vb,bf16x8 pa0,bf16x8 pa1,bf16x8 pa2,bf16x8 pa3){
  #pragma unroll
  for(int d0=0;d0<2;++d0){s16x4 lo[4],hi[4];
    #pragma unroll
    for(int ks=0;ks<4;++ks){
      asm volatile("ds_read_b64_tr_b16 %0,%1 offset:%c2":"=&v"(lo[ks]):"v"(vb),"i"(d0*4096+ks*1024):"memory");
      asm volatile("ds_read_b64_tr_b16 %0,%1 offset:%c2":"=&v"(hi[ks]):"v"(vb),"i"(d0*4096+ks*1024+512):"memory");}
    asm volatile("s_waitcnt lgkmcnt(0)":::"memory");SBAR();
    #define PK(k) (bf16x8){lo[k][0],lo[k][1],lo[k][2],lo[k][3],hi[k][0],hi[k][1],hi[k][2],hi[k][3]}
    o[d0]=__builtin_amdgcn_mfma_f32_32x32x16_bf16(pa0,PK(0),o[d0],0,0,0);
    o[d0]=__builtin_amdgcn_mfma_f32_32x32x16_bf16(pa1,PK(1),o[d0],0,0,0);
    o[d0]=__builtin_amdgcn_mfma_f32_32x32x16_bf16(pa2,PK(2),o[d0],0,0,0);
    o[d0]=__builtin_amdgcn_mfma_f32_32x32x16_bf16(pa3,PK(3),o[d0],0,0,0);
    #undef PK
  }
}

#ifndef ATTN_STORE16
#define ATTN_STORE16(p,v) (*(u32x4*)(p)=(v))
#endif
template<int THRL> __device__ __forceinline__ void attn_unit(int b,int h,int qb,const bf16*Q,const bf16*__restrict__ K,const bf16*__restrict__ V,bf16*O,char*shm,const int wid){
  const int lane=lane_id_asm(),tid=wid*64+lane,r32=lane&31,hi=lane>>5;
  const long rowbase=(long)b*SEQ; const int q0=qb*QB;
  const int qcol=(h>>1)*64, kcol=512+(h>>1)*64, vcol=1024+(h>>2)*128+(h&1)*64, ocol=h*64;
  const bf16*Qw=Q+(rowbase+q0+wid*QBLK)*PD+qcol;
  const bf16*Kh=K+rowbase*PD+kcol,*Vh=V+rowbase*PD+vcol;
  const unsigned lds0=(unsigned)(uintptr_t)shm;
  float*wsf=(float*)(shm+LDS_WS)+wid*64;
  const bf16*ksrc=Kh+(long)lane*PD+wid*8;
  const bf16*vsrc=Vh+(long)(16*(wid&3)+(lane>>2))*PD+(wid>>2)*32+(lane&3)*8;
  const unsigned kdst=lds0+LDS_K+wid*1024, vdst=lds0+LDS_V+wid*1024;
  #define DMA_K(t,slot) glds16(ksrc+(long)(t)*KVBLK*PD,(unsigned)__builtin_amdgcn_readfirstlane(kdst+(slot)))
  #define DMA_V(t,slot) glds16(vsrc+(long)(t)*KVBLK*PD,(unsigned)__builtin_amdgcn_readfirstlane(vdst+(slot)))
  const int vb0=(int)(lds0+LDS_V)+((lane>>4)&1)*32+(lane&3)*8+(4*hi+((lane&15)>>2))*64;
  const char*Kbase=shm+LDS_K; bf16x8 kf[8];
  const lds_cptr shm3=(lds_cptr)shm; const lds_cptr kp0=shm3+LDS_K+hi*1024+r32*16; const lds_cptr vp0=shm3+LDS_V+((lane>>4)&1)*32+(lane&3)*8+(4*hi+((lane&15)>>2))*64;
  const int NT=(q0+QB)/KVBLK;
  DMA_K(0,0);DMA_V(0,0);DMA_K(1,SLOTB);
  bf16x8 qr[4];
  #pragma unroll
  for(int d0=0;d0<4;++d0)qr[d0]=*reinterpret_cast<const bf16x8*>(&Qw[(long)r32*PD+d0*16+hi*8]);
  float mhat=0.f,l_reg=0.f;f32x16 o[2];o[0]=f32x16{};o[1]=f32x16{};f32x16 negm=f32x16{};asm volatile("":"+v"(negm));
  const int qrel=wid*QBLK+r32;
  #define CMASK(P0,P1,t) do{int jb_=(t)-(NT-4); if(jb_>=0)cmask(P0,P1,jb_,qrel,hi);}while(0)
  bool resc=false;
  #define START(P0,P1) do{ const float rm=rowmax(P0,P1); resc=false; \
    { const float dl=rm; mhat=fadd_s(mhat,dl); \
      _Pragma("unroll") for(int r=0;r<16;++r){P0[r]=fsub_s(P0[r],dl);P1[r]=fsub_s(P1[r],dl);} \
      _Pragma("unroll") for(int r=0;r<16;++r)negm[r]=-mhat; asm volatile("":"+v"(negm)); } \
    _Pragma("unroll") for(int r=0;r<16;++r)P0[r]=__builtin_amdgcn_exp2f(P0[r]); }while(0)
  #define RESC() do{ if(resc){ asm volatile("s_waitcnt lgkmcnt(0)":::"memory"); \
      _Pragma("unroll") for(int d_=0;d_<2;++d_) _Pragma("unroll") for(int r=0;r<16;++r)o[d_][r]*=wsf[crow(r,hi)]; } }while(0)
  f32x16 pA0,pA1,pB0,pB1;
  int sl_prev=0,sl_cur=0,sl_next=SLOTB;
  #define ROT() do{sl_prev=sl_cur;sl_cur=sl_next;sl_next=(sl_next==(NSLOT-1)*SLOTB)?0:sl_next+SLOTB;}while(0)
  DMA_K(2,2*SLOTB);
  WAIT_BAR(3);
  qkt(pA0,pA1,Kbase,qr,negm,r32,hi);asm volatile("s_nop 15\n\ts_nop 7":"+v"(pA0),"+v"(pA1));CMASK(pA0,pA1,0);
  START(pA0,pA1);
  _Pragma("unroll") for(int r=0;r<16;++r)pA1[r]=__builtin_amdgcn_exp2f(pA1[r]);
  WAIT_BAR(0);
  DMA_K(3,0);DMA_V(1,SLOTB);
  ROT();
  kload8(kf,kp0+sl_cur);
  WAIT_BAR(2);
  s16x4 vlo[8],vhi[8]; u32x4 pw0,pw1,pw2,pw3;
  #define PKW(P,B) cvtpk_s(P[B],P[B+1])
  #define PAF(k) __builtin_bit_cast(bf16x8,pw##k)
  #define VFR(i) (bf16x8){vlo[i][0],vlo[i][1],vlo[i][2],vlo[i][3],vhi[i][0],vhi[i][1],vhi[i][2],vhi[i][3]}
  #define PIN(x) asm volatile("":"+v"(x))
  #define MX3(a,b,c) __builtin_fmaxf(__builtin_fmaxf((a),(b)),(c))
  #define GAPA(MF,A0,A1,A2,A3,W0,W1,PW) do{ MF; sacc+=A0; sacc+=A1; sacc+=A2; sacc+=A3; PIN(sacc); W0; W1; PIN(PW); SBAR(); }while(0)
  #define EX(v) __builtin_amdgcn_exp2f(v)
  #define GAPB(MF,X,B) do{ MF; X[B]=EX(X[B]); X[B+1]=EX(X[B+1]); X[B+2]=EX(X[B+2]); X[B+3]=EX(X[B+3]); PIN(X); SBAR(); }while(0)
  #define VRD(i) do{ vlo[i]=vtr(vp_+(((i)>>2)*4096+((i)&3)*1024)); vhi[i]=vtr(vp_+(((i)>>2)*4096+((i)&3)*1024+512)); }while(0)
  #define KRD(G,j) do{ if(G){ kload2(kf,kp0+sl_next,j); SBAR(); } }while(0)
  #define STEP(C0,C1,P0,P1,t,GK,GV,GL) do{ SBAR(); \
    const lds_cptr vp_=vp0+sl_prev; \
    VRD(0); SBAR(); float sacc=(P0[0]+P0[1]); \
    GAPA(C0=__builtin_amdgcn_mfma_f32_32x32x16_bf16(kf[0],qr[0],negm,0,0,0), P0[2],P0[3],P0[4],P0[5],     pw0[0]=PKW(P0,0), pw0[1]=PKW(P0,2), pw0); \
    VRD(4); SBAR(); GAPA(C1=__builtin_amdgcn_mfma_f32_32x32x16_bf16(kf[1],qr[0],negm,0,0,0), P0[6],P0[7],P0[8],P0[9],     pw0[2]=PKW(P0,4), pw0[3]=PKW(P0,6), pw0); \
    VRD(1); SBAR(); GAPA(C0=__builtin_amdgcn_mfma_f32_32x32x16_bf16(kf[2],qr[1],C0,0,0,0),   P0[10],P0[11],P0[12],P0[13], pw1[0]=PKW(P0,8), pw1[1]=PKW(P0,10), pw1); \
    VRD(5); SBAR(); GAPA(C1=__builtin_amdgcn_mfma_f32_32x32x16_bf16(kf[3],qr[1],C1,0,0,0),   P0[14],P0[15],P1[0],P1[1],   pw1[2]=PKW(P0,12),pw1[3]=PKW(P0,14), pw1); \
    VRD(2); SBAR(); GAPA(C0=__builtin_amdgcn_mfma_f32_32x32x16_bf16(kf[4],qr[2],C0,0,0,0),   P1[2],P1[3],P1[4],P1[5],     pw2[0]=PKW(P1,0), pw2[1]=PKW(P1,2), pw2); \
    VRD(6); SBAR(); GAPA(C1=__builtin_amdgcn_mfma_f32_32x32x16_bf16(kf[5],qr[2],C1,0,0,0),   P1[6],P1[7],P1[8],P1[9],     pw2[2]=PKW(P1,4), pw2[3]=PKW(P1,6), pw2); \
    VRD(3); SBAR(); GAPA(C0=__builtin_amdgcn_mfma_f32_32x32x16_bf16(kf[6],qr[3],C0,0,0,0),   P1[10],P1[11],P1[12],P1[13], pw3[0]=PKW(P1,8), pw3[1]=PKW(P1,10), pw3); \
    VRD(7); SBAR(); GAPA(C1=__builtin_amdgcn_mfma_f32_32x32x16_bf16(kf[7],qr[3],C1,0,0,0),   P1[14],P1[15],0.f,0.f,       pw3[2]=PKW(P1,12),pw3[3]=PKW(P1,14), pw3); \
    l_reg+=sacc; \
    if(GK){DMA_K((t)+3,sl_cur);} if(GV){DMA_V((t)+1,sl_next);} \
    CMASK(C0,C1,t); \
    { float a=MX3(C0[0],C0[1],C1[0]),b=MX3(C0[2],C0[3],C1[1]); a=MX3(a,C1[2],C1[3]); \
      _Pragma("unroll") for(int r=4;r<16;r+=4){a=MX3(a,C0[r],C0[r+1]);b=MX3(b,C0[r+2],C0[r+3]);a=MX3(a,C1[r],C1[r+1]);b=MX3(b,C1[r+2],C1[r+3]);} \
      float rm=__builtin_fmaxf(a,b); { auto rr=__builtin_amdgcn_permlane32_swap(__float_as_uint(rm),__float_as_uint(rm),false,false); rm=__builtin_fmaxf(__uint_as_float(rr[0]),__uint_as_float(rr[1])); } \
      resc=false; \
      if(__builtin_expect(__any(rm>(float)THRL),0)){ const float dl=__builtin_fmaxf(rm,0.f); mhat+=dl; \
        _Pragma("unroll") for(int r=0;r<16;++r){C0[r]-=dl;C1[r]-=dl;} \
        _Pragma("unroll") for(int r=0;r<16;++r)negm[r]=-mhat; asm volatile("":"+v"(negm)); \
        const float f=__builtin_amdgcn_exp2f(-dl); l_reg*=f; if(hi==0)wsf[r32]=f; resc=true; } } \
    SBAR(); \
    GAPB(o[0]=__builtin_amdgcn_mfma_f32_32x32x16_bf16(PAF(0),VFR(0),o[0],0,0,0), C0,0); \
    GAPB(o[1]=__builtin_amdgcn_mfma_f32_32x32x16_bf16(PAF(0),VFR(4),o[1],0,0,0), C0,4); \
    KRD(GL,0); GAPB(o[0]=__builtin_amdgcn_mfma_f32_32x32x16_bf16(PAF(1),VFR(1),o[0],0,0,0), C0,8); \
    KRD(GL,1); GAPB(o[1]=__builtin_amdgcn_mfma_f32_32x32x16_bf16(PAF(1),VFR(5),o[1],0,0,0), C0,12); \
    KRD(GL,2); GAPB(o[0]=__builtin_amdgcn_mfma_f32_32x32x16_bf16(PAF(2),VFR(2),o[0],0,0,0), C1,0); \
    KRD(GL,3); GAPB(o[1]=__builtin_amdgcn_mfma_f32_32x32x16_bf16(PAF(2),VFR(6),o[1],0,0,0), C1,4); \
    GAPB(o[0]=__builtin_amdgcn_mfma_f32_32x32x16_bf16(PAF(3),VFR(3),o[0],0,0,0), C1,8); \
    GAPB(o[1]=__builtin_amdgcn_mfma_f32_32x32x16_bf16(PAF(3),VFR(7),o[1],0,0,0), C1,12); \
    }while(0)
  int t=1;
  #undef CMASK
  #define CMASK(P0,P1,t) do{}while(0)
  for(;t+5<NT;t+=2){
    STEP(pB0,pB1,pA0,pA1,t,true,true,true);     WAIT_BAR(2); RESC(); ROT();
    STEP(pA0,pA1,pB0,pB1,t+1,true,true,true);   WAIT_BAR(2); RESC(); ROT();
  }
  #undef CMASK
  #define CMASK(P0,P1,t) do{int jb_=(t)-(NT-4); if(jb_>=0)cmask(P0,P1,jb_,qrel,hi);}while(0)
  #define ENDW(tt) do{ if((tt)+3<NT){WAIT_BAR(2);} else if((tt)+2<NT){WAIT_BAR(1);} else {WAIT_BAR(0);} }while(0)
  for(;t+1<NT;t+=2){
    STEP(pB0,pB1,pA0,pA1,t,(t+3<NT),(t+1<NT),(t+1<NT));       ENDW(t);   RESC(); ROT();
    STEP(pA0,pA1,pB0,pB1,t+1,(t+4<NT),(t+2<NT),(t+2<NT));     ENDW(t+1); RESC(); ROT();
  }
  STEP(pB0,pB1,pA0,pA1,NT-1,false,false,false); RESC();
  { float sacc=pB0[0]+pB0[1]; _Pragma("unroll") for(int r=2;r<16;++r)sacc+=pB0[r]; _Pragma("unroll") for(int r=0;r<16;++r)sacc+=pB1[r]; l_reg+=sacc;
    pw0=(u32x4){PKW(pB0,0),PKW(pB0,2),PKW(pB0,4),PKW(pB0,6)};pw1=(u32x4){PKW(pB0,8),PKW(pB0,10),PKW(pB0,12),PKW(pB0,14)};pw2=(u32x4){PKW(pB1,0),PKW(pB1,2),PKW(pB1,4),PKW(pB1,6)};pw3=(u32x4){PKW(pB1,8),PKW(pB1,10),PKW(pB1,12),PKW(pB1,14)};
    SBAR(); pv(o,vb0+sl_cur,PAF(0),PAF(1),PAF(2),PAF(3)); }
  #undef PKW
  #undef PAF
  #undef VFR
  #undef PIN
  #undef MX3
  #undef GAPA
  #undef GAPB
  #undef EX
  #undef VRD
  #undef KRD
  #undef STEP
  #undef ENDW
  {auto rr=__builtin_amdgcn_permlane32_swap(__float_as_uint(l_reg),__float_as_uint(l_reg),false,false);l_reg=__uint_as_float(rr[0])+__uint_as_float(rr[1]);}
  if(hi==0)wsf[32+r32]=l_reg;asm volatile("s_waitcnt lgkmcnt(0)":::"memory");
  float rli[16];
  #pragma unroll
  for(int r=0;r<16;++r)rli[r]=__builtin_amdgcn_rcpf(wsf[32+crow(r,hi)]);
  bf16*Ow=O+(rowbase+q0+wid*QBLK)*PO+ocol;
  { bf16*stg=(bf16*)(shm+LDS_OST)+wid*2048;
    #pragma unroll
    for(int r=0;r<16;++r){const int orow=crow(r,hi);
      #pragma unroll
      for(int d0=0;d0<2;++d0)stg[orow*64+d0*32+r32]=__float2bfloat16(o[d0][r]*rli[r]);}
    asm volatile("s_waitcnt lgkmcnt(0)":::"memory");
    #pragma unroll
    for(int i=0;i<4;++i){const int row=i*8+(lane>>3),ch=lane&7; const u32x4 v=*(const u32x4*)(stg+row*64+ch*8); ATTN_STORE16(Ow+(long)row*PO+ch*8,v);} }
  asm volatile("s_waitcnt lgkmcnt(0)\n\ts_barrier":::"memory");
  #undef DMA_K
  #undef DMA_V
  #undef CMASK
  #undef START
  #undef RESC
  #undef ROT
}
constexpr int ATTN_LDS_BYTES=LDS_BYTES;
#undef SBAR
#undef WAIT_BAR
}
constexpr int NWAVES = 8;
constexpr int BATCH = 4, T = 4096, D = 1024, FF = 2816, M = BATCH * T;
constexpr int NGU = 2 * FF;
constexpr int RW_H = 8, RW_N = 64, RW_W = 512;
constexpr int SHIFT_COLS = 1824, PROJ_W = 3360;
constexpr int PRW = 2048, PDF = 1536, NPW = PRW + PDF;
constexpr int CH = 64, NCH = T / CH, NITEM = BATCH * RW_H * NCH;
constexpr float NORM_EPS = 1e-6f, GN_EPS = 64e-5f, SUBLN_EPS = 1e-5f, LAMBDA_INIT = 0.2f;
#ifndef MK_PER_PHASE
#define MK_PER_PHASE 0
#endif
constexpr int N_PHASES = 13;
#ifndef RS01
#define RS01 1
#endif
#ifndef RS2
#define RS2 1
#endif
#ifndef RA1
#define RA1 1
#endif
#ifndef RA3
#define RA3 1
#endif
#ifndef REP1
#define REP1 1
#endif
#ifndef REP4
#define REP4 1
#endif
#ifndef REPBAR
#define REPBAR 0
#endif
#ifndef REPSCAN
#define REPSCAN 1
#endif
#ifndef REPATT
#define REPATT 1
#endif
#ifndef REP2
#define REP2 1
#endif
#ifndef PROBE_PHASE
#define PROBE_PHASE -1
#endif
#ifndef PROBE_SUB
#define PROBE_SUB -1
#endif
#ifndef REP0
#define REP0 1
#endif
#ifndef REP5
#define REP5 1
#endif
#ifndef REP6
#define REP6 1
#endif
#ifndef REP7
#define REP7 1
#endif

constexpr size_t MiB = 1u << 20;
constexpr size_t WS_CTL = 0, CTL_ZERO_BYTES = 262144;
constexpr size_t WS_LORA = 1 * MiB;
constexpr size_t WS_WGU1 = 2 * MiB, WS_WD1 = 13 * MiB, WS_WIN = 19 * MiB, WS_WO = 26 * MiB, WS_WGU2 = 28 * MiB, WS_WD2 = 39 * MiB;
constexpr size_t WS_S = 2 * MiB;
constexpr size_t WS_XN = 48 * MiB;
constexpr size_t WS_PT = 48 * MiB, WS_QC = 64 * MiB;
constexpr size_t WS_ACT = 80 * MiB;
constexpr size_t WS_PRW = 80 * MiB, WS_PDF = 144 * MiB;
constexpr size_t WS_O = 80 * MiB, WS_YMIX = 112 * MiB;
constexpr size_t WS_VB = 192 * MiB, WS_G = 208 * MiB, WS_RP = 224 * MiB, WS_Y0 = 240 * MiB;
constexpr size_t WS_Y = 192 * MiB;
constexpr size_t WS_YM = 144 * MiB;
constexpr size_t WS_X = 45 * MiB;
constexpr int CW_SEAM = 32768, SEAM_BANK = 64 * 64;
constexpr size_t WS_END = 256 * MiB;
constexpr int CW_QUEUE = 64, CW_BAR = 4096;
constexpr size_t WS_PRM = 65536;

constexpr int ARR = 64 * 72 * 2;
constexpr int L_AT = 0, L_BT = ARR, L_KT = 2 * ARR, L_RT = 3 * ARR, L_ATT = 4 * ARR, L_VT = 5 * ARR, L_BH = 6 * ARR, L_KH = 7 * ARR;
constexpr int L_M = 8 * ARR, L_MT = 9 * ARR, L_TT = 10 * ARR, L_NAK = 11 * ARR, L_NRK = 12 * ARR, L_NRB = 13 * ARR;
constexpr int L_APT = L_AT, L_W1T = L_BT, L_U0T = L_KT;
constexpr int L_XW = L_M, L_XA = L_M + ARR, L_XG = L_M + 2 * ARR;
constexpr int FARR = 64 * 65 * 4;
constexpr int L_WL = L_M, L_AL = L_M + FARR, L_GL = L_M + 2 * FARR;
constexpr int L_GT = 14 * ARR;
constexpr int L_WC = L_GT + 2048;
constexpr int LDS_BYTES = 150 * 1024;
constexpr int L_MISC = LDS_BYTES - 256;
static_assert(L_GL + FARR <= L_GT && L_XG + 64 * 168 * 2 <= L_GT && L_WC + 256 <= L_MISC && 8 * 16640 <= L_MISC, "LDS map");
constexpr int L_LWA = L_M, L_LG = L_WC + 256;
static_assert(L_LG + 20480 <= L_MISC && 16384 <= 2 * ARR, "LoRA weight image");
constexpr int L_YL = 0;

#define GAS __attribute__((address_space(1)))
#define LAS __attribute__((address_space(3)))
typedef unsigned short bf16;
typedef unsigned v4u __attribute__((ext_vector_type(4)));
typedef unsigned v2u __attribute__((ext_vector_type(2)));
typedef float f32x4 __attribute__((ext_vector_type(4)));
typedef short bf16x8 __attribute__((ext_vector_type(8)));
#define LDS_WAIT() asm volatile("s_waitcnt lgkmcnt(0)" ::: "memory")
typedef float f32x2_k __attribute__((ext_vector_type(2))); typedef __bf16 bf16x2_k __attribute__((ext_vector_type(2)));
__device__ __forceinline__ unsigned pk2(float lo, float hi) { f32x2_k v = {lo, hi}; bf16x2_k b = __builtin_convertvector(v, bf16x2_k); return __builtin_bit_cast(unsigned, b); }
__device__ __forceinline__ unsigned f2bf(float f) { return pk2(f, 0.f) & 0xffffu; }
__device__ __forceinline__ float bf2f(unsigned short b) { return __builtin_bit_cast(float, (unsigned)b << 16); }
__device__ __forceinline__ float bflo(unsigned w) { return __builtin_bit_cast(float, w << 16); }
__device__ __forceinline__ float bfhi(unsigned w) { return __builtin_bit_cast(float, w & 0xffff0000u); }
__device__ __forceinline__ float dpp_add(float v, const int ctrl_sel) {
    const int x = __builtin_bit_cast(int, v); int y;
    if (ctrl_sel == 0) y = __builtin_amdgcn_update_dpp(0, x, 0xB1, 0xF, 0xF, true);
    else if (ctrl_sel == 1) y = __builtin_amdgcn_update_dpp(0, x, 0x4E, 0xF, 0xF, true);
    else if (ctrl_sel == 2) y = __builtin_amdgcn_update_dpp(0, x, 0x141, 0xF, 0xF, true);
    else y = __builtin_amdgcn_update_dpp(0, x, 0x140, 0xF, 0xF, true);
    return v + __builtin_bit_cast(float, y);
}
__device__ __forceinline__ float wave_sum(float v) {
    v = dpp_add(v, 0); v = dpp_add(v, 1); v = dpp_add(v, 2); v = dpp_add(v, 3);
    { auto rr = __builtin_amdgcn_permlane16_swap(__float_as_uint(v), __float_as_uint(v), false, false); v = __uint_as_float(rr[0]) + __uint_as_float(rr[1]); }
    { auto rr = __builtin_amdgcn_permlane32_swap(__float_as_uint(v), __float_as_uint(v), false, false); v = __uint_as_float(rr[0]) + __uint_as_float(rr[1]); }
    return v;
}
__device__ __forceinline__ float swap32_add(float a, float b) { auto rr = __builtin_amdgcn_permlane32_swap(__float_as_uint(a), __float_as_uint(b), false, false); return __uint_as_float(rr[0]) + __uint_as_float(rr[1]); }
__device__ __forceinline__ float swap16_add(float a, float b) { auto rr = __builtin_amdgcn_permlane16_swap(__float_as_uint(a), __float_as_uint(b), false, false); return __uint_as_float(rr[0]) + __uint_as_float(rr[1]); }
__device__ __forceinline__ void wave_sum8(float (&x)[8]) {
    const float y0 = swap32_add(x[0], x[4]), y1 = swap32_add(x[1], x[5]), y2 = swap32_add(x[2], x[6]), y3 = swap32_add(x[3], x[7]);
    float z0 = swap16_add(y0, y2), z1 = swap16_add(y1, y3);
    z0 = dpp_add(z0, 0); z1 = dpp_add(z1, 0); z0 = dpp_add(z0, 1); z1 = dpp_add(z1, 1); z0 = dpp_add(z0, 2); z1 = dpp_add(z1, 2); z0 = dpp_add(z0, 3); z1 = dpp_add(z1, 3);
    const int i0 = __builtin_bit_cast(int, z0), i1 = __builtin_bit_cast(int, z1);
    x[0] = __builtin_bit_cast(float, __builtin_amdgcn_readlane(i0, 0));  x[2] = __builtin_bit_cast(float, __builtin_amdgcn_readlane(i0, 16));
    x[4] = __builtin_bit_cast(float, __builtin_amdgcn_readlane(i0, 32)); x[6] = __builtin_bit_cast(float, __builtin_amdgcn_readlane(i0, 48));
    x[1] = __builtin_bit_cast(float, __builtin_amdgcn_readlane(i1, 0));  x[3] = __builtin_bit_cast(float, __builtin_amdgcn_readlane(i1, 16));
    x[5] = __builtin_bit_cast(float, __builtin_amdgcn_readlane(i1, 32)); x[7] = __builtin_bit_cast(float, __builtin_amdgcn_readlane(i1, 48));
}
__device__ __forceinline__ float sigmoidf_(float x) { return __builtin_amdgcn_rcpf(1.0f + __expf(-x)); }

typedef GAS unsigned gu32;
#define RLX_AGENT __ATOMIC_RELAXED, __HIP_MEMORY_SCOPE_AGENT
#define XB_TMO      128
#define XB_XCNT(j)  (256  + 64 * (j))
#define XB_XSUB(j)  (1280 + 64 * (j))
#define XB_XGEN(j)  (2304 + 64 * (j))
#define XB_TOP      3328
#define XB_TOPGEN   3392
#define XCD_BAR_WORDS 3456
#define XB_SPIN_CAP (1u << 18)

__device__ __forceinline__ unsigned xb_ld(unsigned* p)              { return __hip_atomic_load(p, __ATOMIC_RELAXED, __HIP_MEMORY_SCOPE_AGENT); }
__device__ __forceinline__ unsigned xb_add(unsigned* p, unsigned v) { return __hip_atomic_fetch_add(p, v, __ATOMIC_RELAXED, __HIP_MEMORY_SCOPE_AGENT); }
__device__ __forceinline__ unsigned xb_xcc_id() { return (unsigned)__builtin_amdgcn_s_getreg((3 << 11) | 20) & 0xFu; }
#define XB_SPIN(cond, bar) do { unsigned _sp = 0; while (cond) { __builtin_amdgcn_s_sleep(1); \
    if ((++_sp & 255u) == 0u) { if (xb_ld(&(bar)[XB_TMO])) break; if (_sp > XB_SPIN_CAP) { atomicAdd(&(bar)[XB_TMO], 1u); break; } } } } while (0)

struct XcdBarrier {
    unsigned* bar; unsigned x;
    volatile LAS unsigned* st;
};

__device__ __forceinline__ XcdBarrier xcd_barrier_post(unsigned* bar, volatile LAS unsigned* st, const int wid) {
    XcdBarrier b; b.bar = bar; b.x = xb_xcc_id(); b.st = st;
    if (wid == 0 && lane_id_asm() == 0) (void)xb_add(&bar[XB_XCNT(b.x)], 1u);
    return b;
}
__device__ __forceinline__ void xcd_barrier_complete(unsigned* bar, unsigned x, unsigned& nloc, unsigned& nx) {
    const unsigned G = gridDim.x * gridDim.y * gridDim.z;
    unsigned sum, cnt, mine, sp = 0u;
    for (;;) {
        sum = 0u; cnt = 0u; mine = 0u;
#pragma unroll
        for (unsigned j = 0; j < 16; ++j) { const unsigned c = xb_ld(&bar[XB_XCNT(j)]); sum += c; cnt += (c > 0u) ? 1u : 0u; mine = (j == x) ? c : mine; }
        if (sum == G) break;
        __builtin_amdgcn_s_sleep(1);
        if ((++sp & 255u) == 0u) { if (xb_ld(&bar[XB_TMO])) break; if (sp > XB_SPIN_CAP) { atomicAdd(&bar[XB_TMO], 1u); break; } }
    }
    nloc = mine > 0u ? mine : 1u; nx = cnt > 0u ? cnt : 1u;
}

__device__ __forceinline__ void xcd_barrier(const XcdBarrier& b, const int wid) {
    asm volatile("s_waitcnt vmcnt(0)" ::: "memory");
    __syncthreads();
    if (wid == 0 && lane_id_asm() == 0) {
        unsigned* bar = b.bar;
        __builtin_amdgcn_s_waitcnt(0);
        unsigned nloc = b.st[0], nx = b.st[1];
        if (nloc == 0u) { xcd_barrier_complete(bar, b.x, nloc, nx); b.st[0] = nloc; b.st[1] = nx; }
        const unsigned old = xb_add(&bar[XB_XSUB(b.x)], 1u);
        const unsigned gen = old / nloc;
        if (old + 1u == (gen + 1u) * nloc) {
            __builtin_amdgcn_fence(__ATOMIC_RELEASE, "agent");
            asm volatile("s_waitcnt vmcnt(0)" ::: "memory");
            const unsigned og = xb_add(&bar[XB_TOP], 1u);
            const unsigned tg = og / nx;
            if (og + 1u == (tg + 1u) * nx) xb_add(&bar[XB_TOPGEN], 1u);
            else XB_SPIN(xb_ld(&bar[XB_TOPGEN]) == tg, bar);
            __builtin_amdgcn_fence(__ATOMIC_ACQUIRE, "agent");
            xb_add(&bar[XB_XGEN(b.x)], 1u);
            asm volatile("s_waitcnt vmcnt(0)" ::: "memory");
        } else {
            XB_SPIN(xb_ld(&bar[XB_XGEN(b.x)]) == gen, bar);
            __builtin_amdgcn_fence(__ATOMIC_ACQUIRE, "agent");
            asm volatile("s_waitcnt vmcnt(0)" ::: "memory");
        }
    }
    __syncthreads();
}

struct Args { const float* in[31]; float* out; unsigned char* ws; int ph_lo, ph_hi; };
struct Frame {
    LAS unsigned char* lds;
    unsigned* ctl;
    int tid, lane, wave, vcu, G;
    float* out; unsigned char* ws;
};

struct P0Job { const float* W; bf16* WT; int K, N, ldk, kind, r; bool late; };
__device__ __forceinline__ void p0_load(const P0Job& j, f32x4 (&v)[16], int lane) {
    const int nblk = (j.N + 63) / 64, kb = j.r / nblk, nb = j.r % nblk, k0 = 64 * kb, n0 = 64 * nb;
    const int r = lane >> 4, c4 = lane & 15; const bool colok = n0 + 4 * c4 < j.N;
#pragma unroll
    for (int i = 0; i < 16; ++i) { const int kk = 4 * i + r; v[i] = (colok && k0 + kk < j.K) ? __builtin_nontemporal_load((const GAS f32x4*)(j.W + (size_t)(k0 + kk) * j.N + n0 + 4 * c4)) : (f32x4){0.f, 0.f, 0.f, 0.f}; }
}
__device__ __forceinline__ int p0_drow(int kind, int n0) {
    if (kind == 1) return 256 * (n0 >> 7) + (n0 & 127);
    if (kind == 2) return 256 * (n0 >> 7) + 128 + (n0 & 127);
    if (kind == 3) return (n0 >= SHIFT_COLS) ? n0 + (PRW - SHIFT_COLS) : n0;
    return n0;
}
__device__ __forceinline__ float p0_scale(int kind, int n0) { return (kind == 3 && n0 >= SHIFT_COLS && n0 < SHIFT_COLS + 512) ? attn_body::C2 : 1.f; }
__device__ __forceinline__ void p0_finish(const P0Job& j, const f32x4 (&v)[16], LAS float* scr, int lane) {
    const int nblk = (j.N + 63) / 64, kb = j.r / nblk, nb = j.r % nblk, k0 = 64 * kb, n0 = 64 * nb;
    const int r = lane >> 4, c4 = lane & 15; const float sc = (c4 < 8) ? p0_scale(j.kind, n0) : p0_scale(j.kind, n0 + 32);
#pragma unroll
    for (int i = 0; i < 16; ++i) { const int kk = 4 * i + r; LAS float* d = scr + kk * 65 + 4 * c4; d[0] = v[i][0] * sc; d[1] = v[i][1] * sc; d[2] = v[i][2] * sc; d[3] = v[i][3] * sc; }
    LDS_WAIT(); asm volatile("" ::: "memory");
    const int c = lane & 7;
#pragma unroll
    for (int hb = 0; hb < 2; ++hb) { const int drow0 = p0_drow(j.kind, n0 + 32 * hb);
        if (n0 + 32 * hb < j.N && k0 + 8 * c < j.K) {
#pragma unroll
            for (int jj = 0; jj < 4; ++jj) { const int n = (lane >> 3) + 8 * jj; const LAS float* sp = scr + (8 * c) * 65 + 32 * hb + n;
                v4u o; o.x = pk2(sp[0 * 65], sp[1 * 65]); o.y = pk2(sp[2 * 65], sp[3 * 65]); o.z = pk2(sp[4 * 65], sp[5 * 65]); o.w = pk2(sp[6 * 65], sp[7 * 65]);
                GAS v4u* dp = (GAS v4u*)(j.WT + (size_t)(drow0 + n) * j.ldk + k0 + 8 * c); if (j.late) __builtin_nontemporal_store(o, dp); else *dp = o; } } }
    LDS_WAIT(); asm volatile("" ::: "memory");
}
template <int MODE> __device__ __forceinline__ void norm_rows(Frame& F, const float* xin, const float* y, const float* g1, float coef, float* xo, const float* g2, bf16* xn) {
    const int gw = F.vcu * NWAVES + F.wave, NGW = F.G * NWAVES;
    f32x4 gg1[4], gg2[4];
#pragma unroll
    for (int j = 0; j < 4; ++j) { if (MODE != 0) gg1[j] = ((const f32x4*)g1)[F.lane + 64 * j]; if (MODE != 2) gg2[j] = ((const f32x4*)g2)[F.lane + 64 * j]; }
    for (int m = gw; m < M; m += NGW) {
        f32x4 v[4];
#pragma unroll
        for (int j = 0; j < 4; ++j) v[j] = (MODE == 0) ? __builtin_nontemporal_load((const f32x4*)(xin + (size_t)m * D) + F.lane + 64 * j) : ((const f32x4*)(xin + (size_t)m * D))[F.lane + 64 * j];
        if (MODE != 0) {
            f32x4 yy[4]; float s = 0.f;
#pragma unroll
            for (int j = 0; j < 4; ++j) { yy[j] = ((const f32x4*)(y + (size_t)m * D))[F.lane + 64 * j]; s += (yy[j].x * yy[j].x + yy[j].y * yy[j].y) + (yy[j].z * yy[j].z + yy[j].w * yy[j].w); }
            const float rs = coef * __builtin_amdgcn_rsqf(wave_sum(s) * (1.f / D) + NORM_EPS);
#pragma unroll
            for (int j = 0; j < 4; ++j) { v[j] = v[j] + yy[j] * gg1[j] * rs; ((f32x4*)(xo + (size_t)m * D))[F.lane + 64 * j] = v[j]; }
        }
        if (MODE != 2) {
            float s = 0.f;
#pragma unroll
            for (int j = 0; j < 4; ++j) s += (v[j].x * v[j].x + v[j].y * v[j].y) + (v[j].z * v[j].z + v[j].w * v[j].w);
            const float rs = __builtin_amdgcn_rsqf(wave_sum(s) * (1.f / D) + NORM_EPS);
            unsigned long long* o8 = (unsigned long long*)(xn + (size_t)m * D) + F.lane;
#pragma unroll
            for (int j = 0; j < 4; ++j) { const f32x4 o = v[j] * gg2[j] * rs; o8[64 * j] = (unsigned long long)pk2(o.x, o.y) | ((unsigned long long)pk2(o.z, o.w) << 32); }
        }
    }
}
constexpr int P0_I_GU = (D / 64) * (FF / 64), P0_I_DN = (FF / 64) * (D / 64), P0_I_IN = (D / 64) * ((PROJ_W + 63) / 64), P0_I_O = (D / 64) * (D / 64), P0_I_L = 512 / 64, P0_I_G = 3 * (512 / 64);
constexpr int P0_R0 = 2 * P0_I_GU, P0_R1 = P0_R0 + P0_I_DN + P0_I_IN + P0_I_O + 2 * P0_I_L + P0_I_G, P0_R2 = P0_R1 + 2 * P0_I_GU, P0_NITEMS = P0_R2 + P0_I_DN;
__device__ __forceinline__ void p0_convert_range(Frame& F, const Args& A, int first, int last, int gw, int NW) {
    LAS float* scr = (LAS float*)(F.lds + F.wave * 16640);
    const float* const __attribute__((address_space(4)))* KA = (const float* const __attribute__((address_space(4)))*)__builtin_amdgcn_kernarg_segment_ptr();
    bf16* lora = (bf16*)(F.ws + WS_LORA);
    constexpr int I_GU = P0_I_GU, I_DN = P0_I_DN, I_IN = P0_I_IN, I_O = P0_I_O, I_L = P0_I_L;
    auto resolve = [&](int it, P0Job& j) {
        int r = it; j.kind = 0; j.late = false;
        if (r < I_GU) { j.W = KA[3]; j.WT = (bf16*)(F.ws + WS_WGU1); j.K = D; j.N = FF; j.ldk = D; j.kind = 1; j.r = r; return; } r -= I_GU;
        if (r < I_GU) { j.W = KA[4]; j.WT = (bf16*)(F.ws + WS_WGU1); j.K = D; j.N = FF; j.ldk = D; j.kind = 2; j.r = r; return; } r -= I_GU;
        if (r < I_DN) { j.W = KA[5]; j.WT = (bf16*)(F.ws + WS_WD1); j.K = FF; j.N = D; j.ldk = FF; j.r = r; return; } r -= I_DN;
        if (r < I_IN) { j.W = KA[8]; j.WT = (bf16*)(F.ws + WS_WIN); j.K = D; j.N = PROJ_W; j.ldk = D; j.kind = 3; j.r = r; return; } r -= I_IN;
        if (r < I_O) { j.W = KA[10]; j.WT = (bf16*)(F.ws + WS_WO); j.K = D; j.N = D; j.ldk = D; j.r = r; return; } r -= I_O;
        if (r < I_L) { j.W = KA[12]; j.WT = lora; j.K = 64; j.N = 512; j.ldk = 64; j.r = r; return; } r -= I_L;
        if (r < I_L) { j.W = KA[14]; j.WT = lora + 512 * 64; j.K = 64; j.N = 512; j.ldk = 64; j.r = r; return; } r -= I_L;
        if (r < P0_I_G) { j.W = KA[15]; j.WT = lora + 2 * 512 * 64; j.K = 160; j.N = 512; j.ldk = 160; j.r = r; return; } r -= P0_I_G;
        if (r < I_GU) { j.W = KA[28]; j.WT = (bf16*)(F.ws + WS_WGU2); j.K = D; j.N = FF; j.ldk = D; j.kind = 1; j.r = r; j.late = true; return; } r -= I_GU;
        if (r < I_GU) { j.W = KA[29]; j.WT = (bf16*)(F.ws + WS_WGU2); j.K = D; j.N = FF; j.ldk = D; j.kind = 2; j.r = r; j.late = true; return; } r -= I_GU;
        j.W = KA[30]; j.WT = (bf16*)(F.ws + WS_WD2); j.K = FF; j.N = D; j.ldk = FF; j.r = r; j.late = true;
    };
    for (int it = first + gw; it < last; it += 2 * NW) {
        P0Job ja, jb; f32x4 va[16], vb[16]; const bool hasb = it + NW < last;
        resolve(it, ja); p0_load(ja, va, F.lane);
        if (hasb) { resolve(it + NW, jb); p0_load(jb, vb, F.lane); }
        p0_finish(ja, va, scr, F.lane);
        if (hasb) p0_finish(jb, vb, scr, F.lane);
    }
}
__device__ __forceinline__ void p0_prologue(Frame& F, const Args& A) {
    p0_convert_range(F, A, 0, P0_R0, F.vcu * NWAVES + F.wave, F.G * NWAVES);
    {
        GAS v4u* z = (GAS v4u*)(F.ws + WS_WIN + (size_t)SHIFT_COLS * D * 2); const int nz = (PRW - SHIFT_COLS) * D * 2 / 16;
        for (int i = (F.vcu * NWAVES + F.wave) * 64 + F.lane; i < nz; i += F.G * NWAVES * 64) z[i] = (v4u){0u, 0u, 0u, 0u};
    }
    {
        float* PRMw = (float*)(F.ws + WS_PRM); const int gt = (F.vcu * NWAVES + F.wave) * 64 + F.lane, GT = F.G * NWAVES * 64;
        for (int i = gt; i < 1824; i += GT) PRMw[0 + i] = A.in[9][i];
        for (int i = gt; i < 512; i += GT) PRMw[2048 + i] = A.in[11][i];
        for (int i = gt; i < 512; i += GT) PRMw[2560 + i] = A.in[13][i];
        for (int i = gt; i < 512; i += GT) PRMw[3072 + i] = A.in[16][i];
        for (int i = gt; i < 512; i += GT) PRMw[3584 + i] = A.in[17][i];
        for (int i = gt; i < 512; i += GT) PRMw[4096 + i] = A.in[18][i];
        for (int i = gt; i < 512; i += GT) PRMw[4608 + i] = A.in[19][i];
        for (int i = gt; i < 512; i += GT) PRMw[5120 + i] = A.in[20][i];
        for (int i = gt; i < 64; i += GT) PRMw[5632 + i] = A.in[21][i];
        for (int i = gt; i < 64; i += GT) PRMw[5696 + i] = A.in[22][i];
        for (int i = gt; i < 64; i += GT) PRMw[5760 + i] = A.in[23][i];
        for (int i = gt; i < 64; i += GT) PRMw[5824 + i] = A.in[24][i];
        for (int i = gt; i < 128; i += GT) PRMw[5888 + i] = A.in[25][i];
        for (int i = gt; i < 1024; i += GT) PRMw[6144 + i] = A.in[2][i];
        for (int i = gt; i < 1024; i += GT) PRMw[7168 + i] = A.in[6][i];
        for (int i = gt; i < 1024; i += GT) PRMw[8192 + i] = A.in[7][i];
        for (int i = gt; i < 1024; i += GT) PRMw[9216 + i] = A.in[26][i];
        for (int i = gt; i < 1024; i += GT) PRMw[10240 + i] = A.in[27][i];
    }
    norm_rows<0>(F, A.in[0], nullptr, nullptr, 0.f, nullptr, A.in[1], (bf16*)(F.ws + WS_XN));
}

__device__ __forceinline__ f32x4 mm_tile(const LAS unsigned char* X, int ldx, int x0, const LAS unsigned char* Y, int ldy, int y0, int ksteps, f32x4 acc, int fr, int fq) {
    const LAS unsigned char* xp = X + (x0 + fr) * ldx + fq * 16; const LAS unsigned char* yp = Y + (y0 + fr) * ldy + fq * 16;
    for (int k = 0; k < ksteps; ++k) { const bf16x8 a = *(const LAS bf16x8*)(xp + k * 64), b = *(const LAS bf16x8*)(yp + k * 64); acc = __builtin_amdgcn_mfma_f32_16x16x32_bf16(a, b, acc, 0, 0, 0); }
    return acc;
}
__device__ __forceinline__ void st4_lds(LAS unsigned char* p, f32x4 v) { v2u w; w.x = pk2(v[0], v[1]); w.y = pk2(v[2], v[3]); *(LAS v2u*)p = w; }
__device__ __forceinline__ void st4_g(bf16* p, f32x4 v) { v2u w; w.x = pk2(v[0], v[1]); w.y = pk2(v[2], v[3]); *(GAS v2u*)p = w; }
__device__ __forceinline__ f32x4 ld4_lds(const LAS unsigned char* p) { const v2u w = *(const LAS v2u*)p; return (f32x4){bflo(w.x), bfhi(w.x), bflo(w.y), bfhi(w.y)}; }
__device__ __forceinline__ f32x4 ld4_g(const bf16* p) { const v2u w = *(const GAS v2u*)p; return (f32x4){bflo(w.x), bfhi(w.x), bflo(w.y), bfhi(w.y)}; }
constexpr int LD = 144;
__device__ __forceinline__ void st4t_lds(LAS unsigned char* base, int p, int q, f32x4 v) {
    const unsigned w0 = pk2(v[0], v[1]), w1 = pk2(v[2], v[3]);
    *(LAS bf16*)(base + (q + 0) * LD + p * 2) = (bf16)(w0 & 0xffffu); *(LAS bf16*)(base + (q + 1) * LD + p * 2) = (bf16)(w0 >> 16);
    *(LAS bf16*)(base + (q + 2) * LD + p * 2) = (bf16)(w1 & 0xffffu); *(LAS bf16*)(base + (q + 3) * LD + p * 2) = (bf16)(w1 >> 16);
}

#define LBAR() asm volatile("s_waitcnt lgkmcnt(0)\n\ts_barrier" ::: "memory")
__device__ __forceinline__ void lora_load(const bf16* lora, int h, bf16x8 (&wq)[2][9], int w, int fr, int fq) {
#pragma unroll
    for (int q = 0; q < 2; ++q) { const int n0 = 16 * ((2 * w + q) & 3);
        const bf16* wrow = lora + (size_t)(h * 64 + n0 + fr) * 64 + fq * 8; const bf16* arow = wrow + 512 * 64; const bf16* grow = lora + 2 * 512 * 64 + (size_t)(h * 64 + n0 + fr) * 160 + fq * 8;
#pragma unroll
        for (int k = 0; k < 2; ++k) { wq[q][k] = *(const GAS bf16x8*)(wrow + k * 32); wq[q][2 + k] = *(const GAS bf16x8*)(arow + k * 32); }
#pragma unroll
        for (int k = 0; k < 5; ++k) wq[q][4 + k] = *(const GAS bf16x8*)(grow + k * 32); }
}
__device__ __forceinline__ void lora_dma(const bf16* lora, int h, unsigned lds0, int w, int lane) {
    for (int p = w; p < 36; p += NWAVES) {
        const bf16* src; unsigned dst;
        if (p < 16) { const int row = 8 * (p & 7) + (lane >> 3); src = lora + (p >= 8 ? 512 * 64 : 0) + (size_t)(h * 64 + row) * 64 + (lane & 7) * 8; dst = lds0 + L_LWA + p * 1024; }
        else { const int q = p - 16, ks = q >> 2, row = 16 * (q & 3) + (lane >> 2); src = lora + 2 * 512 * 64 + (size_t)(h * 64 + row) * 160 + ks * 32 + (lane & 3) * 8; dst = lds0 + L_LG + q * 1024; }
        attn_body::glds16(src, (unsigned)__builtin_amdgcn_readfirstlane(dst));
    }
}
__device__ __forceinline__ void rwkv_chunk_group(Frame& F, int bc, unsigned long long& tsub) {
#define TSUB(k) do { } while (0)
    const float* PRM = (const float*)(F.ws + WS_PRM);
    LAS unsigned char* L = F.lds;
    const int tid = F.tid, lane = F.lane, w = F.wave, fr = lane & 15, fq = lane >> 4;
    const int b = bc / NCH, c = bc % NCH;
    const int row0 = b * T + c * CH;
    const bf16* P = (const bf16*)(F.ws + WS_PRW);
    const float* mu = (PRM + 0);
    const f32x4 Z4 = (f32x4){0.f, 0.f, 0.f, 0.f};
#pragma unroll 1
    for (int i = 0; i < 5; ++i) { const int qd = tid + 512 * i; const int t = qd / 36, l0 = 8 * (qd % 36);
        if (qd < CH * 36) {
            const size_t off = (size_t)(row0 + t) * PRW + 1536 + l0; const v4u cur = *(const GAS v4u*)(P + off); v4u prv = (v4u){0u, 0u, 0u, 0u}; if (c * CH + t > 0) prv = *(const GAS v4u*)(P + off - PRW);
            const f32x4 m0 = *(const f32x4*)(mu + 1536 + l0), m1 = *(const f32x4*)(mu + 1536 + l0 + 4);
            float x[8];
#pragma unroll
            for (int e = 0; e < 4; ++e) { const unsigned cw = cur[e], pw = prv[e]; const float c0 = bflo(cw), c1 = bfhi(cw), p0 = bflo(pw), p1 = bfhi(pw);
                const float ma = (e < 2) ? m0[2 * e] : m1[2 * e - 4], mb = (e < 2) ? m0[2 * e + 1] : m1[2 * e - 3];
                x[2 * e] = c0 + (p0 - c0) * ma; x[2 * e + 1] = c1 + (p1 - c1) * mb; }
            LAS unsigned char* dst;
            if (l0 < 64) { dst = L + L_XW + t * LD + l0 * 2;
#pragma unroll
                for (int e = 0; e < 8; ++e) x[e] = 1.f - 2.f * __builtin_amdgcn_rcpf(1.f + __expf(2.f * x[e])); }
            else if (l0 < 128) { dst = L + L_XA + t * LD + (l0 - 64) * 2; }
            else { dst = L + L_XG + t * 336 + (l0 - 128) * 2;
#pragma unroll
                for (int e = 0; e < 8; ++e) x[e] = __builtin_amdgcn_rcpf(1.f + __expf(-x[e])); }
            *(LAS v4u*)dst = (v4u){pk2(x[0], x[1]), pk2(x[2], x[3]), pk2(x[4], x[5]), pk2(x[6], x[7])};
        } }
    LBAR();
    bf16x8 xw[2], xa[2], xg[5];
    { const int m0 = 16 * (w >> 1);
#pragma unroll
      for (int k = 0; k < 2; ++k) { xw[k] = *(const LAS bf16x8*)(L + L_XW + (m0 + fr) * LD + fq * 16 + k * 64); xa[k] = *(const LAS bf16x8*)(L + L_XA + (m0 + fr) * LD + fq * 16 + k * 64); }
#pragma unroll
      for (int k = 0; k < 5; ++k) xg[k] = *(const LAS bf16x8*)(L + L_XG + (m0 + fr) * 336 + fq * 16 + k * 64); }
    const int ch = lane, tb = 8 * w;
    bf16 raw[9][3];
    { const bool has = (c * CH + tb > 0);
#pragma unroll
      for (int tt = 0; tt < 9; ++tt) { const size_t off = (size_t)(row0 + tb + tt - 1) * PRW + (F.vcu & (RW_H - 1)) * 64 + ch;
          if (tt > 0 || has) { raw[tt][0] = P[off]; raw[tt][1] = P[off + 512]; raw[tt][2] = P[off + 1024]; } else { raw[tt][0] = 0; raw[tt][1] = 0; raw[tt][2] = 0; } } }
    const bf16* lora = (const bf16*)(F.ws + WS_LORA);
    LBAR();
    const unsigned lds0 = (unsigned)(uintptr_t)L;
    lora_dma(lora, F.vcu & (RW_H - 1), lds0, w, lane);
    TSUB(0);
    for (int hh = 0; hh < RW_H; ++hh) {
    const int h = (hh + F.vcu) & (RW_H - 1), hnext = (hh + 1 + F.vcu) & (RW_H - 1);
    const int item = (b * RW_H + h) * NCH + c;
    {
        asm volatile("s_waitcnt vmcnt(0)" ::: "memory"); LBAR();
        f32x4 aw[2], aa[2], ag[2];
#pragma unroll
        for (int q = 0; q < 2; ++q) { const int n0 = 16 * ((2 * w + q) & 3); aw[q] = Z4; aa[q] = Z4; ag[q] = Z4;
            const LAS unsigned char* wp = L + L_LWA + (n0 + fr) * 128 + fq * 16; const LAS unsigned char* gp = L + L_LG + (n0 + fr) * 64 + fq * 16;
#pragma unroll
            for (int k = 0; k < 2; ++k) { aw[q] = __builtin_amdgcn_mfma_f32_16x16x32_bf16(xw[k], *(const LAS bf16x8*)(wp + k * 64), aw[q], 0, 0, 0); aa[q] = __builtin_amdgcn_mfma_f32_16x16x32_bf16(xa[k], *(const LAS bf16x8*)(wp + 8192 + k * 64), aa[q], 0, 0, 0); }
#pragma unroll
            for (int k = 0; k < 5; ++k) ag[q] = __builtin_amdgcn_mfma_f32_16x16x32_bf16(xg[k], *(const LAS bf16x8*)(gp + k * 4096), ag[q], 0, 0, 0);
        }
        LBAR();
#pragma unroll
        for (int q = 0; q < 2; ++q) { const int tw = 2 * w + q, m0 = 16 * (tw >> 2), n0 = 16 * (tw & 3);
#pragma unroll
            for (int v = 0; v < 4; ++v) { const int t = m0 + 4 * fq + v, cc = n0 + fr;
                *(LAS float*)(L + L_WL + (t * 65 + cc) * 4) = aw[q][v]; *(LAS float*)(L + L_AL + (t * 65 + cc) * 4) = aa[q][v]; *(LAS float*)(L + L_GL + (t * 65 + cc) * 4) = ag[q][v]; } }
        LBAR();
    }
    TSUB(1);
    {
        const int gc = h * 64 + ch;
        const float mur = mu[gc], muk = mu[512 + gc], muv = mu[1024 + gc];
        const float w0 = (PRM + 2048)[gc], a0 = (PRM + 2560)[gc], k_k = (PRM + 3072)[gc], k_a = (PRM + 3584)[gc], r_k = (PRM + 4096)[gc];
        float rr[8], kp[8], vv[8], aa[8], bb[8], ld[8], vbv[8], ggv[8];
        float pr = bf2f(raw[0][0]), pk = bf2f(raw[0][1]), pv = bf2f(raw[0][2]);
        bf16* VBp = (bf16*)(F.ws + WS_VB) + (size_t)item * 4096; bf16* Gp = (bf16*)(F.ws + WS_G) + (size_t)item * 4096;
        float run = 0.f; float kkv[8], icv[8], sq[8], bq[8];
#pragma unroll
        for (int tt = 0; tt < 8; ++tt) { const int t = tb + tt;
            const float cr = bf2f(raw[tt + 1][0]), ck = bf2f(raw[tt + 1][1]), cv = bf2f(raw[tt + 1][2]);
            const float r = cr + (pr - cr) * mur, k = ck + (pk - ck) * muk, v = cv + (pv - cv) * muv; pr = cr; pk = ck; pv = cv;
            const float wl = *(const LAS float*)(L + L_WL + (t * 65 + ch) * 4), al = *(const LAS float*)(L + L_AL + (t * 65 + ch) * 4), gl = *(const LAS float*)(L + L_GL + (t * 65 + ch) * 4);
            const float z = -(w0 + wl); const float sp = fmaxf(z, 0.f) + __logf(1.f + __expf(-fabsf(z)));
            const float lgd = -__expf(-sp - 0.5f);
            const float ic = sigmoidf_(a0 + al);
            const float kv = k * k_k; const float kq = k * (1.f + (ic - 1.f) * k_a);
            kkv[tt] = kv; icv[tt] = ic; sq[tt] = kv * kv; bq[tt] = r * kq * r_k;
            rr[tt] = r; kp[tt] = kq; vv[tt] = v; run += lgd; ld[tt] = run; ggv[tt] = gl;
        }
        wave_sum8(sq); wave_sum8(bq);
#pragma unroll
        for (int tt = 0; tt < 8; ++tt) { const float kn = kkv[tt] * __builtin_amdgcn_rsqf(fmaxf(sq[tt], 1e-24f));
            aa[tt] = -kn; bb[tt] = kn * icv[tt]; vbv[tt] = bq[tt] * vv[tt]; }
        *(LAS float*)(L + L_GT + (w * 64 + ch) * 4) = run;
        *(GAS v4u*)(VBp + ch * 64 + tb) = (v4u){pk2(vbv[0], vbv[1]), pk2(vbv[2], vbv[3]), pk2(vbv[4], vbv[5]), pk2(vbv[6], vbv[7])};
        *(GAS v4u*)(Gp + ch * 64 + tb) = (v4u){pk2(ggv[0], ggv[1]), pk2(ggv[2], ggv[3]), pk2(ggv[4], ggv[5]), pk2(ggv[6], ggv[7])};
        if (hh + 1 < RW_H) {
            const bool has = (c * CH + tb > 0);
#pragma unroll
            for (int tt = 0; tt < 9; ++tt) { const size_t off = (size_t)(row0 + tb + tt - 1) * PRW + hnext * 64 + ch;
                if (tt > 0 || has) { raw[tt][0] = P[off]; raw[tt][1] = P[off + 512]; raw[tt][2] = P[off + 1024]; } }
        }
        LBAR();
        float offs = 0.f, tot = 0.f;
#pragma unroll
        for (int g = 0; g < 8; ++g) { const float x = *(const LAS float*)(L + L_GT + (g * 64 + ch) * 4); if (g < w) offs += x; tot += x; }
        const float etot = __expf(tot);
        if (w == 0) *(LAS float*)(L + L_WC + ch * 4) = etot;
        unsigned patt[4], pvt[4], pbh[4], pkh[4]; float hAt = 0.f, hBh = 0.f, hKh = 0.f;
        float e_ex = __expf(offs);
#pragma unroll
        for (int tt = 0; tt < 8; ++tt) { const int t = tb + tt; const float cl = offs + ld[tt];
            const float e_in = __expf(cl), e_inv = __builtin_amdgcn_rcpf(e_in), e_hat = etot * e_inv;
            const float At = aa[tt] * e_ex, Bt = bb[tt] * e_inv, Kt = kp[tt] * e_inv, Rt = rr[tt] * e_in, Bh = bb[tt] * e_hat, Kh = kp[tt] * e_hat; e_ex = e_in;
            *(LAS bf16*)(L + L_AT + t * LD + ch * 2) = (bf16)f2bf(At); *(LAS bf16*)(L + L_BT + t * LD + ch * 2) = (bf16)f2bf(Bt);
            *(LAS bf16*)(L + L_KT + t * LD + ch * 2) = (bf16)f2bf(Kt); *(LAS bf16*)(L + L_RT + t * LD + ch * 2) = (bf16)f2bf(Rt);
            if (tt & 1) { patt[tt >> 1] = pk2(hAt, At); pvt[tt >> 1] = pk2(vv[tt - 1], vv[tt]); pbh[tt >> 1] = pk2(hBh, Bh); pkh[tt >> 1] = pk2(hKh, Kh); }
            hAt = At; hBh = Bh; hKh = Kh;
        }
        *(LAS v4u*)(L + L_ATT + ch * LD + tb * 2) = (v4u){patt[0], patt[1], patt[2], patt[3]};
        *(LAS v4u*)(L + L_VT + ch * LD + tb * 2) = (v4u){pvt[0], pvt[1], pvt[2], pvt[3]};
        *(LAS v4u*)(L + L_BH + ch * LD + tb * 2) = (v4u){pbh[0], pbh[1], pbh[2], pbh[3]};
        *(LAS v4u*)(L + L_KH + ch * LD + tb * 2) = (v4u){pkh[0], pkh[1], pkh[2], pkh[3]};
        LBAR();
    }
    TSUB(2);
#pragma unroll
    for (int q = 0; q < 2; ++q) { const int tw = 2 * w + q, p0 = 16 * (tw >> 2), q0 = 16 * (tw & 3);
        f32x4 m = mm_tile(L + L_AT, LD, q0, L + L_BT, LD, p0, 2, Z4, fr, fq);
        f32x4 nak = mm_tile(L + L_KT, LD, q0, L + L_AT, LD, p0, 2, Z4, fr, fq);
        f32x4 nrk = mm_tile(L + L_KT, LD, q0, L + L_RT, LD, p0, 2, Z4, fr, fq);
        f32x4 nrb = mm_tile(L + L_BT, LD, q0, L + L_RT, LD, p0, 2, Z4, fr, fq);
        f32x4 tt;
        const int p = p0 + fr;
#pragma unroll
        for (int v = 0; v < 4; ++v) { const int qq = q0 + 4 * fq + v;
            if (!(p < qq)) m[v] = 0.f;
            if (!(qq < p)) nak[v] = 0.f;
            if (!(qq <= p)) { nrk[v] = 0.f; nrb[v] = 0.f; }
            tt[v] = (p == qq) ? 1.f : 0.f; }
        const int o = p * LD + (q0 + 4 * fq) * 2;
        st4_lds(L + L_M + o, m); st4t_lds(L + L_MT, p, q0 + 4 * fq, m); st4_lds(L + L_NAK + o, nak); st4_lds(L + L_NRK + o, nrk); st4_lds(L + L_NRB + o, nrb); st4_lds(L + L_TT + o, tt);
    }
    LBAR();
    TSUB(3);
    for (int it = 0; it < 6; ++it) {
        const int rM = (it & 1) ? L_AT : L_M, rMT = (it & 1) ? L_BT : L_MT, rTT = (it & 1) ? L_KT : L_TT;
        const int wM = (it & 1) ? L_M : L_AT, wMT = (it & 1) ? L_MT : L_BT, wTT = (it & 1) ? L_TT : L_KT;
#pragma unroll
        for (int q = 0; q < 2; ++q) { const int tw = 2 * w + q, p0 = 16 * (tw >> 2), q0 = 16 * (tw & 3); const int o = (p0 + fr) * LD + (q0 + 4 * fq) * 2;
            f32x4 tn = Z4, mn = Z4;
            if (q0 <= p0) { tn = mm_tile(L + rM, LD, q0, L + rTT, LD, p0, 2, ld4_lds(L + rTT + o), fr, fq);
                          }
            if (q0 >= p0 && it < 5) mn = mm_tile(L + rMT, LD, q0, L + rM, LD, p0, 2, Z4, fr, fq);
            st4_lds(L + wTT + o, tn); if (it < 5) { st4_lds(L + wM + o, mn); st4t_lds(L + wMT, p0 + fr, q0 + 4 * fq, mn); } }
        LBAR();
    }
    if (hh + 1 < RW_H) lora_dma(lora, hnext, lds0, w, lane);
    TSUB(4);
#pragma unroll
    for (int q = 0; q < 2; ++q) { const int tw = 2 * w + q, p0 = 16 * (tw >> 2), q0 = 16 * (tw & 3); const int o = (p0 + fr) * LD + (q0 + 4 * fq) * 2;
        const f32x4 ap = mm_tile(L + L_TT, LD, q0, L + L_ATT, LD, p0, 2, Z4, fr, fq);
        const f32x4 w1 = mm_tile(L + L_NAK, LD, q0, L + L_VT, LD, p0, 2, Z4, fr, fq);
        st4_lds(L + L_APT + o, ap); st4_lds(L + L_W1T + o, w1); }
    LBAR();
    {
        bf16* RPp = (bf16*)(F.ws + WS_RP) + (size_t)item * 4096; bf16* PTp = (bf16*)(F.ws + WS_PT) + (size_t)item * 4096;
#pragma unroll
        for (int q = 0; q < 2; ++q) { const int tw = 2 * w + q, p0 = 16 * (tw >> 2), q0 = 16 * (tw & 3); const int p = p0 + fr; const int o = p * LD + (q0 + 4 * fq) * 2;
            const f32x4 u0 = mm_tile(L + L_TT, LD, q0, L + L_W1T, LD, p0, 2, Z4, fr, fq);
            const f32x4 rp = mm_tile(L + L_APT, LD, q0, L + L_NRB, LD, p0, 2, ld4_lds(L + L_RT + o), fr, fq);
            f32x4 pt = mm_tile(L + L_APT, LD, q0, L + L_BH, LD, p0, 2, Z4, fr, fq);
            const float wc = *(const LAS float*)(L + L_WC + p * 4);
#pragma unroll
            for (int v = 0; v < 4; ++v) if (p == q0 + 4 * fq + v) pt[v] += wc;
            st4_lds(L + L_U0T + o, u0);
            st4_g(RPp + p * 64 + q0 + 4 * fq, rp); st4_g(PTp + p * 64 + q0 + 4 * fq, pt); }
    }
    LBAR();
    {
        bf16* Y0p = (bf16*)(F.ws + WS_Y0) + (size_t)item * 4096; bf16* QCp = (bf16*)(F.ws + WS_QC) + (size_t)item * 4096;
#pragma unroll
        for (int q = 0; q < 2; ++q) { const int tw = 2 * w + q, p0 = 16 * (tw >> 2), q0 = 16 * (tw & 3); const int p = p0 + fr;
            f32x4 y0 = mm_tile(L + L_VT, LD, q0, L + L_NRK, LD, p0, 2, Z4, fr, fq);
            y0 = mm_tile(L + L_U0T, LD, q0, L + L_NRB, LD, p0, 2, y0, fr, fq);
            f32x4 qc = mm_tile(L + L_KH, LD, q0, L + L_VT, LD, p0, 2, Z4, fr, fq);
            qc = mm_tile(L + L_BH, LD, q0, L + L_U0T, LD, p0, 2, qc, fr, fq);
            st4_g(Y0p + p * 64 + q0 + 4 * fq, y0); st4_g(QCp + p * 64 + q0 + 4 * fq, qc); }
    }
    LBAR();
    TSUB(5);
    }
#undef TSUB
}
struct ScanOps { bf16x8 pf[2][2]; v2u qi[2]; };
__device__ __forceinline__ void scan_load(const bf16* PT, const bf16* QC, int c, ScanOps& o, int w, int fr, int fq) {
#pragma unroll
    for (int q = 0; q < 2; ++q) { const int tw = 2 * w + q, p0 = 16 * (tw >> 2), q0 = 16 * (tw & 3);
        o.pf[q][0] = *(const GAS bf16x8*)(PT + (size_t)c * 4096 + (q0 + fr) * 64 + fq * 8); o.pf[q][1] = *(const GAS bf16x8*)(PT + (size_t)c * 4096 + (q0 + fr) * 64 + 32 + fq * 8);
        o.qi[q] = *(const GAS v2u*)(QC + (size_t)c * 4096 + (p0 + fr) * 64 + q0 + 4 * fq); }
}
__device__ __forceinline__ void scan_step(LAS unsigned char* L, bf16* S, int c, const ScanOps& o, f32x4 (&acc)[2], int w, int fr, int fq) {
#pragma unroll
    for (int q = 0; q < 2; ++q) { const int tw = 2 * w + q, p0 = 16 * (tw >> 2), q0 = 16 * (tw & 3);
        st4_g(S + (size_t)c * 4096 + (p0 + fr) * 64 + q0 + 4 * fq, acc[q]);
        st4_lds(L + (c & 1) * ARR + (p0 + fr) * LD + (q0 + 4 * fq) * 2, acc[q]); }
    LBAR();
#pragma unroll
    for (int q = 0; q < 2; ++q) { const int tw = 2 * w + q, p0 = 16 * (tw >> 2);
        const LAS unsigned char* sp = L + (c & 1) * ARR + (p0 + fr) * LD + fq * 16;
        const bf16x8 s0 = *(const LAS bf16x8*)sp, s1 = *(const LAS bf16x8*)(sp + 64);
        f32x4 a = (f32x4){bflo(o.qi[q].x), bfhi(o.qi[q].x), bflo(o.qi[q].y), bfhi(o.qi[q].y)};
        a = __builtin_amdgcn_mfma_f32_16x16x32_bf16(o.pf[q][0], s0, a, 0, 0, 0);
        a = __builtin_amdgcn_mfma_f32_16x16x32_bf16(o.pf[q][1], s1, a, 0, 0, 0);
        acc[q] = a; }
}
__device__ __forceinline__ void rwkv_state_scan(Frame& F, int bh) {
    LAS unsigned char* L = F.lds;
    const int lane = F.lane, w = F.wave, fr = lane & 15, fq = lane >> 4;
    const bf16* PT = (const bf16*)(F.ws + WS_PT) + (size_t)bh * NCH * 4096; const bf16* QC = (const bf16*)(F.ws + WS_QC) + (size_t)bh * NCH * 4096;
    bf16* S = (bf16*)(F.ws + WS_S) + (size_t)bh * NCH * 4096;
    f32x4 acc[2]; acc[0] = (f32x4){0.f, 0.f, 0.f, 0.f}; acc[1] = acc[0];
    ScanOps o0, o1, o2, o3;
    scan_load(PT, QC, 0, o0, w, fr, fq); scan_load(PT, QC, 1, o1, w, fr, fq); scan_load(PT, QC, 2, o2, w, fr, fq); scan_load(PT, QC, 3, o3, w, fr, fq);
#pragma unroll 1
    for (int c = 0; c < NCH; c += 4) {
        const int n0 = (c + 4 < NCH) ? c + 4 : c, n1 = (c + 5 < NCH) ? c + 5 : c, n2 = (c + 6 < NCH) ? c + 6 : c, n3 = (c + 7 < NCH) ? c + 7 : c;
        scan_step(L, S, c, o0, acc, w, fr, fq);     scan_load(PT, QC, n0, o0, w, fr, fq);
        scan_step(L, S, c + 1, o1, acc, w, fr, fq); scan_load(PT, QC, n1, o1, w, fr, fq);
        scan_step(L, S, c + 2, o2, acc, w, fr, fq); scan_load(PT, QC, n2, o2, w, fr, fq);
        scan_step(L, S, c + 3, o3, acc, w, fr, fq); scan_load(PT, QC, n3, o3, w, fr, fq);
    }
    LBAR();
}
struct ChunkOutOps { v2u y0[2]; bf16x8 sf[2][2], rf[2][2]; };
__device__ __forceinline__ void chunk_out_load(Frame& F, int item, ChunkOutOps& o, int w, int fr, int fq) {
    const bf16* S = (const bf16*)(F.ws + WS_S) + (size_t)item * 4096; const bf16* RP = (const bf16*)(F.ws + WS_RP) + (size_t)item * 4096; const bf16* Y0 = (const bf16*)(F.ws + WS_Y0) + (size_t)item * 4096;
#pragma unroll
    for (int q = 0; q < 2; ++q) { const int tw = 2 * w + q, p0 = 16 * (tw >> 2), q0 = 16 * (tw & 3);
        o.y0[q] = *(const GAS v2u*)(Y0 + (p0 + fr) * 64 + q0 + 4 * fq);
#pragma unroll
        for (int k = 0; k < 2; ++k) { o.sf[q][k] = *(const GAS bf16x8*)(S + (q0 + fr) * 64 + k * 32 + fq * 8); o.rf[q][k] = *(const GAS bf16x8*)(RP + (p0 + fr) * 64 + k * 32 + fq * 8); } }
}
__device__ __forceinline__ void rwkv_chunk_out_all(Frame& F) {
    const float* PRM = (const float*)(F.ws + WS_PRM);
    LAS unsigned char* L = F.lds;
    const int lane = F.lane, w = F.wave, fr = lane & 15, fq = lane >> 4;
    ChunkOutOps cur, nxt;
    int item = F.vcu;
    if (item < NITEM) chunk_out_load(F, item, cur, w, fr, fq);
    for (; item < NITEM; item += F.G) {
        const int bh = item / NCH, c = item % NCH, b = bh / RW_H, h = bh % RW_H; const int row0 = b * T + c * CH;
        const int ch = lane, gc = h * 64 + ch;
        const bf16* VB = (const bf16*)(F.ws + WS_VB) + (size_t)item * 4096; const bf16* G = (const bf16*)(F.ws + WS_G) + (size_t)item * 4096;
        const v4u vbq = *(const GAS v4u*)(VB + ch * 64 + 8 * w), ggq = *(const GAS v4u*)(G + ch * 64 + 8 * w);
        const int inext = item + F.G;
        if (inext < NITEM) chunk_out_load(F, inext, nxt, w, fr, fq);
#pragma unroll
        for (int q = 0; q < 2; ++q) { const int tw = 2 * w + q, p0 = 16 * (tw >> 2), q0 = 16 * (tw & 3);
            f32x4 a = (f32x4){bflo(cur.y0[q].x), bfhi(cur.y0[q].x), bflo(cur.y0[q].y), bfhi(cur.y0[q].y)};
#pragma unroll
            for (int k = 0; k < 2; ++k) a = __builtin_amdgcn_mfma_f32_16x16x32_bf16(cur.sf[q][k], cur.rf[q][k], a, 0, 0, 0);
#pragma unroll
            for (int v = 0; v < 4; ++v) *(LAS float*)(L + L_YL + ((p0 + fr) * 65 + q0 + 4 * fq + v) * 4) = a[v];
        }
        LBAR();
        {
            const float gw = (PRM + 4608)[gc], gb = (PRM + 5120)[gc];
            bf16* YM = (bf16*)(F.ws + WS_YMIX);
            float yv[8], sm[8], sv[8];
#pragma unroll
            for (int tt = 0; tt < 8; ++tt) { yv[tt] = *(const LAS float*)(L + L_YL + ((8 * w + tt) * 65 + ch) * 4); sm[tt] = yv[tt]; }
            wave_sum8(sm);
#pragma unroll
            for (int tt = 0; tt < 8; ++tt) { yv[tt] -= sm[tt] * (1.f / 64.f); sv[tt] = yv[tt] * yv[tt]; }
            wave_sum8(sv);
#pragma unroll
            for (int tt = 0; tt < 8; ++tt) { const int t = 8 * w + tt;
                const float yn = yv[tt] * __builtin_amdgcn_rsqf(sv[tt] * (1.f / 64.f) + GN_EPS) * gw + gb;
                const float o = (yn + ((tt & 1) ? bfhi(vbq[tt >> 1]) : bflo(vbq[tt >> 1]))) * ((tt & 1) ? bfhi(ggq[tt >> 1]) : bflo(ggq[tt >> 1]));
                YM[(size_t)(row0 + t) * D + gc] = (bf16)f2bf(o); }
        }
        LBAR();
        cur = nxt;
    }
}
__device__ __forceinline__ void diff_post_rows(Frame& F) {
    const float* PRM = (const float*)(F.ws + WS_PRM);
    const int lane = F.lane; const int gw = F.vcu * NWAVES + F.wave, NGW = F.G * NWAVES;
    const float l1 = wave_sum((PRM + 5632)[lane] * (PRM + 5696)[lane]), l2 = wave_sum((PRM + 5760)[lane] * (PRM + 5824)[lane]);
    const float lam = __expf(l1) - __expf(l2) + LAMBDA_INIT;
    const int e0 = 2 * lane, vh = e0 >> 6, d = e0 & 63;
    const float sw0 = (PRM + 5888)[e0] * (1.f - LAMBDA_INIT), sw1 = (PRM + 5888)[e0 + 1] * (1.f - LAMBDA_INIT);
    const bf16* O = (const bf16*)(F.ws + WS_O); bf16* YM = (bf16*)(F.ws + WS_YMIX);
    unsigned c1[2][4], c2[2][4], n1[2][4], n2[2][4];
    int m = gw;
#pragma unroll
    for (int r = 0; r < 2; ++r)
#pragma unroll
        for (int hd = 0; hd < 4; ++hd) { const int mr = m + r * NGW; c1[r][hd] = 0u; c2[r][hd] = 0u;
            if (mr < M) { c1[r][hd] = *(const GAS unsigned*)(O + (size_t)mr * 1024 + (hd * 4 + vh) * 64 + d); c2[r][hd] = *(const GAS unsigned*)(O + (size_t)mr * 1024 + (hd * 4 + 2 + vh) * 64 + d); } }
    for (; m < M; m += 2 * NGW) {
#pragma unroll
        for (int r = 0; r < 2; ++r)
#pragma unroll
            for (int hd = 0; hd < 4; ++hd) { const int mr = m + (2 + r) * NGW; n1[r][hd] = 0u; n2[r][hd] = 0u;
                if (mr < M) { n1[r][hd] = *(const GAS unsigned*)(O + (size_t)mr * 1024 + (hd * 4 + vh) * 64 + d); n2[r][hd] = *(const GAS unsigned*)(O + (size_t)mr * 1024 + (hd * 4 + 2 + vh) * 64 + d); } }
        float o0[8], o1[8], ss[8];
#pragma unroll
        for (int r = 0; r < 2; ++r)
#pragma unroll
            for (int hd = 0; hd < 4; ++hd) { const unsigned w1 = c1[r][hd], w2 = c2[r][hd]; const int k = r * 4 + hd;
                o0[k] = bflo(w1) - lam * bflo(w2); o1[k] = bfhi(w1) - lam * bfhi(w2); ss[k] = o0[k] * o0[k] + o1[k] * o1[k]; }
        wave_sum8(ss);
#pragma unroll
        for (int r = 0; r < 2; ++r) { const int mr = m + r * NGW;
            if (mr < M) {
#pragma unroll
                for (int hd = 0; hd < 4; ++hd) { const int k = r * 4 + hd; const float rs = __builtin_amdgcn_rsqf(ss[k] * (1.f / 128.f) + SUBLN_EPS);
                    *(GAS unsigned*)(YM + (size_t)mr * D + 512 + hd * 128 + e0) = pk2(o0[k] * rs * sw0, o1[k] * rs * sw1); } } }
#pragma unroll
        for (int r = 0; r < 2; ++r)
#pragma unroll
            for (int hd = 0; hd < 4; ++hd) { c1[r][hd] = n1[r][hd]; c2[r][hd] = n2[r][hd]; }
    }
}
__global__ void __launch_bounds__(NWAVES * 64, 2) hybrid_fwd(const Args A) {
    extern __shared__ __attribute__((aligned(16))) unsigned char lds[];
    Frame F;
    F.lds = (LAS unsigned char*)lds;
    F.wave = __builtin_amdgcn_readfirstlane((int)threadIdx.x >> 6); F.lane = lane_id_asm(); F.tid = F.wave * 64 + F.lane;
    F.G = gridDim.x; { const int bx = blockIdx.x; F.vcu = (F.G % 8 == 0) ? (bx % 8) * (F.G / 8) + bx / 8 : bx; }
    F.ws = A.ws; F.ctl = (unsigned*)(A.ws + WS_CTL); F.out = A.out;
    const int lo = A.ph_lo, hi = A.ph_hi;
    cg::grid_group grid = cg::this_grid();
    volatile LAS unsigned* MISC = (volatile LAS unsigned*)(F.lds + L_MISC);
    if (F.tid < 16) MISC[F.tid] = 0u;
    __syncthreads();
    XcdBarrier bar; bar.bar = F.ctl + CW_BAR; bar.x = 0; bar.st = nullptr;
    if (hi - lo > 1) {
        if (blockIdx.x == 0) { GAS v4u* z = (GAS v4u*)(F.ws + WS_CTL); for (int i = F.tid; i < (int)(CTL_ZERO_BYTES / 16); i += NWAVES * 64) if (i < (int)(WS_PRM / 16) || i >= (int)((CW_SEAM * 4) / 16)) z[i] = (v4u){0u, 0u, 0u, 0u}; }
        grid.sync();
        bar = xcd_barrier_post(F.ctl + CW_BAR, MISC + 8, F.wave);
    }
    const float* PRM = (const float*)(F.ws + WS_PRM);
#define IN(k) (lo <= (k) && (k) < hi)
    unsigned long long pt0 = 0;
#define PSTART(k) do { if ((k) == PROBE_PHASE) pt0 = __builtin_amdgcn_s_memrealtime(); } while (0)
#define PEND(k) do { if ((k) == PROBE_PHASE) { const unsigned long long pt1 = __builtin_amdgcn_s_memrealtime(); while (__builtin_amdgcn_s_memrealtime() - pt1 < pt1 - pt0) __builtin_amdgcn_s_sleep(8); xcd_barrier(bar, F.wave); } } while (0)
#define SEAM(k) do { if (hi - lo > 1) { xcd_barrier(bar, F.wave); F.lane = lane_id_asm(); F.tid = F.wave * 64 + F.lane; } } while (0)
    bf16* XN = (bf16*)(F.ws + WS_XN); bf16* ACT = (bf16*)(F.ws + WS_ACT); float* Y = (float*)(F.ws + WS_Y); float* YMo = (float*)(F.ws + WS_YM);

    PSTART(0); if (IN(0)) { for (int rep = 0; rep < REP0; ++rep) p0_prologue(F, A); } SEAM(0); PEND(0);
    PSTART(1); if (IN(1)) for (int rep = 0; rep < REP1; ++rep) { pg8::Gemm g{XN, (const bf16*)(F.ws + WS_WGU1), M, NGU, D}; pg8::StaticOrder S; S.init(M, NGU, F.G, (int)blockIdx.x);
        pg8::EpiSwiGLU E{ACT, FF}; pg8::gemm_phase<pg8::EpiSwiGLU, pg8::StaticOrder, true, true>(F.lds, g, S, E, F.wave);
        if (F.G == 256 && (int)blockIdx.x >= 128) p0_convert_range(F, A, P0_R0, P0_R1, ((int)blockIdx.x - 128) * NWAVES + F.wave, 128 * NWAVES);
        else if (F.G != 256) p0_convert_range(F, A, P0_R0, P0_R1, F.vcu * NWAVES + F.wave, F.G * NWAVES); } SEAM(1); PEND(1);
    PSTART(2); if (IN(2)) for (int rep = 0; rep < REP2; ++rep) { pg8::Gemm g{ACT, (const bf16*)(F.ws + WS_WD1), M, D, FF}; pg8::StaticOrder S; S.init(M, D, F.G, (int)blockIdx.x);
        pg8::PanelRms s1{(float*)(F.ws + WS_X), F.ctl + CW_SEAM, NORM_EPS}, s2{(float*)(F.ws + WS_X) + 65536, F.ctl + CW_SEAM + SEAM_BANK, NORM_EPS};
        pg8::EpiRmsResRms<false> E{A.in[0], (bf16*)F.out, XN, D, PRM + 6144, 0.5f, PRM + 7168, s1, s2};
        pg8::gemm_phase<pg8::EpiRmsResRms<false>, pg8::StaticOrder, false, true>(F.lds, g, S, E, F.wave); } SEAM(2); PEND(2);
    PSTART(4); if (IN(4)) for (int rep = 0; rep < REP4; ++rep) { pg8::Gemm g{XN, (const bf16*)(F.ws + WS_WIN), M, NPW, D}; pg8::StaticOrder S; S.init(M, NPW, F.G, (int)blockIdx.x);
        pg8::EpiP E{(bf16*)(F.ws + WS_PRW), PRW, (bf16*)(F.ws + WS_PDF), PDF}; pg8::gemm_phase<pg8::EpiP, pg8::StaticOrder, true, true>(F.lds, g, S, E, F.wave);
        if (F.G == 256 && (int)blockIdx.x >= 128) p0_convert_range(F, A, P0_R1, P0_R2, ((int)blockIdx.x - 128) * NWAVES + F.wave, 128 * NWAVES);
        else if (F.G != 256) p0_convert_range(F, A, P0_R1, P0_R2, F.vcu * NWAVES + F.wave, F.G * NWAVES); } SEAM(4); PEND(4); for (int rep = 0; rep < REPBAR; ++rep) xcd_barrier(bar, F.wave);
    PSTART(5); if (IN(5)) { for (int rep = 0; rep < REP5; ++rep) { unsigned long long tsub = 0; for (int bc = F.vcu; bc < BATCH * NCH; bc += F.G) rwkv_chunk_group(F, bc, tsub); if (PROBE_SUB >= 0) { const unsigned long long t1 = __builtin_amdgcn_s_memrealtime(); while (__builtin_amdgcn_s_memrealtime() - t1 < tsub) __builtin_amdgcn_s_sleep(8); } } } SEAM(5); PEND(5);
    PSTART(6); if (IN(6)) for (int rep = 0; rep < REP6; ++rep) {
        if ((F.vcu & 7) == 0) for (int rs = 0; rs < REPSCAN; ++rs) rwkv_state_scan(F, F.vcu >> 3);
        LAS unsigned* misc = (LAS unsigned*)(F.lds + L_MISC);
        const attn_body::bf16* Pd = (const attn_body::bf16*)(F.ws + WS_PDF);
        for (;;) {
            if (F.wave == 0 && lane_id_asm() == 0) misc[0] = atomicAdd(F.ctl + CW_QUEUE + 64 * rep, 1u);
            __syncthreads(); const unsigned idx = misc[0]; __syncthreads();
            if (idx >= 1024u) break;
            const int qb = 15 - (int)(idx >> 6), bhv = (int)(idx & 63u);
            attn_body::attn_unit<8>(bhv >> 4, bhv & 15, qb, Pd, Pd, Pd, (attn_body::bf16*)(F.ws + WS_O), (char*)lds, F.wave);
#if REPATT > 1
            attn_body::attn_unit<8>(bhv >> 4, bhv & 15, qb, Pd, Pd, Pd, (attn_body::bf16*)(F.ws + WS_O), (char*)lds, F.wave);
#endif
        }
    } SEAM(6); PEND(6);
    PSTART(7); if (IN(7)) { for (int rep = 0; rep < REP7; ++rep) { rwkv_chunk_out_all(F); diff_post_rows(F); } } SEAM(7); PEND(7);
    PSTART(8); if (IN(8)) { pg8::Gemm g{(const bf16*)(F.ws + WS_YMIX), (const bf16*)(F.ws + WS_WO), M, D, D}; pg8::StaticOrder S; S.init(M, D, F.G, (int)blockIdx.x);
        pg8::PanelRms s1{(float*)(F.ws + WS_X) + 2 * 65536, F.ctl + CW_SEAM + 2 * SEAM_BANK, NORM_EPS}, s2{(float*)(F.ws + WS_X) + 3 * 65536, F.ctl + CW_SEAM + 3 * SEAM_BANK, NORM_EPS};
        pg8::EpiRmsResRms<true> E{(const bf16*)F.out, (bf16*)(F.ws + WS_Y), XN, D, PRM + 8192, 1.0f, PRM + 9216, s1, s2};
        pg8::gemm_phase<pg8::EpiRmsResRms<true>, pg8::StaticOrder, false, true>(F.lds, g, S, E, F.wave); } SEAM(8); PEND(8);
    PSTART(10); if (IN(10)) { pg8::Gemm g{XN, (const bf16*)(F.ws + WS_WGU2), M, NGU, D}; pg8::StaticOrder S; S.init(M, NGU, F.G, (int)blockIdx.x);
        pg8::EpiSwiGLU E{ACT, FF}; pg8::gemm_phase<pg8::EpiSwiGLU, pg8::StaticOrder, true, true>(F.lds, g, S, E, F.wave);
        if (F.G == 256 && (int)blockIdx.x >= 128) p0_convert_range(F, A, P0_R2, P0_NITEMS, ((int)blockIdx.x - 128) * NWAVES + F.wave, 128 * NWAVES);
        else if (F.G != 256) p0_convert_range(F, A, P0_R2, P0_NITEMS, F.vcu * NWAVES + F.wave, F.G * NWAVES); } SEAM(10); PEND(10);
    if (IN(11)) { pg8::Gemm g{ACT, (const bf16*)(F.ws + WS_WD2), M, D, FF}; pg8::StaticOrder S; S.init(M, D, F.G, (int)blockIdx.x);
        pg8::PanelRms s1{(float*)(F.ws + WS_X) + 4 * 65536, F.ctl + CW_SEAM + 4 * SEAM_BANK, NORM_EPS};
        pg8::EpiRmsRes<true> E{(const bf16*)(F.ws + WS_Y), F.out, D, PRM + 10240, 0.5f, s1};
        pg8::gemm_phase<pg8::EpiRmsRes<true>, pg8::StaticOrder, false, true>(F.lds, g, S, E, F.wave); }
#undef IN
#undef SEAM
}

extern "C" void kernel_launch(void* const* d_in, const int* in_sizes, int n_in, void* d_out, int out_size, void* d_ws, size_t ws_size, hipStream_t stream) {
    static int grid = 0;
    if (grid == 0) {
        if (n_in != 31 || in_sizes[0] != M * D || out_size != M * D || ws_size < WS_END) { fprintf(stderr, "kernel_launch: unexpected shapes (n_in %d, in0 %d, out %d, ws %zu); nothing launched\n", n_in, n_in > 0 ? in_sizes[0] : -1, out_size, ws_size); grid = -1; return; }
        int dev = 0, cus = 0, per_cu = 0;
        if (hipGetDevice(&dev) != hipSuccess || hipDeviceGetAttribute(&cus, hipDeviceAttributeMultiprocessorCount, dev) != hipSuccess) { grid = -1; return; }
        if (hipFuncSetAttribute((const void*)hybrid_fwd, hipFuncAttributeMaxDynamicSharedMemorySize, LDS_BYTES) != hipSuccess) { fprintf(stderr, "kernel_launch: hipFuncSetAttribute failed\n"); grid = -1; return; }
        if (hipOccupancyMaxActiveBlocksPerMultiprocessor(&per_cu, (const void*)hybrid_fwd, NWAVES * 64, LDS_BYTES) != hipSuccess || per_cu < 1) { fprintf(stderr, "kernel_launch: occupancy query reports %d workgroups per CU\n", per_cu); per_cu = 1; }
        (void)hipGetLastError();
        grid = cus;
    }
    if (grid < 0) return;
#if MK_PER_PHASE
    (void)hipMemsetAsync((char*)d_ws + WS_CTL, 0, CTL_ZERO_BYTES, stream);
#endif
    Args a{};
    for (int i = 0; i < 31; ++i) a.in[i] = (const float*)d_in[i];
    a.out = (float*)d_out; a.ws = (unsigned char*)d_ws;
#if MK_PER_PHASE
    for (int p = 0; p < N_PHASES; ++p) { a.ph_lo = p; a.ph_hi = p + 1; hipLaunchKernelGGL(hybrid_fwd, dim3(grid), dim3(NWAVES * 64), LDS_BYTES, stream, a); }
#else
    a.ph_lo = 0; a.ph_hi = N_PHASES;
    void* kargs[] = {&a};
    const hipError_t e = hipLaunchCooperativeKernel((const void*)hybrid_fwd, dim3(grid), dim3(NWAVES * 64), kargs, LDS_BYTES, stream);
    if (e != hipSuccess) fprintf(stderr, "kernel_launch: cooperative launch failed: %s (grid %d)\n", hipGetErrorString(e), grid);
#endif
}
```

```cpp
#include <hip/hip_runtime.h>
#include <hip/hip_cooperative_groups.h>
#include <cstdio>
#include <cstdint>
namespace cg = cooperative_groups;
__device__ __forceinline__ int lane_id_asm() { int l; asm volatile("v_mbcnt_lo_u32_b32 %0, -1, 0\n\tv_mbcnt_hi_u32_b32 %0, -1, %0" : "=v"(l)); return l; }
namespace pg8 {
#define PG8_LAS __attribute__((address_space(3)))
typedef unsigned short bf16_t;
typedef short bf16x8 __attribute__((ext_vector_type(8)));
typedef float f32x4 __attribute__((ext_vector_type(4)));
typedef unsigned u32x4 __attribute__((ext_vector_type(4)));
constexpr int BM = 256, BK = 64, HALF = 128, HTB = HALF * BK * 2  , STAGE_BYTES = 8 * HTB, NXCD = 8, WGM = 8;

__host__ __device__ __forceinline__ int lds_byte(int r, int c) { const int st = (r >> 4) * 2 + (c >> 5), rr = r & 15, cc = c & 31, ob = rr * 64 + cc * 2; return st * 1024 + (ob ^ (((ob >> 9) & 1) << 5)); }
__host__ __device__ __forceinline__ void stage_rc(int b, int& R, int& C) { const int st = b / 1024, sb = b % 1024, swz = sb ^ (((sb >> 9) & 1) << 5); R = (st >> 1) * 16 + swz / 64; C = (st & 1) * 32 + (swz % 64) / 2; }
__host__ __device__ __forceinline__ int perm32(int rho) { const int n = rho >> 4, i = rho & 15; return 8 * (i >> 2) + 4 * n + (i & 3); }

struct Unit { int pm, pn; };
struct Gemm { const bf16_t* A; const bf16_t* Bt; int M, N, K; };

struct StaticOrder {
    int nM, nN, nwg, G, c;
    __host__ __device__ void init(int M, int N, int G_, int c_) { nM = M / BM; nN = N / BM; nwg = nM * nN; G = G_; c = c_; }
    __host__ __device__ bool next(int i, Unit& u) const {
        const long L = (long)i * G + c; if (L >= nwg) return false;
        int wgid = (int)L; { const int q = nwg / NXCD, r = nwg % NXCD, xcd = wgid % NXCD, off = wgid / NXCD; wgid = (xcd < r ? xcd * (q + 1) : r * (q + 1) + (xcd - r) * q) + off; }
        const int nig = WGM * nN, gid = wgid / nig, fm = gid * WGM, gsz = (nM - fm) < WGM ? (nM - fm) : WGM;
        u.pm = fm + ((wgid % nig) % gsz); u.pn = (wgid % nig) / gsz; return true;
    }
    __device__ __forceinline__ void a_ready(const Unit&) const {}
    __device__ __forceinline__ void done(const Unit&) const {}
};

__device__ __forceinline__ unsigned cvt_pk_bf16(float lo, float hi) { unsigned r; asm volatile("v_cvt_pk_bf16_f32 %0, %1, %2" : "=v"(r) : "v"(lo), "v"(hi)); return r; }
__device__ __forceinline__ float silu_mul(float g, float u) { return g * __builtin_amdgcn_rcpf(1.0f + __builtin_amdgcn_exp2f(-1.4426950408889634f * g)) * u; }
typedef float f32x2p __attribute__((ext_vector_type(2)));
__device__ __forceinline__ f32x2p silu_mul2(f32x2p g, f32x2p u) {
    const f32x2p t = g * (-1.4426950408889634f); f32x2p e; e.x = __builtin_amdgcn_exp2f(t.x); e.y = __builtin_amdgcn_exp2f(t.y);
    const f32x2p d = e + 1.0f; f32x2p r; r.x = __builtin_amdgcn_rcpf(d.x); r.y = __builtin_amdgcn_rcpf(d.y);
    return (g * u) * r;
}
struct EpiSwiGLU {
    static constexpr bool PERM = true, AFTER_DRAIN = false;
    bf16_t* O; int ldc;
    __device__ __forceinline__ void operator()(const f32x4 (&acc)[2][2][4][2], const Unit& u, int wr, int wc, int fr, int fq) const {
        const int row0 = u.pm * BM + wr * 64 + fr, col0 = u.pn * HALF + wc * 32 + 8 * fq;
#pragma unroll
        for (int ai = 0; ai < 2; ++ai)
#pragma unroll
            for (int m = 0; m < 4; ++m) { bf16_t* rowp = O + (size_t)(row0 + ai * HALF + m * 16) * ldc + col0;
                const f32x4 g0 = acc[ai][0][m][0], g1 = acc[ai][0][m][1], u0 = acc[ai][1][m][0], u1 = acc[ai][1][m][1];
                const f32x2p a = silu_mul2((f32x2p){g0[0], g0[1]}, (f32x2p){u0[0], u0[1]}), b = silu_mul2((f32x2p){g0[2], g0[3]}, (f32x2p){u0[2], u0[3]});
                const f32x2p c = silu_mul2((f32x2p){g1[0], g1[1]}, (f32x2p){u1[0], u1[1]}), d = silu_mul2((f32x2p){g1[2], g1[3]}, (f32x2p){u1[2], u1[3]});
                u32x4 w; w.x = cvt_pk_bf16(a.x, a.y); w.y = cvt_pk_bf16(b.x, b.y); w.z = cvt_pk_bf16(c.x, c.y); w.w = cvt_pk_bf16(d.x, d.y);
                *(u32x4*)rowp = w; }
    }
};
struct EpiF32 {
    static constexpr bool PERM = false, AFTER_DRAIN = false;
    float* O; int ldc;
    __device__ __forceinline__ void operator()(const f32x4 (&acc)[2][2][4][2], const Unit& u, int wr, int wc, int fr, int fq) const {
        const int row0 = u.pm * BM + wr * 64 + fr, col0 = u.pn * BM + wc * 32 + 4 * fq;
#pragma unroll
        for (int ai = 0; ai < 2; ++ai)
#pragma unroll
            for (int m = 0; m < 4; ++m) { float* rowp = O + (size_t)(row0 + ai * HALF + m * 16) * ldc + col0;
#pragma unroll
                for (int bj = 0; bj < 2; ++bj)
#pragma unroll
                    for (int n = 0; n < 2; ++n) *(f32x4*)(rowp + bj * HALF + n * 16) = acc[ai][bj][m][n]; }
    }
};
struct EpiP {
    static constexpr bool PERM = true, AFTER_DRAIN = false;
    bf16_t* O0; int ld0; bf16_t* O1; int ld1;
    __device__ __forceinline__ void operator()(const f32x4 (&acc)[2][2][4][2], const Unit& u, int wr, int wc, int fr, int fq) const {
        const int row0 = u.pm * BM + wr * 64 + fr; const bool first = u.pn < 8;
        bf16_t* base = first ? O0 : O1; const int ldc = first ? ld0 : ld1; const int col0 = (first ? u.pn : u.pn - 8) * BM + wc * 32 + 8 * fq;
#pragma unroll
        for (int ai = 0; ai < 2; ++ai)
#pragma unroll
            for (int m = 0; m < 4; ++m) { bf16_t* rowp = base + (size_t)(row0 + ai * HALF + m * 16) * ldc + col0;
#pragma unroll
                for (int bj = 0; bj < 2; ++bj) { const f32x4 v0 = acc[ai][bj][m][0], v1 = acc[ai][bj][m][1];
                    u32x4 w; w.x = cvt_pk_bf16(v0[0], v0[1]); w.y = cvt_pk_bf16(v0[2], v0[3]); w.z = cvt_pk_bf16(v1[0], v1[1]); w.w = cvt_pk_bf16(v1[2], v1[3]);
                    *(u32x4*)(rowp + bj * HALF) = w; } }
    }
};

struct PanelRms {
    float* xbuf;
    unsigned* cnt;
    float eps;
    __device__ __forceinline__ void run(const f32x4 (&v)[2][2][4][2], const Unit& u, int wr, int wc, int fr, int fq, PG8_LAS unsigned char* lds, int wid, int lane) const {
        PG8_LAS float* P = (PG8_LAS float*)lds;
        PG8_LAS float* S = (PG8_LAS float*)(lds + 8192);
#pragma unroll
        for (int ai = 0; ai < 2; ++ai)
#pragma unroll
            for (int m = 0; m < 4; ++m) {
                float s = 0.f;
#pragma unroll
                for (int bj = 0; bj < 2; ++bj)
#pragma unroll
                    for (int n = 0; n < 2; ++n) { const f32x4 x = v[ai][bj][m][n]; s += (x[0] * x[0] + x[1] * x[1]) + (x[2] * x[2] + x[3] * x[3]); }
                s += __shfl_xor(s, 16); s += __shfl_xor(s, 32);
                if (fq == 0) P[(ai * HALF + wr * 64 + m * 16 + fr) * 4 + wc] = s;
            }
        asm volatile("s_waitcnt lgkmcnt(0)" ::: "memory"); __builtin_amdgcn_s_barrier(); asm volatile("" ::: "memory");
        const int row = wid * 32 + (lane & 31);
        if (lane < 32) {
            const float t = (P[row * 4 + 0] + P[row * 4 + 1]) + (P[row * 4 + 2] + P[row * 4 + 3]);
            __hip_atomic_store(xbuf + ((size_t)(u.pm * BM + row) * 4 + u.pn), t, __ATOMIC_RELAXED, __HIP_MEMORY_SCOPE_AGENT);
        }
        asm volatile("s_waitcnt vmcnt(0)" ::: "memory");
        if (lane == 0) __hip_atomic_fetch_add(cnt + 64 * u.pm, 1u, __ATOMIC_RELAXED, __HIP_MEMORY_SCOPE_AGENT);
        if (wid == 0) {
            unsigned spins = 0;
            for (;;) {
                if ((unsigned)__builtin_amdgcn_readfirstlane(__hip_atomic_load(cnt + 64 * u.pm, __ATOMIC_RELAXED, __HIP_MEMORY_SCOPE_AGENT)) >= 32u) break;
                if (++spins > (1u << 22)) break;
                __builtin_amdgcn_s_sleep(2);
            }
            __builtin_amdgcn_fence(__ATOMIC_ACQUIRE, "agent");
        }
        asm volatile("s_waitcnt vmcnt(0) lgkmcnt(0)" ::: "memory"); __builtin_amdgcn_s_barrier(); asm volatile("" ::: "memory");
        if (lane < 32) {
            const float* slot = xbuf + (size_t)(u.pm * BM + row) * 4; float q = 0.f;
#pragma unroll
            for (int t = 0; t < 4; ++t) q += __hip_atomic_load(slot + t, __ATOMIC_RELAXED, __HIP_MEMORY_SCOPE_AGENT);
            S[row] = __builtin_amdgcn_rsqf(q * (1.0f / 1024.0f) + eps);
        }
        asm volatile("s_waitcnt lgkmcnt(0)" ::: "memory"); __builtin_amdgcn_s_barrier(); asm volatile("" ::: "memory");
    }
};
template <bool BF> __device__ __forceinline__ void ld_res8(const void* base, size_t off, f32x4& a, f32x4& b) {
    if constexpr (BF) { const u32x4 w = __builtin_nontemporal_load((const u32x4*)((const bf16_t*)base + off));
        a = (f32x4){__builtin_bit_cast(float, w.x << 16), __builtin_bit_cast(float, w.x & 0xffff0000u), __builtin_bit_cast(float, w.y << 16), __builtin_bit_cast(float, w.y & 0xffff0000u)};
        b = (f32x4){__builtin_bit_cast(float, w.z << 16), __builtin_bit_cast(float, w.z & 0xffff0000u), __builtin_bit_cast(float, w.w << 16), __builtin_bit_cast(float, w.w & 0xffff0000u)}; }
    else { a = __builtin_nontemporal_load((const f32x4*)((const float*)base + off)); b = __builtin_nontemporal_load((const f32x4*)((const float*)base + off + 4)); }
}
__device__ __forceinline__ u32x4 pack_bf8(f32x4 a, f32x4 b) { u32x4 w; w.x = cvt_pk_bf16(a[0], a[1]); w.y = cvt_pk_bf16(a[2], a[3]); w.z = cvt_pk_bf16(b[0], b[1]); w.w = cvt_pk_bf16(b[2], b[3]); return w; }
template <bool BF> struct EpiRmsRes {
    static constexpr bool PERM = true, AFTER_DRAIN = true;
    const void* base; float* out; int ldc; const float* g1; float coef; PanelRms st;
    __device__ __forceinline__ void fused(f32x4 (&acc)[2][2][4][2], const Unit& u, int wr, int wc, int fr, int fq, PG8_LAS unsigned char* lds, int wid, int lane) const {
        const PG8_LAS float* S = (const PG8_LAS float*)(lds + 8192);
        const int col0 = u.pn * BM + wc * 32 + 8 * fq;
        f32x4 pre[4][2][2];
#pragma unroll
        for (int m = 0; m < 4; ++m) { const size_t off = (size_t)(u.pm * BM + wr * 64 + m * 16 + fr) * ldc + col0;
#pragma unroll
            for (int bj = 0; bj < 2; ++bj) ld_res8<BF>(base, off + bj * HALF, pre[m][bj][0], pre[m][bj][1]); }
        st.run(acc, u, wr, wc, fr, fq, lds, wid, lane);
        f32x4 gv[2][2];
#pragma unroll
        for (int bj = 0; bj < 2; ++bj)
#pragma unroll
            for (int n = 0; n < 2; ++n) gv[bj][n] = *(const f32x4*)(g1 + col0 + bj * HALF + n * 4) * coef;
#pragma unroll
        for (int ai = 0; ai < 2; ++ai)
#pragma unroll
            for (int m = 0; m < 4; ++m) { const int r = ai * HALF + wr * 64 + m * 16 + fr; const float rs = S[r]; const size_t off = (size_t)(u.pm * BM + r) * ldc + col0;
#pragma unroll
                for (int bj = 0; bj < 2; ++bj) { f32x4 b0, b1; if (ai == 0) { b0 = pre[m][bj][0]; b1 = pre[m][bj][1]; } else ld_res8<BF>(base, off + bj * HALF, b0, b1);
                    __builtin_nontemporal_store(b0 + acc[ai][bj][m][0] * gv[bj][0] * rs, (f32x4*)(out + off + bj * HALF));
                    __builtin_nontemporal_store(b1 + acc[ai][bj][m][1] * gv[bj][1] * rs, (f32x4*)(out + off + bj * HALF + 4)); }
                if (m & 1) asm volatile("" ::: "memory"); }
    }
};
template <bool BF> struct EpiRmsResRms {
    static constexpr bool PERM = true, AFTER_DRAIN = true;
    const void* base; bf16_t* out; bf16_t* xn; int ldc; const float* g1; float coef; const float* g2; PanelRms st1, st2;
    __device__ __forceinline__ void fused(f32x4 (&acc)[2][2][4][2], const Unit& u, int wr, int wc, int fr, int fq, PG8_LAS unsigned char* lds, int wid, int lane) const {
        const PG8_LAS float* S = (const PG8_LAS float*)(lds + 8192);
        const int col0 = u.pn * BM + wc * 32 + 8 * fq;
        f32x4 pre[4][2][2];
#pragma unroll
        for (int m = 0; m < 4; ++m) { const size_t off = (size_t)(u.pm * BM + wr * 64 + m * 16 + fr) * ldc + col0;
#pragma unroll
            for (int bj = 0; bj < 2; ++bj) ld_res8<BF>(base, off + bj * HALF, pre[m][bj][0], pre[m][bj][1]); }
        st1.run(acc, u, wr, wc, fr, fq, lds, wid, lane);
        {
            f32x4 gv[2][2];
#pragma unroll
            for (int bj = 0; bj < 2; ++bj)
#pragma unroll
                for (int n = 0; n < 2; ++n) gv[bj][n] = *(const f32x4*)(g1 + col0 + bj * HALF + n * 4) * coef;
#pragma unroll
            for (int ai = 0; ai < 2; ++ai)
#pragma unroll
                for (int m = 0; m < 4; ++m) { const int r = ai * HALF + wr * 64 + m * 16 + fr; const float rs = S[r]; const size_t off = (size_t)(u.pm * BM + r) * ldc + col0;
#pragma unroll
                    for (int bj = 0; bj < 2; ++bj) { f32x4 b0, b1; if (ai == 0) { b0 = pre[m][bj][0]; b1 = pre[m][bj][1]; } else ld_res8<BF>(base, off + bj * HALF, b0, b1);
                        acc[ai][bj][m][0] = b0 + acc[ai][bj][m][0] * gv[bj][0] * rs; acc[ai][bj][m][1] = b1 + acc[ai][bj][m][1] * gv[bj][1] * rs; }
                    asm volatile("" : "+v"(acc[ai][0][m][0]), "+v"(acc[ai][0][m][1]), "+v"(acc[ai][1][m][0]), "+v"(acc[ai][1][m][1]));
                    if (m & 1) asm volatile("" ::: "memory"); }
        }
        st2.run(acc, u, wr, wc, fr, fq, lds, wid, lane);
        f32x4 gv[2][2];
#pragma unroll
        for (int bj = 0; bj < 2; ++bj)
#pragma unroll
            for (int n = 0; n < 2; ++n) gv[bj][n] = *(const f32x4*)(g2 + col0 + bj * HALF + n * 4);
#pragma unroll
        for (int ai = 0; ai < 2; ++ai)
#pragma unroll
            for (int m = 0; m < 4; ++m) { const int r = ai * HALF + wr * 64 + m * 16 + fr; const float rs = S[r]; const size_t off = (size_t)(u.pm * BM + r) * ldc + col0;
#pragma unroll
                for (int bj = 0; bj < 2; ++bj) { const f32x4 x0 = acc[ai][bj][m][0], x1 = acc[ai][bj][m][1];
                    __builtin_nontemporal_store(pack_bf8(x0, x1), (u32x4*)(out + off + bj * HALF));
                    *(u32x4*)(xn + off + bj * HALF) = pack_bf8(x0 * gv[bj][0] * rs, x1 * gv[bj][1] * rs); }
                asm volatile("" ::: "memory"); }
    }
};

template <class Epi, class Sched, bool ALIGN_EPI = false, bool SP2 = false>
__device__ __forceinline__ void gemm_phase(PG8_LAS unsigned char* lds, const Gemm g, const Sched& S, const Epi& E, const int wid) {
    const int lane = lane_id_asm(), tid = wid * 64 + lane, wr = wid >> 2, wc = wid & 3, fr = lane & 15, fq = lane >> 4;
    const int K = g.K, nt = K / BK;
    unsigned voffA[2], voffB[2];
#pragma unroll
    for (int i = 0; i < 2; ++i) { int R, C; stage_rc(tid * 16 + i * 8192, R, C); const int Rb = Epi::PERM ? ((R & ~31) + perm32(R & 31)) : R;
        voffA[i] = (unsigned)(R * K + C) * 2u; voffB[i] = (unsigned)(Rb * K + C) * 2u; }
    const size_t kstep = (size_t)(BK * 2);
    const size_t hstep = (size_t)HALF * K * 2;
    const size_t tstep = 2 * hstep;
    const unsigned ldsw = (unsigned)wid * 1024u;
    const int aoff = lds_byte(wr * 64 + fr, fq * 8), boff = lds_byte(wc * 32 + fr, fq * 8);
#define PG8_SA(b, h) (((b) * 2 + (h)) * HTB)
#define PG8_SB(b, h) ((4 + (b) * 2 + (h)) * HTB)
#define PG8_STAGE(bufoff, gbase, voff) do { _Pragma("unroll") for (int _i = 0; _i < 2; ++_i) \
        __builtin_amdgcn_global_load_lds((const unsigned*)((const char*)(gbase) + (voff)[_i]), (PG8_LAS unsigned*)(lds + (bufoff) + ldsw + _i * 8192), 16, 0, 0); } while (0)
#define PG8_LDA(dst, b, h) do { _Pragma("unroll") for (int m = 0; m < 4; ++m) _Pragma("unroll") for (int k = 0; k < 2; ++k) dst[m][k] = *(const PG8_LAS bf16x8*)(lds + PG8_SA(b, h) + aoff + m * 2048 + k * 1024); } while (0)
#define PG8_LDB(dst, b, h) do { _Pragma("unroll") for (int n = 0; n < 2; ++n) _Pragma("unroll") for (int k = 0; k < 2; ++k) dst[n][k] = *(const PG8_LAS bf16x8*)(lds + PG8_SB(b, h) + boff + n * 2048 + k * 1024); } while (0)
#define PG8_MMA(ai, bj, At, Bt) do { __builtin_amdgcn_s_setprio(1); _Pragma("unroll") for (int m = 0; m < 4; ++m) _Pragma("unroll") for (int n = 0; n < 2; ++n) _Pragma("unroll") for (int k = 0; k < 2; ++k) \
        acc[ai][bj][m][n] = __builtin_amdgcn_mfma_f32_16x16x32_bf16(Bt[n][k], At[m][k], acc[ai][bj][m][n], 0, 0, 0); __builtin_amdgcn_s_setprio(0); } while (0)
#define PG8_WAIT_V(n) asm volatile("s_waitcnt vmcnt(" #n ")" ::: "memory")
#define PG8_WAIT_L(n) asm volatile("s_waitcnt lgkmcnt(" #n ")" ::: "memory")
#define PG8_BAR __builtin_amdgcn_s_barrier()
#define PG8_SCHED __builtin_amdgcn_sched_barrier(0)
    Unit cur, nxt; int ui = 0;
    if (!S.next(0, cur)) return;
    f32x4 acc[2][2][4][2];
#pragma unroll
    for (int a = 0; a < 2; ++a)
#pragma unroll
        for (int b = 0; b < 2; ++b)
#pragma unroll
            for (int m = 0; m < 4; ++m)
#pragma unroll
                for (int n = 0; n < 2; ++n) acc[a][b][m][n] = (f32x4){0.f, 0.f, 0.f, 0.f};
    bf16x8 At[4][2], B0[2][2], B1[2][2];
    const char* cA = (const char*)g.A + (size_t)cur.pm * tstep; const char* cB = (const char*)g.Bt + (size_t)cur.pn * tstep;
    S.a_ready(cur);
    if constexpr (SP2) {
        PG8_STAGE(PG8_SB(0, 0), cB, voffB); PG8_STAGE(PG8_SB(0, 1), cB + hstep, voffB); PG8_STAGE(PG8_SA(0, 0), cA, voffA); PG8_STAGE(PG8_SA(0, 1), cA + hstep, voffA);
        if (wr == 1) PG8_BAR;
        PG8_WAIT_V(2); PG8_BAR;
        PG8_STAGE(PG8_SB(1, 0), cB + kstep, voffB); PG8_STAGE(PG8_SA(1, 0), cA + kstep, voffA); PG8_STAGE(PG8_SB(1, 1), cB + hstep + kstep, voffB);
        PG8_WAIT_V(6); PG8_BAR;
    } else {
        PG8_STAGE(PG8_SB(0, 0), cB, voffB); PG8_STAGE(PG8_SA(0, 0), cA, voffA); PG8_STAGE(PG8_SB(0, 1), cB + hstep, voffB); PG8_STAGE(PG8_SA(0, 1), cA + hstep, voffA);
        if (wr == 1) PG8_BAR;
        PG8_WAIT_V(4); PG8_BAR;
        PG8_STAGE(PG8_SB(1, 0), cB + kstep, voffB); PG8_STAGE(PG8_SA(1, 0), cA + kstep, voffA); PG8_STAGE(PG8_SB(1, 1), cB + hstep + kstep, voffB);
        PG8_WAIT_V(6); PG8_BAR;
    }
    for (;;) {
        const bool has_next = S.next(ui + 1, nxt);
        const char* nA = has_next ? (const char*)g.A + (size_t)nxt.pm * tstep : cA; const char* nB = has_next ? (const char*)g.Bt + (size_t)nxt.pn * tstep : cB;
        for (int t = 0; t < nt; t += 2) {
            const bool last = (t == nt - 2);
            const char* a1 = cA + (size_t)(t + 1) * kstep;
            const char* a2 = last ? nA : cA + (size_t)(t + 2) * kstep; const char* b2 = last ? nB : cB + (size_t)(t + 2) * kstep;
            const char* a3 = a2 + kstep; const char* b3 = b2 + kstep;
            if (last && has_next) S.a_ready(nxt);
            if constexpr (SP2) {
            PG8_LDB(B0, 0, 0); PG8_LDB(B1, 0, 1); PG8_SCHED; PG8_LDA(At, 0, 0); PG8_STAGE(PG8_SA(1, 1), a1 + hstep, voffA);
            PG8_WAIT_V(8); PG8_WAIT_L(0); PG8_BAR; PG8_MMA(0, 0, At, B0); PG8_MMA(0, 1, At, B1); PG8_BAR; PG8_SCHED;
            PG8_LDA(At, 0, 1); PG8_STAGE(PG8_SB(0, 0), b2, voffB); PG8_STAGE(PG8_SB(0, 1), b2 + hstep, voffB); PG8_STAGE(PG8_SA(0, 0), a2, voffA);
            PG8_WAIT_V(8); PG8_WAIT_L(0); PG8_BAR; PG8_MMA(1, 0, At, B0); PG8_MMA(1, 1, At, B1); PG8_BAR; PG8_SCHED;
            PG8_LDB(B0, 1, 0); PG8_LDB(B1, 1, 1); PG8_SCHED; PG8_LDA(At, 1, 0); PG8_STAGE(PG8_SA(0, 1), a2 + hstep, voffA);
            PG8_WAIT_V(8); PG8_WAIT_L(0); PG8_BAR; PG8_MMA(0, 0, At, B0); PG8_MMA(0, 1, At, B1); PG8_BAR; PG8_SCHED;
            PG8_LDA(At, 1, 1); PG8_STAGE(PG8_SB(1, 0), b3, voffB); PG8_STAGE(PG8_SB(1, 1), b3 + hstep, voffB); PG8_STAGE(PG8_SA(1, 0), a3, voffA);
            PG8_WAIT_V(8); PG8_WAIT_L(0); PG8_BAR; PG8_MMA(1, 0, At, B0); PG8_MMA(1, 1, At, B1); PG8_BAR; PG8_SCHED;
            } else {
            PG8_LDB(B0, 0, 0); PG8_SCHED; PG8_LDA(At, 0, 0); PG8_STAGE(PG8_SA(1, 1), a1 + hstep, voffA);
            PG8_WAIT_L(8); PG8_BAR; PG8_WAIT_L(0); PG8_MMA(0, 0, At, B0); PG8_BAR; PG8_SCHED;
            PG8_LDB(B1, 0, 1); PG8_STAGE(PG8_SB(0, 0), b2, voffB);
            PG8_BAR; PG8_WAIT_L(0); PG8_MMA(0, 1, At, B1); PG8_BAR;
            PG8_LDA(At, 0, 1); PG8_STAGE(PG8_SA(0, 0), a2, voffA);
            PG8_BAR; PG8_WAIT_L(0); PG8_MMA(1, 0, At, B0); PG8_BAR; PG8_SCHED;
            PG8_STAGE(PG8_SB(0, 1), b2 + hstep, voffB);
            PG8_WAIT_V(6); PG8_BAR; PG8_MMA(1, 1, At, B1); PG8_BAR;
            PG8_LDB(B0, 1, 0); PG8_SCHED; PG8_LDA(At, 1, 0); PG8_STAGE(PG8_SA(0, 1), a2 + hstep, voffA);
            PG8_WAIT_L(8); PG8_BAR; PG8_WAIT_L(0); PG8_MMA(0, 0, At, B0); PG8_BAR; PG8_SCHED;
            PG8_LDB(B1, 1, 1); PG8_STAGE(PG8_SB(1, 0), b3, voffB);
            PG8_BAR; PG8_WAIT_L(0); PG8_MMA(0, 1, At, B1); PG8_BAR;
            PG8_LDA(At, 1, 1); PG8_STAGE(PG8_SA(1, 0), a3, voffA);
            PG8_BAR; PG8_WAIT_L(0); PG8_MMA(1, 0, At, B0); PG8_BAR; PG8_SCHED;
            PG8_STAGE(PG8_SB(1, 1), b3 + hstep, voffB);
            PG8_WAIT_V(6); PG8_BAR; PG8_MMA(1, 1, At, B1); PG8_BAR;
            }
        }
        if constexpr (ALIGN_EPI) { if (wr == 0) PG8_BAR; }
        if constexpr (!Epi::AFTER_DRAIN) { E(acc, cur, wr, wc, fr, fq); S.done(cur); }
        if (!has_next) break;
#pragma unroll
        for (int a = 0; a < 2; ++a)
#pragma unroll
            for (int b = 0; b < 2; ++b)
#pragma unroll
                for (int m = 0; m < 4; ++m)
#pragma unroll
                    for (int n = 0; n < 2; ++n) acc[a][b][m][n] = (f32x4){0.f, 0.f, 0.f, 0.f};
        cur = nxt; cA = nA; cB = nB; ++ui;
        if constexpr (ALIGN_EPI) { if (wr == 1) PG8_BAR; }
    }
    PG8_WAIT_V(0);
    if constexpr (!ALIGN_EPI) { if (wr == 0) PG8_BAR; }
    PG8_BAR;
    if constexpr (Epi::AFTER_DRAIN) { E.fused(acc, cur, wr, wc, fr, fq, lds, wid, lane); S.done(cur); }
#undef PG8_SA
#undef PG8_SB
#undef PG8_STAGE
#undef PG8_LDA
#undef PG8_LDB
#undef PG8_MMA
#undef PG8_WAIT_V
#undef PG8_WAIT_L
#undef PG8_BAR
#undef PG8_SCHED
}
}
#include <hip/hip_bf16.h>
#include <cmath>
namespace attn_body {
using bf16=__hip_bfloat16;
using bf16x8=__attribute__((ext_vector_type(8)))short;
using s16x4=__attribute__((ext_vector_type(4)))short;
using f32x16=__attribute__((ext_vector_type(16)))float;
using u32x4=__attribute__((ext_vector_type(4)))unsigned;
constexpr int BATCH=4,NHEAD=16,SEQ=4096,D=64,PD=1536,PO=1024;
constexpr int NW=8,QBLK=32,QB=QBLK*NW,KVBLK=64,NQB=SEQ/QB;
constexpr int ATTN_UNIT_ROWS=QB;
__device__ __forceinline__ int crow(int r,int hi){return (r&3)+8*(r>>2)+4*hi;}
#define SBAR() __builtin_amdgcn_sched_barrier(0)
__device__ __forceinline__ void cmask(f32x16&p0,f32x16&p1,int jb,int qrel,int hi){
  const float NEG=-INFINITY; int kb=64*jb+4*hi;
  #pragma unroll
  for(int r=0;r<16;++r){int kv=kb+(r&3)+8*(r>>2); if(kv>qrel)p0[r]=NEG; if(kv+32>qrel)p1[r]=NEG;}
}

constexpr int NSLOT=3, SLOTB=8192;
constexpr int LDS_K=0, LDS_V=NSLOT*SLOTB, LDS_WS=2*NSLOT*SLOTB, LDS_OST=LDS_WS+NW*64*4, LDS_BYTES=LDS_OST+NW*4096;
constexpr float C2=0.125f*1.4426950408889634f;
__device__ __forceinline__ void glds16(const void*gsrc,unsigned lds_dst){unsigned keep;
  asm volatile("s_mov_b32 %0, m0\n\ts_mov_b32 m0, %2\n\ts_nop 0\n\tglobal_load_lds_dwordx4 %1, off\n\ts_mov_b32 m0, %0":"=&s"(keep):"v"(gsrc),"s"(lds_dst):"memory");}
__device__ __forceinline__ float max3f(float a,float b,float c){float r;asm("v_max3_f32 %0, %1, %2, %3":"=v"(r):"v"(a),"v"(b),"v"(c));return r;}
__device__ __forceinline__ float max2f(float a,float b){float r;asm("v_max_f32_e32 %0, %1, %2":"=v"(r):"v"(a),"v"(b));return r;}
__device__ __forceinline__ float fadd_s(float a,float b){float r;asm("v_add_f32_e32 %0, %1, %2":"=v"(r):"v"(a),"v"(b));return r;}
__device__ __forceinline__ float fsub_s(float a,float b){float r;asm("v_sub_f32_e32 %0, %1, %2":"=v"(r):"v"(a),"v"(b));return r;}
typedef float f32x2_t __attribute__((ext_vector_type(2))); typedef __bf16 bf16x2_t __attribute__((ext_vector_type(2)));
__device__ __forceinline__ unsigned cvtpk_s(float lo,float hi){f32x2_t v={lo,hi};bf16x2_t b=__builtin_convertvector(v,bf16x2_t);return __builtin_bit_cast(unsigned,b);}
#define WAIT_BAR(N) asm volatile("s_waitcnt vmcnt(" #N ") lgkmcnt(0)\n\ts_barrier":::"memory")

__device__ __forceinline__ void qkt(f32x16&p0,f32x16&p1,const char*Kslot,const bf16x8*qr,const f32x16&negm,int r32,int hi){
  const char*kb=Kslot+hi*1024+r32*16;
  #pragma unroll
  for(int d0=0;d0<4;++d0){
    const bf16x8 b0=*reinterpret_cast<const bf16x8*>(kb+d0*2048);
    const bf16x8 b1=*reinterpret_cast<const bf16x8*>(kb+d0*2048+512);
    if(d0==0){p0=__builtin_amdgcn_mfma_f32_32x32x16_bf16(b0,qr[0],negm,0,0,0);p1=__builtin_amdgcn_mfma_f32_32x32x16_bf16(b1,qr[0],negm,0,0,0);}
    else{p0=__builtin_amdgcn_mfma_f32_32x32x16_bf16(b0,qr[d0],p0,0,0,0);p1=__builtin_amdgcn_mfma_f32_32x32x16_bf16(b1,qr[d0],p1,0,0,0);}}
}
typedef __attribute__((address_space(3))) const char* lds_cptr;
typedef short v4i16_t __attribute__((ext_vector_type(4)));
__device__ __forceinline__ void kload8(bf16x8*kf,lds_cptr kp){
  kf[0]=*(const __attribute__((address_space(3))) bf16x8*)(kp);      kf[1]=*(const __attribute__((address_space(3))) bf16x8*)(kp+512);
  kf[2]=*(const __attribute__((address_space(3))) bf16x8*)(kp+2048); kf[3]=*(const __attribute__((address_space(3))) bf16x8*)(kp+2560);
  kf[4]=*(const __attribute__((address_space(3))) bf16x8*)(kp+4096); kf[5]=*(const __attribute__((address_space(3))) bf16x8*)(kp+4608);
  kf[6]=*(const __attribute__((address_space(3))) bf16x8*)(kp+6144); kf[7]=*(const __attribute__((address_space(3))) bf16x8*)(kp+6656);
}
__device__ __forceinline__ void kload2(bf16x8*kf,lds_cptr kp,int j){ kf[2*j]=*(const __attribute__((address_space(3))) bf16x8*)(kp+j*2048); kf[2*j+1]=*(const __attribute__((address_space(3))) bf16x8*)(kp+j*2048+512); }
__device__ __forceinline__ s16x4 vtr(lds_cptr p){ return __builtin_bit_cast(s16x4,__builtin_amdgcn_ds_read_tr16_b64_v4i16((__attribute__((address_space(3))) v4i16_t*)p)); }
__device__ __forceinline__ float rowmax(const f32x16&p0,const f32x16&p1){
  float a=max3f(p0[0],p0[1],p1[0]),b=max3f(p0[2],p0[3],p1[1]);a=max3f(a,p1[2],p1[3]);
  #pragma unroll
  for(int r=4;r<16;r+=4){a=max3f(a,p0[r],p0[r+1]);b=max3f(b,p0[r+2],p0[r+3]);a=max3f(a,p1[r],p1[r+1]);b=max3f(b,p1[r+2],p1[r+3]);}
  const float m=max2f(a,b);
  auto rr=__builtin_amdgcn_permlane32_swap(__float_as_uint(m),__float_as_uint(m),false,false);
  return max2f(__uint_as_float(rr[0]),__uint_as_float(rr[1]));
}
__device__ __forceinline__ void pv(f32x16*o,int vb,bf16x8 pa0,bf16x8 pa1,bf16x8 pa2,bf16x8 pa3){
  #pragma unroll
  for(int d0=0;d0<2;++d0){s16x4 lo[4],hi[4];
    #pragma unroll
    for(int ks=0;ks<4;++ks){
      asm volatile("ds_read_b64_tr_b16 %0,%1 offset:%c2":"=&v"(lo[ks]):"v"(vb),"i"(d0*4096+ks*1024):"memory");
      asm volatile("ds_read_b64_tr_b16 %0,%1 offset:%c2":"=&v"(hi[ks]):"v"(vb),"i"(d0*4096+ks*1024+512):"memory");}
    asm volatile("s_waitcnt lgkmcnt(0)":::"memory");SBAR();
    #define PK(k) (bf16x8){lo[k][0],lo[k][1],lo[k][2],lo[k][3],hi[k][0],hi[k][1],hi[k][2],hi[k][3]}
    o[d0]=__builtin_amdgcn_mfma_f32_32x32x16_bf16(pa0,PK(0),o[d0],0,0,0);
    o[d0]=__builtin_amdgcn_mfma_f32_32x32x16_bf16(pa1,PK(1),o[d0],0,0,0);
    o[d0]=__builtin_amdgcn_mfma_f32_32x32x16_bf16(pa2,PK(2),o[d0],0,0,0);
    o[d0]=__builtin_amdgcn_mfma_f32_32x32x16_bf16(pa3,PK(3),o[d0],0,0,0);
    #undef PK
  }
}

#ifndef ATTN_STORE16
#define ATTN_STORE16(p,v) (*(u32x4*)(p)=(v))
#endif
template<int THRL> __device__ __forceinline__ void attn_unit(int b,int h,int qb,const bf16*Q,const bf16*__restrict__ K,const bf16*__restrict__ V,bf16*O,char*shm,const int wid){
  const int lane=lane_id_asm(),tid=wid*64+lane,r32=lane&31,hi=lane>>5;
  const long rowbase=(long)b*SEQ; const int q0=qb*QB;
  const int qcol=(h>>1)*64, kcol=512+(h>>1)*64, vcol=1024+(h>>2)*128+(h&1)*64, ocol=h*64;
  const bf16*Qw=Q+(rowbase+q0+wid*QBLK)*PD+qcol;
  const bf16*Kh=K+rowbase*PD+kcol,*Vh=V+rowbase*PD+vcol;
  const unsigned lds0=(unsigned)(uintptr_t)shm;
  float*wsf=(float*)(shm+LDS_WS)+wid*64;
  const bf16*ksrc=Kh+(long)lane*PD+wid*8;
  const bf16*vsrc=Vh+(long)(16*(wid&3)+(lane>>2))*PD+(wid>>2)*32+(lane&3)*8;
  const unsigned kdst=lds0+LDS_K+wid*1024, vdst=lds0+LDS_V+wid*1024;
  #define DMA_K(t,slot) glds16(ksrc+(long)(t)*KVBLK*PD,(unsigned)__builtin_amdgcn_readfirstlane(kdst+(slot)))
  #define DMA_V(t,slot) glds16(vsrc+(long)(t)*KVBLK*PD,(unsigned)__builtin_amdgcn_readfirstlane(vdst+(slot)))
  const int vb0=(int)(lds0+LDS_V)+((lane>>4)&1)*32+(lane&3)*8+(4*hi+((lane&15)>>2))*64;
  const char*Kbase=shm+LDS_K; bf16x8 kf[8];
  const lds_cptr shm3=(lds_cptr)shm; const lds_cptr kp0=shm3+LDS_K+hi*1024+r32*16; const lds_cptr vp0=shm3+LDS_V+((lane>>4)&1)*32+(lane&3)*8+(4*hi+((lane&15)>>2))*64;
  const int NT=(q0+QB)/KVBLK;
  DMA_K(0,0);DMA_V(0,0);DMA_K(1,SLOTB);
  bf16x8 qr[4];
  #pragma unroll
  for(int d0=0;d0<4;++d0)qr[d0]=*reinterpret_cast<const bf16x8*>(&Qw[(long)r32*PD+d0*16+hi*8]);
  float mhat=0.f,l_reg=0.f;f32x16 o[2];o[0]=f32x16{};o[1]=f32x16{};f32x16 negm=f32x16{};asm volatile("":"+v"(negm));
  const int qrel=wid*QBLK+r32;
  #define CMASK(P0,P1,t) do{int jb_=(t)-(NT-4); if(jb_>=0)cmask(P0,P1,jb_,qrel,hi);}while(0)
  bool resc=false;
  #define START(P0,P1) do{ const float rm=rowmax(P0,P1); resc=false; \
    { const float dl=rm; mhat=fadd_s(mhat,dl); \
      _Pragma("unroll") for(int r=0;r<16;++r){P0[r]=fsub_s(P0[r],dl);P1[r]=fsub_s(P1[r],dl);} \
      _Pragma("unroll") for(int r=0;r<16;++r)negm[r]=-mhat; asm volatile("":"+v"(negm)); } \
    _Pragma("unroll") for(int r=0;r<16;++r)P0[r]=__builtin_amdgcn_exp2f(P0[r]); }while(0)
  #define RESC() do{ if(resc){ asm volatile("s_waitcnt lgkmcnt(0)":::"memory"); \
      _Pragma("unroll") for(int d_=0;d_<2;++d_) _Pragma("unroll") for(int r=0;r<16;++r)o[d_][r]*=wsf[crow(r,hi)]; } }while(0)
  f32x16 pA0,pA1,pB0,pB1;
  int sl_prev=0,sl_cur=0,sl_next=SLOTB;
  #define ROT() do{sl_prev=sl_cur;sl_cur=sl_next;sl_next=(sl_next==(NSLOT-1)*SLOTB)?0:sl_next+SLOTB;}while(0)
  DMA_K(2,2*SLOTB);
  WAIT_BAR(3);
  qkt(pA0,pA1,Kbase,qr,negm,r32,hi);asm volatile("s_nop 15\n\ts_nop 7":"+v"(pA0),"+v"(pA1));CMASK(pA0,pA1,0);
  START(pA0,pA1);
  _Pragma("unroll") for(int r=0;r<16;++r)pA1[r]=__builtin_amdgcn_exp2f(pA1[r]);
  WAIT_BAR(0);
  DMA_K(3,0);DMA_V(1,SLOTB);
  ROT();
  kload8(kf,kp0+sl_cur);
  WAIT_BAR(2);
  s16x4 vlo[8],vhi[8]; u32x4 pw0,pw1,pw2,pw3;
  #define PKW(P,B) cvtpk_s(P[B],P[B+1])
  #define PAF(k) __builtin_bit_cast(bf16x8,pw##k)
  #define VFR(i) (bf16x8){vlo[i][0],vlo[i][1],vlo[i][2],vlo[i][3],vhi[i][0],vhi[i][1],vhi[i][2],vhi[i][3]}
  #define PIN(x) asm volatile("":"+v"(x))
  #define MX3(a,b,c) __builtin_fmaxf(__builtin_fmaxf((a),(b)),(c))
  #define GAPA(MF,A0,A1,A2,A3,W0,W1,PW) do{ MF; sacc+=A0; sacc+=A1; sacc+=A2; sacc+=A3; PIN(sacc); W0; W1; PIN(PW); SBAR(); }while(0)
  #define EX(v) __builtin_amdgcn_exp2f(v)
  #define GAPB(MF,X,B) do{ MF; X[B]=EX(X[B]); X[B+1]=EX(X[B+1]); X[B+2]=EX(X[B+2]); X[B+3]=EX(X[B+3]); PIN(X); SBAR(); }while(0)
  #define VRD(i) do{ vlo[i]=vtr(vp_+(((i)>>2)*4096+((i)&3)*1024)); vhi[i]=vtr(vp_+(((i)>>2)*4096+((i)&3)*1024+512)); }while(0)
  #define KRD(G,j) do{ if(G){ kload2(kf,kp0+sl_next,j); SBAR(); } }while(0)
  #define STEP(C0,C1,P0,P1,t,GK,GV,GL) do{ SBAR(); \
    const lds_cptr vp_=vp0+sl_prev; \
    VRD(0); SBAR(); float sacc=(P0[0]+P0[1]); \
    GAPA(C0=__builtin_amdgcn_mfma_f32_32x32x16_bf16(kf[0],qr[0],negm,0,0,0), P0[2],P0[3],P0[4],P0[5],     pw0[0]=PKW(P0,0), pw0[1]=PKW(P0,2), pw0); \
    VRD(4); SBAR(); GAPA(C1=__builtin_amdgcn_mfma_f32_32x32x16_bf16(kf[1],qr[0],negm,0,0,0), P0[6],P0[7],P0[8],P0[9],     pw0[2]=PKW(P0,4), pw0[3]=PKW(P0,6), pw0); \
    VRD(1); SBAR(); GAPA(C0=__builtin_amdgcn_mfma_f32_32x32x16_bf16(kf[2],qr[1],C0,0,0,0),   P0[10],P0[11],P0[12],P0[13], pw1[0]=PKW(P0,8), pw1[1]=PKW(P0,10), pw1); \
    VRD(5); SBAR(); GAPA(C1=__builtin_amdgcn_mfma_f32_32x32x16_bf16(kf[3],qr[1],C1,0,0,0),   P0[14],P0[15],P1[0],P1[1],   pw1[2]=PKW(P0,12),pw1[3]=PKW(P0,14), pw1); \
    VRD(2); SBAR(); GAPA(C0=__builtin_amdgcn_mfma_f32_32x32x16_bf16(kf[4],qr[2],C0,0,0,0),   P1[2],P1[3],P1[4],P1[5],     pw2[0]=PKW(P1,0), pw2[1]=PKW(P1,2), pw2); \
    VRD(6); SBAR(); GAPA(C1=__builtin_amdgcn_mfma_f32_32x32x16_bf16(kf[5],qr[2],C1,0,0,0),   P1[6],P1[7],P1[8],P1[9],     pw2[2]=PKW(P1,4), pw2[3]=PKW(P1,6), pw2); \
    VRD(3); SBAR(); GAPA(C0=__builtin_amdgcn_mfma_f32_32x32x16_bf16(kf[6],qr[3],C0,0,0,0),   P1[10],P1[11],P1[12],P1[13], pw3[0]=PKW(P1,8), pw3[1]=PKW(P1,10), pw3); \
    VRD(7); SBAR(); GAPA(C1=__builtin_amdgcn_mfma_f32_32x32x16_bf16(kf[7],qr[3],C1,0,0,0),   P1[14],P1[15],0.f,0.f,       pw3[2]=PKW(P1,12),pw3[3]=PKW(P1,14), pw3); \
    l_reg+=sacc; \
    if(GK){DMA_K((t)+3,sl_cur);} if(GV){DMA_V((t)+1,sl_next);} \
    CMASK(C0,C1,t); \
    { float a=MX3(C0[0],C0[1],C1[0]),b=MX3(C0[2],C0[3],C1[1]); a=MX3(a,C1[2],C1[3]); \
      _Pragma("unroll") for(int r=4;r<16;r+=4){a=MX3(a,C0[r],C0[r+1]);b=MX3(b,C0[r+2],C0[r+3]);a=MX3(a,C1[r],C1[r+1]);b=MX3(b,C1[r+2],C1[r+3]);} \
      float rm=__builtin_fmaxf(a,b); { auto rr=__builtin_amdgcn_permlane32_swap(__float_as_uint(rm),__float_as_uint(rm),false,false); rm=__builtin_fmaxf(__uint_as_float(rr[0]),__uint_as_float(rr[1])); } \
      resc=false; \
      if(__builtin_expect(__any(rm>(float)THRL),0)){ const float dl=__builtin_fmaxf(rm,0.f); mhat+=dl; \
        _Pragma("unroll") for(int r=0;r<16;++r){C0[r]-=dl;C1[r]-=dl;} \
        _Pragma("unroll") for(int r=0;r<16;++r)negm[r]=-mhat; asm volatile("":"+v"(negm)); \
        const float f=__builtin_amdgcn_exp2f(-dl); l_reg*=f; if(hi==0)wsf[r32]=f; resc=true; } } \
    SBAR(); \
    GAPB(o[0]=__builtin_amdgcn_mfma_f32_32x32x16_bf16(PAF(0),VFR(0),o[0],0,0,0), C0,0); \
    GAPB(o[1]=__builtin_amdgcn_mfma_f32_32x32x16_bf16(PAF(0),VFR(4),o[1],0,0,0), C0,4); \
    KRD(GL,0); GAPB(o[0]=__builtin_amdgcn_mfma_f32_32x32x16_bf16(PAF(1),VFR(1),o[0],0,0,0), C0,8); \
    KRD(GL,1); GAPB(o[1]=__builtin_amdgcn_mfma_f32_32x32x16_bf16(PAF(1),VFR(5),o[1],0,0,0), C0,12); \
    KRD(GL,2); GAPB(o[0]=__builtin_amdgcn_mfma_f32_32x32x16_bf16(PAF(2),VFR(2),o[0],0,0,0), C1,0); \
    KRD(GL,3); GAPB(o[1]=__builtin_amdgcn_mfma_f32_32x32x16_bf16(PAF(2),VFR(6),o[1],0,0,0), C1,4); \
    GAPB(o[0]=__builtin_amdgcn_mfma_f32_32x32x16_bf16(PAF(3),VFR(3),o[0],0,0,0), C1,8); \
    GAPB(o[1]=__builtin_amdgcn_mfma_f32_32x32x16_bf16(PAF(3),VFR(7),o[1],0,0,0), C1,12); \
    }while(0)
  int t=1;
  #undef CMASK
  #define CMASK(P0,P1,t) do{}while(0)
  for(;t+5<NT;t+=2){
    STEP(pB0,pB1,pA0,pA1,t,true,true,true);     WAIT_BAR(2); RESC(); ROT();
    STEP(pA0,pA1,pB0,pB1,t+1,true,true,true);   WAIT_BAR(2); RESC(); ROT();
  }
  #undef CMASK
  #define CMASK(P0,P1,t) do{int jb_=(t)-(NT-4); if(jb_>=0)cmask(P0,P1,jb_,qrel,hi);}while(0)
  #define ENDW(tt) do{ if((tt)+3<NT){WAIT_BAR(2);} else if((tt)+2<NT){WAIT_BAR(1);} else {WAIT_BAR(0);} }while(0)
  for(;t+1<NT;t+=2){
    STEP(pB0,pB1,pA0,pA1,t,(t+3<NT),(t+1<NT),(t+1<NT));       ENDW(t);   RESC(); ROT();
    STEP(pA0,pA1,pB0,pB1,t+1,(t+4<NT),(t+2<NT),(t+2<NT));     ENDW(t+1); RESC(); ROT();
  }
  STEP(pB0,pB1,pA0,pA1,NT-1,false,false,false); RESC();
  { float sacc=pB0[0]+pB0[1]; _Pragma("unroll") for(int r=2;r<16;++r)sacc+=pB0[r]; _Pragma("unroll") for(int r=0;r<16;++r)sacc+=pB1[r]; l_reg+=sacc;
    pw0=(u32x4){PKW(pB0,0),PKW(pB0,2),PKW(pB0,4),PKW(pB0,6)};pw1=(u32x4){PKW(pB0,8),PKW(pB0,10),PKW(pB0,12),PKW(pB0,14)};pw2=(u32x4){PKW(pB1,0),PKW(pB1,2),PKW(pB1,4),PKW(pB1,6)};pw3=(u32x4){PKW(pB1,8),PKW(pB1,10),PKW(pB1,12),PKW(pB1,14)};
    SBAR(); pv(o,vb0+sl_cur,PAF(0),PAF(1),PAF(2),PAF(3)); }
  #undef PKW
  #undef PAF
  #undef VFR
  #undef PIN
  #undef MX3
  #undef GAPA
  #undef GAPB
  #undef EX
  #undef VRD
  #undef KRD
  #undef STEP
  #undef ENDW
  {auto rr=__builtin_amdgcn_permlane32_swap(__float_as_uint(l_reg),__float_as_uint(l_reg),false,false);l_reg=__uint_as_float(rr[0])+__uint_as_float(rr[1]);}
  if(hi==0)wsf[32+r32]=l_reg;asm volatile("s_waitcnt lgkmcnt(0)":::"memory");
  float rli[16];
  #pragma unroll
  for(int r=0;r<16;++r)rli[r]=__builtin_amdgcn_rcpf(wsf[32+crow(r,hi)]);
  bf16*Ow=O+(rowbase+q0+wid*QBLK)*PO+ocol;
  { bf16*stg=(bf16*)(shm+LDS_OST)+wid*2048;
    #pragma unroll
    for(int r=0;r<16;++r){const int orow=crow(r,hi);
      #pragma unroll
      for(int d0=0;d0<2;++d0)stg[orow*64+d0*32+r32]=__float2bfloat16(o[d0][r]*rli[r]);}
    asm volatile("s_waitcnt lgkmcnt(0)":::"memory");
    #pragma unroll
    for(int i=0;i<4;++i){const int row=i*8+(lane>>3),ch=lane&7; const u32x4 v=*(const u32x4*)(stg+row*64+ch*8); ATTN_STORE16(Ow+(long)row*PO+ch*8,v);} }
  asm volatile("s_waitcnt lgkmcnt(0)\n\ts_barrier":::"memory");
  #undef DMA_K
  #undef DMA_V
  #undef CMASK
  #undef START
  #undef RESC
  #undef ROT
}
constexpr int ATTN_LDS_BYTES=LDS_BYTES;
#undef SBAR
#undef WAIT_BAR
}
constexpr int NWAVES = 8;
constexpr int BATCH = 4, T = 4096, D = 1024, FF = 2816, M = BATCH * T;
constexpr int NGU = 2 * FF;
constexpr int RW_H = 8, RW_N = 64, RW_W = 512;
constexpr int SHIFT_COLS = 1824, PROJ_W = 3360;
constexpr int PRW = 2048, PDF = 1536, NPW = PRW + PDF;
constexpr int CH = 64, NCH = T / CH, NITEM = BATCH * RW_H * NCH;
constexpr float NORM_EPS = 1e-6f, GN_EPS = 64e-5f, SUBLN_EPS = 1e-5f, LAMBDA_INIT = 0.2f;
#ifndef MK_PER_PHASE
#define MK_PER_PHASE 0
#endif
constexpr int N_PHASES = 13;
#ifndef RS01
#define RS01 1
#endif
#ifndef RS2
#define RS2 1
#endif
#ifndef RA1
#define RA1 1
#endif
#ifndef RA3
#define RA3 1
#endif
#ifndef REP1
#define REP1 1
#endif
#ifndef REP4
#define REP4 1
#endif
#ifndef REPBAR
#define REPBAR 0
#endif
#ifndef REPSCAN
#define REPSCAN 1
#endif
#ifndef REPATT
#define REPATT 1
#endif
#ifndef REP2
#define REP2 1
#endif
#ifndef PROBE_PHASE
#define PROBE_PHASE -1
#endif
#ifndef PROBE_SUB
#define PROBE_SUB -1
#endif
#ifndef REP0
#define REP0 1
#endif
#ifndef REP5
#define REP5 1
#endif
#ifndef REP6
#define REP6 1
#endif
#ifndef REP7
#define REP7 1
#endif

constexpr size_t MiB = 1u << 20;
constexpr size_t WS_CTL = 0, CTL_ZERO_BYTES = 262144;
constexpr size_t WS_LORA = 1 * MiB;
constexpr size_t WS_WGU1 = 2 * MiB, WS_WD1 = 13 * MiB, WS_WIN = 19 * MiB, WS_WO = 26 * MiB, WS_WGU2 = 28 * MiB, WS_WD2 = 39 * MiB;
constexpr size_t WS_S = 2 * MiB;
constexpr size_t WS_XN = 48 * MiB;
constexpr size_t WS_PT = 48 * MiB, WS_QC = 64 * MiB;
constexpr size_t WS_ACT = 80 * MiB;
constexpr size_t WS_PRW = 80 * MiB, WS_PDF = 144 * MiB;
constexpr size_t WS_O = 80 * MiB, WS_YMIX = 112 * MiB;
constexpr size_t WS_VB = 192 * MiB, WS_G = 208 * MiB, WS_RP = 224 * MiB, WS_Y0 = 240 * MiB;
constexpr size_t WS_Y = 192 * MiB;
constexpr size_t WS_YM = 144 * MiB;
constexpr size_t WS_X = 45 * MiB;
constexpr int CW_SEAM = 32768, SEAM_BANK = 64 * 64;
constexpr size_t WS_END = 256 * MiB;
constexpr int CW_QUEUE = 64, CW_BAR = 4096;
constexpr size_t WS_PRM = 65536;

constexpr int ARR = 64 * 72 * 2;
constexpr int L_AT = 0, L_BT = ARR, L_KT = 2 * ARR, L_RT = 3 * ARR, L_ATT = 4 * ARR, L_VT = 5 * ARR, L_BH = 6 * ARR, L_KH = 7 * ARR;
constexpr int L_M = 8 * ARR, L_MT = 9 * ARR, L_TT = 10 * ARR, L_NAK = 11 * ARR, L_NRK = 12 * ARR, L_NRB = 13 * ARR;
constexpr int L_APT = L_AT, L_W1T = L_BT, L_U0T = L_KT;
constexpr int L_XW = L_M, L_XA = L_M + ARR, L_XG = L_M + 2 * ARR;
constexpr int FARR = 64 * 65 * 4;
constexpr int L_WL = L_M, L_AL = L_M + FARR, L_GL = L_M + 2 * FARR;
constexpr int L_GT = 14 * ARR;
constexpr int L_WC = L_GT + 2048;
constexpr int LDS_BYTES = 150 * 1024;
constexpr int L_MISC = LDS_BYTES - 256;
static_assert(L_GL + FARR <= L_GT && L_XG + 64 * 168 * 2 <= L_GT && L_WC + 256 <= L_MISC && 8 * 16640 <= L_MISC, "LDS map");
constexpr int L_LWA = L_M, L_LG = L_WC + 256;
static_assert(L_LG + 20480 <= L_MISC && 16384 <= 2 * ARR, "LoRA weight image");
constexpr int L_YL = 0;

#define GAS __attribute__((address_space(1)))
#define LAS __attribute__((address_space(3)))
typedef unsigned short bf16;
typedef unsigned v4u __attribute__((ext_vector_type(4)));
typedef unsigned v2u __attribute__((ext_vector_type(2)));
typedef float f32x4 __attribute__((ext_vector_type(4)));
typedef short bf16x8 __attribute__((ext_vector_type(8)));
#define LDS_WAIT() asm volatile("s_waitcnt lgkmcnt(0)" ::: "memory")
typedef float f32x2_k __attribute__((ext_vector_type(2))); typedef __bf16 bf16x2_k __attribute__((ext_vector_type(2)));
__device__ __forceinline__ unsigned pk2(float lo, float hi) { f32x2_k v = {lo, hi}; bf16x2_k b = __builtin_convertvector(v, bf16x2_k); return __builtin_bit_cast(unsigned, b); }
__device__ __forceinline__ unsigned f2bf(float f) { return pk2(f, 0.f) & 0xffffu; }
__device__ __forceinline__ float bf2f(unsigned short b) { return __builtin_bit_cast(float, (unsigned)b << 16); }
__device__ __forceinline__ float bflo(unsigned w) { return __builtin_bit_cast(float, w << 16); }
__device__ __forceinline__ float bfhi(unsigned w) { return __builtin_bit_cast(float, w & 0xffff0000u); }
__device__ __forceinline__ float dpp_add(float v, const int ctrl_sel) {
    const int x = __builtin_bit_cast(int, v); int y;
    if (ctrl_sel == 0) y = __builtin_amdgcn_update_dpp(0, x, 0xB1, 0xF, 0xF, true);
    else if (ctrl_sel == 1) y = __builtin_amdgcn_update_dpp(0, x, 0x4E, 0xF, 0xF, true);
    else if (ctrl_sel == 2) y = __builtin_amdgcn_update_dpp(0, x, 0x141, 0xF, 0xF, true);
    else y = __builtin_amdgcn_update_dpp(0, x, 0x140, 0xF, 0xF, true);
    return v + __builtin_bit_cast(float, y);
}
__device__ __forceinline__ float wave_sum(float v) {
    v = dpp_add(v, 0); v = dpp_add(v, 1); v = dpp_add(v, 2); v = dpp_add(v, 3);
    { auto rr = __builtin_amdgcn_permlane16_swap(__float_as_uint(v), __float_as_uint(v), false, false); v = __uint_as_float(rr[0]) + __uint_as_float(rr[1]); }
    { auto rr = __builtin_amdgcn_permlane32_swap(__float_as_uint(v), __float_as_uint(v), false, false); v = __uint_as_float(rr[0]) + __uint_as_float(rr[1]); }
    return v;
}
__device__ __forceinline__ float swap32_add(float a, float b) { auto rr = __builtin_amdgcn_permlane32_swap(__float_as_uint(a), __float_as_uint(b), false, false); return __uint_as_float(rr[0]) + __uint_as_float(rr[1]); }
__device__ __forceinline__ float swap16_add(float a, float b) { auto rr = __builtin_amdgcn_permlane16_swap(__float_as_uint(a), __float_as_uint(b), false, false); return __uint_as_float(rr[0]) + __uint_as_float(rr[1]); }
__device__ __forceinline__ void wave_sum8(float (&x)[8]) {
    const float y0 = swap32_add(x[0], x[4]), y1 = swap32_add(x[1], x[5]), y2 = swap32_add(x[2], x[6]), y3 = swap32_add(x[3], x[7]);
    float z0 = swap16_add(y0, y2), z1 = swap16_add(y1, y3);
    z0 = dpp_add(z0, 0); z1 = dpp_add(z1, 0); z0 = dpp_add(z0, 1); z1 = dpp_add(z1, 1); z0 = dpp_add(z0, 2); z1 = dpp_add(z1, 2); z0 = dpp_add(z0, 3); z1 = dpp_add(z1, 3);
    const int i0 = __builtin_bit_cast(int, z0), i1 = __builtin_bit_cast(int, z1);
    x[0] = __builtin_bit_cast(float, __builtin_amdgcn_readlane(i0, 0));  x[2] = __builtin_bit_cast(float, __builtin_amdgcn_readlane(i0, 16));
    x[4] = __builtin_bit_cast(float, __builtin_amdgcn_readlane(i0, 32)); x[6] = __builtin_bit_cast(float, __builtin_amdgcn_readlane(i0, 48));
    x[1] = __builtin_bit_cast(float, __builtin_amdgcn_readlane(i1, 0));  x[3] = __builtin_bit_cast(float, __builtin_amdgcn_readlane(i1, 16));
    x[5] = __builtin_bit_cast(float, __builtin_amdgcn_readlane(i1, 32)); x[7] = __builtin_bit_cast(float, __builtin_amdgcn_readlane(i1, 48));
}
__device__ __forceinline__ float sigmoidf_(float x) { return __builtin_amdgcn_rcpf(1.0f + __expf(-x)); }

typedef GAS unsigned gu32;
#define RLX_AGENT __ATOMIC_RELAXED, __HIP_MEMORY_SCOPE_AGENT
#define XB_TMO      128
#define XB_XCNT(j)  (256  + 64 * (j))
#define XB_XSUB(j)  (1280 + 64 * (j))
#define XB_XGEN(j)  (2304 + 64 * (j))
#define XB_TOP      3328
#define XB_TOPGEN   3392
#define XCD_BAR_WORDS 3456
#define XB_SPIN_CAP (1u << 18)

__device__ __forceinline__ unsigned xb_ld(unsigned* p)              { return __hip_atomic_load(p, __ATOMIC_RELAXED, __HIP_MEMORY_SCOPE_AGENT); }
__device__ __forceinline__ unsigned xb_add(unsigned* p, unsigned v) { return __hip_atomic_fetch_add(p, v, __ATOMIC_RELAXED, __HIP_MEMORY_SCOPE_AGENT); }
__device__ __forceinline__ unsigned xb_xcc_id() { return (unsigned)__builtin_amdgcn_s_getreg((3 << 11) | 20) & 0xFu; }
#define XB_SPIN(cond, bar) do { unsigned _sp = 0; while (cond) { __builtin_amdgcn_s_sleep(1); \
    if ((++_sp & 255u) == 0u) { if (xb_ld(&(bar)[XB_TMO])) break; if (_sp > XB_SPIN_CAP) { atomicAdd(&(bar)[XB_TMO], 1u); break; } } } } while (0)

struct XcdBarrier {
    unsigned* bar; unsigned x;
    volatile LAS unsigned* st;
};

__device__ __forceinline__ XcdBarrier xcd_barrier_post(unsigned* bar, volatile LAS unsigned* st, const int wid) {
    XcdBarrier b; b.bar = bar; b.x = xb_xcc_id(); b.st = st;
    if (wid == 0 && lane_id_asm() == 0) (void)xb_add(&bar[XB_XCNT(b.x)], 1u);
    return b;
}
__device__ __forceinline__ void xcd_barrier_complete(unsigned* bar, unsigned x, unsigned& nloc, unsigned& nx) {
    const unsigned G = gridDim.x * gridDim.y * gridDim.z;
    unsigned sum, cnt, mine, sp = 0u;
    for (;;) {
        sum = 0u; cnt = 0u; mine = 0u;
#pragma unroll
        for (unsigned j = 0; j < 16; ++j) { const unsigned c = xb_ld(&bar[XB_XCNT(j)]); sum += c; cnt += (c > 0u) ? 1u : 0u; mine = (j == x) ? c : mine; }
        if (sum == G) break;
        __builtin_amdgcn_s_sleep(1);
        if ((++sp & 255u) == 0u) { if (xb_ld(&bar[XB_TMO])) break; if (sp > XB_SPIN_CAP) { atomicAdd(&bar[XB_TMO], 1u); break; } }
    }
    nloc = mine > 0u ? mine : 1u; nx = cnt > 0u ? cnt : 1u;
}

__device__ __forceinline__ void xcd_barrier(const XcdBarrier& b, const int wid) {
    asm volatile("s_waitcnt vmcnt(0)" ::: "memory");
    __syncthreads();
    if (wid == 0 && lane_id_asm() == 0) {
        unsigned* bar = b.bar;
        __builtin_amdgcn_s_waitcnt(0);
        unsigned nloc = b.st[0], nx = b.st[1];
        if (nloc == 0u) { xcd_barrier_complete(bar, b.x, nloc, nx); b.st[0] = nloc; b.st[1] = nx; }
        const unsigned old = xb_add(&bar[XB_XSUB(b.x)], 1u);
        const unsigned gen = old / nloc;
        if (old + 1u == (gen + 1u) * nloc) {
            __builtin_amdgcn_fence(__ATOMIC_RELEASE, "agent");
            asm volatile("s_waitcnt vmcnt(0)" ::: "memory");
            const unsigned og = xb_add(&bar[XB_TOP], 1u);
            const unsigned tg = og / nx;
            if (og + 1u == (tg + 1u) * nx) xb_add(&bar[XB_TOPGEN], 1u);
            else XB_SPIN(xb_ld(&bar[XB_TOPGEN]) == tg, bar);
            __builtin_amdgcn_fence(__ATOMIC_ACQUIRE, "agent");
            xb_add(&bar[XB_XGEN(b.x)], 1u);
            asm volatile("s_waitcnt vmcnt(0)" ::: "memory");
        } else {
            XB_SPIN(xb_ld(&bar[XB_XGEN(b.x)]) == gen, bar);
            __builtin_amdgcn_fence(__ATOMIC_ACQUIRE, "agent");
            asm volatile("s_waitcnt vmcnt(0)" ::: "memory");
        }
    }
    __syncthreads();
}

struct Args { const float* in[31]; float* out; unsigned char* ws; int ph_lo, ph_hi; };
struct Frame {
    LAS unsigned char* lds;
    unsigned* ctl;
    int tid, lane, wave, vcu, G;
    float* out; unsigned char* ws;
};

struct P0Job { const float* W; bf16* WT; int K, N, ldk, kind, r; bool late; };
__device__ __forceinline__ void p0_load(const P0Job& j, f32x4 (&v)[16], int lane) {
    const int nblk = (j.N + 63) / 64, kb = j.r / nblk, nb = j.r % nblk, k0 = 64 * kb, n0 = 64 * nb;
    const int r = lane >> 4, c4 = lane & 15; const bool colok = n0 + 4 * c4 < j.N;
#pragma unroll
    for (int i = 0; i < 16; ++i) { const int kk = 4 * i + r; v[i] = (colok && k0 + kk < j.K) ? __builtin_nontemporal_load((const GAS f32x4*)(j.W + (size_t)(k0 + kk) * j.N + n0 + 4 * c4)) : (f32x4){0.f, 0.f, 0.f, 0.f}; }
}
__device__ __forceinline__ int p0_drow(int kind, int n0) {
    if (kind == 1) return 256 * (n0 >> 7) + (n0 & 127);
    if (kind == 2) return 256 * (n0 >> 7) + 128 + (n0 & 127);
    if (kind == 3) return (n0 >= SHIFT_COLS) ? n0 + (PRW - SHIFT_COLS) : n0;
    return n0;
}
__device__ __forceinline__ float p0_scale(int kind, int n0) { return (kind == 3 && n0 >= SHIFT_COLS && n0 < SHIFT_COLS + 512) ? attn_body::C2 : 1.f; }
__device__ __forceinline__ void p0_finish(const P0Job& j, const f32x4 (&v)[16], LAS float* scr, int lane) {
    const int nblk = (j.N + 63) / 64, kb = j.r / nblk, nb = j.r % nblk, k0 = 64 * kb, n0 = 64 * nb;
    const int r = lane >> 4, c4 = lane & 15; const float sc = (c4 < 8) ? p0_scale(j.kind, n0) : p0_scale(j.kind, n0 + 32);
#pragma unroll
    for (int i = 0; i < 16; ++i) { const int kk = 4 * i + r; LAS float* d = scr + kk * 65 + 4 * c4; d[0] = v[i][0] * sc; d[1] = v[i][1] * sc; d[2] = v[i][2] * sc; d[3] = v[i][3] * sc; }
    LDS_WAIT(); asm volatile("" ::: "memory");
    const int c = lane & 7;
#pragma unroll
    for (int hb = 0; hb < 2; ++hb) { const int drow0 = p0_drow(j.kind, n0 + 32 * hb);
        if (n0 + 32 * hb < j.N && k0 + 8 * c < j.K) {
#pragma unroll
            for (int jj = 0; jj < 4; ++jj) { const int n = (lane >> 3) + 8 * jj; const LAS float* sp = scr + (8 * c) * 65 + 32 * hb + n;
                v4u o; o.x = pk2(sp[0 * 65], sp[1 * 65]); o.y = pk2(sp[2 * 65], sp[3 * 65]); o.z = pk2(sp[4 * 65], sp[5 * 65]); o.w = pk2(sp[6 * 65], sp[7 * 65]);
                GAS v4u* dp = (GAS v4u*)(j.WT + (size_t)(drow0 + n) * j.ldk + k0 + 8 * c); if (j.late) __builtin_nontemporal_store(o, dp); else *dp = o; } } }
    LDS_WAIT(); asm volatile("" ::: "memory");
}
template <int MODE> __device__ __forceinline__ void norm_rows(Frame& F, const float* xin, const float* y, const float* g1, float coef, float* xo, const float* g2, bf16* xn) {
    const int gw = F.vcu * NWAVES + F.wave, NGW = F.G * NWAVES;
    f32x4 gg1[4], gg2[4];
#pragma unroll
    for (int j = 0; j < 4; ++j) { if (MODE != 0) gg1[j] = ((const f32x4*)g1)[F.lane + 64 * j]; if (MODE != 2) gg2[j] = ((const f32x4*)g2)[F.lane + 64 * j]; }
    for (int m = gw; m < M; m += NGW) {
        f32x4 v[4];
#pragma unroll
        for (int j = 0; j < 4; ++j) v[j] = (MODE == 0) ? __builtin_nontemporal_load((const f32x4*)(xin + (size_t)m * D) + F.lane + 64 * j) : ((const f32x4*)(xin + (size_t)m * D))[F.lane + 64 * j];
        if (MODE != 0) {
            f32x4 yy[4]; float s = 0.f;
#pragma unroll
            for (int j = 0; j < 4; ++j) { yy[j] = ((const f32x4*)(y + (size_t)m * D))[F.lane + 64 * j]; s += (yy[j].x * yy[j].x + yy[j].y * yy[j].y) + (yy[j].z * yy[j].z + yy[j].w * yy[j].w); }
            const float rs = coef * __builtin_amdgcn_rsqf(wave_sum(s) * (1.f / D) + NORM_EPS);
#pragma unroll
            for (int j = 0; j < 4; ++j) { v[j] = v[j] + yy[j] * gg1[j] * rs; ((f32x4*)(xo + (size_t)m * D))[F.lane + 64 * j] = v[j]; }
        }
        if (MODE != 2) {
            float s = 0.f;
#pragma unroll
            for (int j = 0; j < 4; ++j) s += (v[j].x * v[j].x + v[j].y * v[j].y) + (v[j].z * v[j].z + v[j].w * v[j].w);
            const float rs = __builtin_amdgcn_rsqf(wave_sum(s) * (1.f / D) + NORM_EPS);
            unsigned long long* o8 = (unsigned long long*)(xn + (size_t)m * D) + F.lane;
#pragma unroll
            for (int j = 0; j < 4; ++j) { const f32x4 o = v[j] * gg2[j] * rs; o8[64 * j] = (unsigned long long)pk2(o.x, o.y) | ((unsigned long long)pk2(o.z, o.w) << 32); }
        }
    }
}
constexpr int P0_I_GU = (D / 64) * (FF / 64), P0_I_DN = (FF / 64) * (D / 64), P0_I_IN = (D / 64) * ((PROJ_W + 63) / 64), P0_I_O = (D / 64) * (D / 64), P0_I_L = 512 / 64, P0_I_G = 3 * (512 / 64);
constexpr int P0_R0 = 2 * P0_I_GU, P0_R1 = P0_R0 + P0_I_DN + P0_I_IN + P0_I_O + 2 * P0_I_L + P0_I_G, P0_R2 = P0_R1 + 2 * P0_I_GU, P0_NITEMS = P0_R2 + P0_I_DN;
__device__ __forceinline__ void p0_convert_range(Frame& F, const Args& A, int first, int last, int gw, int NW) {
    LAS float* scr = (LAS float*)(F.lds + F.wave * 16640);
    const float* const __attribute__((address_space(4)))* KA = (const float* const __attribute__((address_space(4)))*)__builtin_amdgcn_kernarg_segment_ptr();
    bf16* lora = (bf16*)(F.ws + WS_LORA);
    constexpr int I_GU = P0_I_GU, I_DN = P0_I_DN, I_IN = P0_I_IN, I_O = P0_I_O, I_L = P0_I_L;
    auto resolve = [&](int it, P0Job& j) {
        int r = it; j.kind = 0; j.late = false;
        if (r < I_GU) { j.W = KA[3]; j.WT = (bf16*)(F.ws + WS_WGU1); j.K = D; j.N = FF; j.ldk = D; j.kind = 1; j.r = r; return; } r -= I_GU;
        if (r < I_GU) { j.W = KA[4]; j.WT = (bf16*)(F.ws + WS_WGU1); j.K = D; j.N = FF; j.ldk = D; j.kind = 2; j.r = r; return; } r -= I_GU;
        if (r < I_DN) { j.W = KA[5]; j.WT = (bf16*)(F.ws + WS_WD1); j.K = FF; j.N = D; j.ldk = FF; j.r = r; return; } r -= I_DN;
        if (r < I_IN) { j.W = KA[8]; j.WT = (bf16*)(F.ws + WS_WIN); j.K = D; j.N = PROJ_W; j.ldk = D; j.kind = 3; j.r = r; return; } r -= I_IN;
        if (r < I_O) { j.W = KA[10]; j.WT = (bf16*)(F.ws + WS_WO); j.K = D; j.N = D; j.ldk = D; j.r = r; return; } r -= I_O;
        if (r < I_L) { j.W = KA[12]; j.WT = lora; j.K = 64; j.N = 512; j.ldk = 64; j.r = r; return; } r -= I_L;
        if (r < I_L) { j.W = KA[14]; j.WT = lora + 512 * 64; j.K = 64; j.N = 512; j.ldk = 64; j.r = r; return; } r -= I_L;
        if (r < P0_I_G) { j.W = KA[15]; j.WT = lora + 2 * 512 * 64; j.K = 160; j.N = 512; j.ldk = 160; j.r = r; return; } r -= P0_I_G;
        if (r < I_GU) { j.W = KA[28]; j.WT = (bf16*)(F.ws + WS_WGU2); j.K = D; j.N = FF; j.ldk = D; j.kind = 1; j.r = r; j.late = true; return; } r -= I_GU;
        if (r < I_GU) { j.W = KA[29]; j.WT = (bf16*)(F.ws + WS_WGU2); j.K = D; j.N = FF; j.ldk = D; j.kind = 2; j.r = r; j.late = true; return; } r -= I_GU;
        j.W = KA[30]; j.WT = (bf16*)(F.ws + WS_WD2); j.K = FF; j.N = D; j.ldk = FF; j.r = r; j.late = true;
    };
    for (int it = first + gw; it < last; it += 2 * NW) {
        P0Job ja, jb; f32x4 va[16], vb[16]; const bool hasb = it + NW < last;
        resolve(it, ja); p0_load(ja, va, F.lane);
        if (hasb) { resolve(it + NW, jb); p0_load(jb, vb, F.lane); }
        p0_finish(ja, va, scr, F.lane);
        if (hasb) p0_finish(jb, vb, scr, F.lane);
    }
}
__device__ __forceinline__ void p0_prologue(Frame& F, const Args& A) {
    p0_convert_range(F, A, 0, P0_R0, F.vcu * NWAVES + F.wave, F.G * NWAVES);
    {
        GAS v4u* z = (GAS v4u*)(F.ws + WS_WIN + (size_t)SHIFT_COLS * D * 2); const int nz = (PRW - SHIFT_COLS) * D * 2 / 16;
        for (int i = (F.vcu * NWAVES + F.wave) * 64 + F.lane; i < nz; i += F.G * NWAVES * 64) z[i] = (v4u){0u, 0u, 0u, 0u};
    }
    {
        float* PRMw = (float*)(F.ws + WS_PRM); const int gt = (F.vcu * NWAVES + F.wave) * 64 + F.lane, GT = F.G * NWAVES * 64;
        for (int i = gt; i < 1824; i += GT) PRMw[0 + i] = A.in[9][i];
        for (int i = gt; i < 512; i += GT) PRMw[2048 + i] = A.in[11][i];
        for (int i = gt; i < 512; i += GT) PRMw[2560 + i] = A.in[13][i];
        for (int i = gt; i < 512; i += GT) PRMw[3072 + i] = A.in[16][i];
        for (int i = gt; i < 512; i += GT) PRMw[3584 + i] = A.in[17][i];
        for (int i = gt; i < 512; i += GT) PRMw[4096 + i] = A.in[18][i];
        for (int i = gt; i < 512; i += GT) PRMw[4608 + i] = A.in[19][i];
        for (int i = gt; i < 512; i += GT) PRMw[5120 + i] = A.in[20][i];
        for (int i = gt; i < 64; i += GT) PRMw[5632 + i] = A.in[21][i];
        for (int i = gt; i < 64; i += GT) PRMw[5696 + i] = A.in[22][i];
        for (int i = gt; i < 64; i += GT) PRMw[5760 + i] = A.in[23][i];
        for (int i = gt; i < 64; i += GT) PRMw[5824 + i] = A.in[24][i];
        for (int i = gt; i < 128; i += GT) PRMw[5888 + i] = A.in[25][i];
        for (int i = gt; i < 1024; i += GT) PRMw[6144 + i] = A.in[2][i];
        for (int i = gt; i < 1024; i += GT) PRMw[7168 + i] = A.in[6][i];
        for (int i = gt; i < 1024; i += GT) PRMw[8192 + i] = A.in[7][i];
        for (int i = gt; i < 1024; i += GT) PRMw[9216 + i] = A.in[26][i];
        for (int i = gt; i < 1024; i += GT) PRMw[10240 + i] = A.in[27][i];
    }
    norm_rows<0>(F, A.in[0], nullptr, nullptr, 0.f, nullptr, A.in[1], (bf16*)(F.ws + WS_XN));
}

__device__ __forceinline__ f32x4 mm_tile(const LAS unsigned char* X, int ldx, int x0, const LAS unsigned char* Y, int ldy, int y0, int ksteps, f32x4 acc, int fr, int fq) {
    const LAS unsigned char* xp = X + (x0 + fr) * ldx + fq * 16; const LAS unsigned char* yp = Y + (y0 + fr) * ldy + fq * 16;
    for (int k = 0; k < ksteps; ++k) { const bf16x8 a = *(const LAS bf16x8*)(xp + k * 64), b = *(const LAS bf16x8*)(yp + k * 64); acc = __builtin_amdgcn_mfma_f32_16x16x32_bf16(a, b, acc, 0, 0, 0); }
    return acc;
}
__device__ __forceinline__ void st4_lds(LAS unsigned char* p, f32x4 v) { v2u w; w.x = pk2(v[0], v[1]); w.y = pk2(v[2], v[3]); *(LAS v2u*)p = w; }
__device__ __forceinline__ void st4_g(bf16* p, f32x4 v) { v2u w; w.x = pk2(v[0], v[1]); w.y = pk2(v[2], v[3]); *(GAS v2u*)p = w; }
__device__ __forceinline__ f32x4 ld4_lds(const LAS unsigned char* p) { const v2u w = *(const LAS v2u*)p; return (f32x4){bflo(w.x), bfhi(w.x), bflo(w.y), bfhi(w.y)}; }
__device__ __forceinline__ f32x4 ld4_g(const bf16* p) { const v2u w = *(const GAS v2u*)p; return (f32x4){bflo(w.x), bfhi(w.x), bflo(w.y), bfhi(w.y)}; }
constexpr int LD = 144;
__device__ __forceinline__ void st4t_lds(LAS unsigned char* base, int p, int q, f32x4 v) {
    const unsigned w0 = pk2(v[0], v[1]), w1 = pk2(v[2], v[3]);
    *(LAS bf16*)(base + (q + 0) * LD + p * 2) = (bf16)(w0 & 0xffffu); *(LAS bf16*)(base + (q + 1) * LD + p * 2) = (bf16)(w0 >> 16);
    *(LAS bf16*)(base + (q + 2) * LD + p * 2) = (bf16)(w1 & 0xffffu); *(LAS bf16*)(base + (q + 3) * LD + p * 2) = (bf16)(w1 >> 16);
}

#define LBAR() asm volatile("s_waitcnt lgkmcnt(0)\n\ts_barrier" ::: "memory")
__device__ __forceinline__ void lora_load(const bf16* lora, int h, bf16x8 (&wq)[2][9], int w, int fr, int fq) {
#pragma unroll
    for (int q = 0; q < 2; ++q) { const int n0 = 16 * ((2 * w + q) & 3);
        const bf16* wrow = lora + (size_t)(h * 64 + n0 + fr) * 64 + fq * 8; const bf16* arow = wrow + 512 * 64; const bf16* grow = lora + 2 * 512 * 64 + (size_t)(h * 64 + n0 + fr) * 160 + fq * 8;
#pragma unroll
        for (int k = 0; k < 2; ++k) { wq[q][k] = *(const GAS bf16x8*)(wrow + k * 32); wq[q][2 + k] = *(const GAS bf16x8*)(arow + k * 32); }
#pragma unroll
        for (int k = 0; k < 5; ++k) wq[q][4 + k] = *(const GAS bf16x8*)(grow + k * 32); }
}
__device__ __forceinline__ void lora_dma(const bf16* lora, int h, unsigned lds0, int w, int lane) {
    for (int p = w; p < 36; p += NWAVES) {
        const bf16* src; unsigned dst;
        if (p < 16) { const int row = 8 * (p & 7) + (lane >> 3); src = lora + (p >= 8 ? 512 * 64 : 0) + (size_t)(h * 64 + row) * 64 + (lane & 7) * 8; dst = lds0 + L_LWA + p * 1024; }
        else { const int q = p - 16, ks = q >> 2, row = 16 * (q & 3) + (lane >> 2); src = lora + 2 * 512 * 64 + (size_t)(h * 64 + row) * 160 + ks * 32 + (lane & 3) * 8; dst = lds0 + L_LG + q * 1024; }
        attn_body::glds16(src, (unsigned)__builtin_amdgcn_readfirstlane(dst));
    }
}
__device__ __forceinline__ void rwkv_chunk_group(Frame& F, int bc, unsigned long long& tsub) {
#define TSUB(k) do { } while (0)
    const float* PRM = (const float*)(F.ws + WS_PRM);
    LAS unsigned char* L = F.lds;
    const int tid = F.tid, lane = F.lane, w = F.wave, fr = lane & 15, fq = lane >> 4;
    const int b = bc / NCH, c = bc % NCH;
    const int row0 = b * T + c * CH;
    const bf16* P = (const bf16*)(F.ws + WS_PRW);
    const float* mu = (PRM + 0);
    const f32x4 Z4 = (f32x4){0.f, 0.f, 0.f, 0.f};
#pragma unroll 1
    for (int i = 0; i < 5; ++i) { const int qd = tid + 512 * i; const int t = qd / 36, l0 = 8 * (qd % 36);
        if (qd < CH * 36) {
            const size_t off = (size_t)(row0 + t) * PRW + 1536 + l0; const v4u cur = *(const GAS v4u*)(P + off); v4u prv = (v4u){0u, 0u, 0u, 0u}; if (c * CH + t > 0) prv = *(const GAS v4u*)(P + off - PRW);
            const f32x4 m0 = *(const f32x4*)(mu + 1536 + l0), m1 = *(const f32x4*)(mu + 1536 + l0 + 4);
            float x[8];
#pragma unroll
            for (int e = 0; e < 4; ++e) { const unsigned cw = cur[e], pw = prv[e]; const float c0 = bflo(cw), c1 = bfhi(cw), p0 = bflo(pw), p1 = bfhi(pw);
                const float ma = (e < 2) ? m0[2 * e] : m1[2 * e - 4], mb = (e < 2) ? m0[2 * e + 1] : m1[2 * e - 3];
                x[2 * e] = c0 + (p0 - c0) * ma; x[2 * e + 1] = c1 + (p1 - c1) * mb; }
            LAS unsigned char* dst;
            if (l0 < 64) { dst = L + L_XW + t * LD + l0 * 2;
#pragma unroll
                for (int e = 0; e < 8; ++e) x[e] = 1.f - 2.f * __builtin_amdgcn_rcpf(1.f + __expf(2.f * x[e])); }
            else if (l0 < 128) { dst = L + L_XA + t * LD + (l0 - 64) * 2; }
            else { dst = L + L_XG + t * 336 + (l0 - 128) * 2;
#pragma unroll
                for (int e = 0; e < 8; ++e) x[e] = __builtin_amdgcn_rcpf(1.f + __expf(-x[e])); }
            *(LAS v4u*)dst = (v4u){pk2(x[0], x[1]), pk2(x[2], x[3]), pk2(x[4], x[5]), pk2(x[6], x[7])};
        } }
    LBAR();
    bf16x8 xw[2], xa[2], xg[5];
    { const int m0 = 16 * (w >> 1);
#pragma unroll
      for (int k = 0; k < 2; ++k) { xw[k] = *(const LAS bf16x8*)(L + L_XW + (m0 + fr) * LD + fq * 16 + k * 64); xa[k] = *(const LAS bf16x8*)(L + L_XA + (m0 + fr) * LD + fq * 16 + k * 64); }
#pragma unroll
      for (int k = 0; k < 5; ++k) xg[k] = *(const LAS bf16x8*)(L + L_XG + (m0 + fr) * 336 + fq * 16 + k * 64); }
    const int ch = lane, tb = 8 * w;
    bf16 raw[9][3];
    { const bool has = (c * CH + tb > 0);
#pragma unroll
      for (int tt = 0; tt < 9; ++tt) { const size_t off = (size_t)(row0 + tb + tt - 1) * PRW + (F.vcu & (RW_H - 1)) * 64 + ch;
          if (tt > 0 || has) { raw[tt][0] = P[off]; raw[tt][1] = P[off + 512]; raw[tt][2] = P[off + 1024]; } else { raw[tt][0] = 0; raw[tt][1] = 0; raw[tt][2] = 0; } } }
    const bf16* lora = (const bf16*)(F.ws + WS_LORA);
    LBAR();
    const unsigned lds0 = (unsigned)(uintptr_t)L;
    lora_dma(lora, F.vcu & (RW_H - 1), lds0, w, lane);
    TSUB(0);
    for (int hh = 0; hh < RW_H; ++hh) {
    const int h = (hh + F.vcu) & (RW_H - 1), hnext = (hh + 1 + F.vcu) & (RW_H - 1);
    const int item = (b * RW_H + h) * NCH + c;
    {
        asm volatile("s_waitcnt vmcnt(0)" ::: "memory"); LBAR();
        f32x4 aw[2], aa[2], ag[2];
#pragma unroll
        for (int q = 0; q < 2; ++q) { const int n0 = 16 * ((2 * w + q) & 3); aw[q] = Z4; aa[q] = Z4; ag[q] = Z4;
            const LAS unsigned char* wp = L + L_LWA + (n0 + fr) * 128 + fq * 16; const LAS unsigned char* gp = L + L_LG + (n0 + fr) * 64 + fq * 16;
#pragma unroll
            for (int k = 0; k < 2; ++k) { aw[q] = __builtin_amdgcn_mfma_f32_16x16x32_bf16(xw[k], *(const LAS bf16x8*)(wp + k * 64), aw[q], 0, 0, 0); aa[q] = __builtin_amdgcn_mfma_f32_16x16x32_bf16(xa[k], *(const LAS bf16x8*)(wp + 8192 + k * 64), aa[q], 0, 0, 0); }
#pragma unroll
            for (int k = 0; k < 5; ++k) ag[q] = __builtin_amdgcn_mfma_f32_16x16x32_bf16(xg[k], *(const LAS bf16x8*)(gp + k * 4096), ag[q], 0, 0, 0);
        }
        LBAR();
#pragma unroll
        for (int q = 0; q < 2; ++q) { const int tw = 2 * w + q, m0 = 16 * (tw >> 2), n0 = 16 * (tw & 3);
#pragma unroll
            for (int v = 0; v < 4; ++v) { const int t = m0 + 4 * fq + v, cc = n0 + fr;
                *(LAS float*)(L + L_WL + (t * 65 + cc) * 4) = aw[q][v]; *(LAS float*)(L + L_AL + (t * 65 + cc) * 4) = aa[q][v]; *(LAS float*)(L + L_GL + (t * 65 + cc) * 4) = ag[q][v]; } }
        LBAR();
    }
    TSUB(1);
    {
        const int gc = h * 64 + ch;
        const float mur = mu[gc], muk = mu[512 + gc], muv = mu[1024 + gc];
        const float w0 = (PRM + 2048)[gc], a0 = (PRM + 2560)[gc], k_k = (PRM + 3072)[gc], k_a = (PRM + 3584)[gc], r_k = (PRM + 4096)[gc];
        float rr[8], kp[8], vv[8], aa[8], bb[8], ld[8], vbv[8], ggv[8];
        float pr = bf2f(raw[0][0]), pk = bf2f(raw[0][1]), pv = bf2f(raw[0][2]);
        bf16* VBp = (bf16*)(F.ws + WS_VB) + (size_t)item * 4096; bf16* Gp = (bf16*)(F.ws + WS_G) + (size_t)item * 4096;
        float run = 0.f; float kkv[8], icv[8], sq[8], bq[8];
#pragma unroll
        for (int tt = 0; tt < 8; ++tt) { const int t = tb + tt;
            const float cr = bf2f(raw[tt + 1][0]), ck = bf2f(raw[tt + 1][1]), cv = bf2f(raw[tt + 1][2]);
            const float r = cr + (pr - cr) * mur, k = ck + (pk - ck) * muk, v = cv + (pv - cv) * muv; pr = cr; pk = ck; pv = cv;
            const float wl = *(const LAS float*)(L + L_WL + (t * 65 + ch) * 4), al = *(const LAS float*)(L + L_AL + (t * 65 + ch) * 4), gl = *(const LAS float*)(L + L_GL + (t * 65 + ch) * 4);
            const float z = -(w0 + wl); const float sp = fmaxf(z, 0.f) + __logf(1.f + __expf(-fabsf(z)));
            const float lgd = -__expf(-sp - 0.5f);
            const float ic = sigmoidf_(a0 + al);
            const float kv = k * k_k; const float kq = k * (1.f + (ic - 1.f) * k_a);
            kkv[tt] = kv; icv[tt] = ic; sq[tt] = kv * kv; bq[tt] = r * kq * r_k;
            rr[tt] = r; kp[tt] = kq; vv[tt] = v; run += lgd; ld[tt] = run; ggv[tt] = gl;
        }
        wave_sum8(sq); wave_sum8(bq);
#pragma unroll
        for (int tt = 0; tt < 8; ++tt) { const float kn = kkv[tt] * __builtin_amdgcn_rsqf(fmaxf(sq[tt], 1e-24f));
            aa[tt] = -kn; bb[tt] = kn * icv[tt]; vbv[tt] = bq[tt] * vv[tt]; }
        *(LAS float*)(L + L_GT + (w * 64 + ch) * 4) = run;
        *(GAS v4u*)(VBp + ch * 64 + tb) = (v4u){pk2(vbv[0], vbv[1]), pk2(vbv[2], vbv[3]), pk2(vbv[4], vbv[5]), pk2(vbv[6], vbv[7])};
        *(GAS v4u*)(Gp + ch * 64 + tb) = (v4u){pk2(ggv[0], ggv[1]), pk2(ggv[2], ggv[3]), pk2(ggv[4], ggv[5]), pk2(ggv[6], ggv[7])};
        if (hh + 1 < RW_H) {
            const bool has = (c * CH + tb > 0);
#pragma unroll
            for (int tt = 0; tt < 9; ++tt) { const size_t off = (size_t)(row0 + tb + tt - 1) * PRW + hnext * 64 + ch;
                if (tt > 0 || has) { raw[tt][0] = P[off]; raw[tt][1] = P[off + 512]; raw[tt][2] = P[off + 1024]; } }
        }
        LBAR();
        float offs = 0.f, tot = 0.f;
#pragma unroll
        for (int g = 0; g < 8; ++g) { const float x = *(const LAS float*)(L + L_GT + (g * 64 + ch) * 4); if (g < w) offs += x; tot += x; }
        const float etot = __expf(tot);
        if (w == 0) *(LAS float*)(L + L_WC + ch * 4) = etot;
        unsigned patt[4], pvt[4], pbh[4], pkh[4]; float hAt = 0.f, hBh = 0.f, hKh = 0.f;
        float e_ex = __expf(offs);
#pragma unroll
        for (int tt = 0; tt < 8; ++tt) { const int t = tb + tt; const float cl = offs + ld[tt];
            const float e_in = __expf(cl), e_inv = __builtin_amdgcn_rcpf(e_in), e_hat = etot * e_inv;
            const float At = aa[tt] * e_ex, Bt = bb[tt] * e_inv, Kt = kp[tt] * e_inv, Rt = rr[tt] * e_in, Bh = bb[tt] * e_hat, Kh = kp[tt] * e_hat; e_ex = e_in;
            *(LAS bf16*)(L + L_AT + t * LD + ch * 2) = (bf16)f2bf(At); *(LAS bf16*)(L + L_BT + t * LD + ch * 2) = (bf16)f2bf(Bt);
            *(LAS bf16*)(L + L_KT + t * LD + ch * 2) = (bf16)f2bf(Kt); *(LAS bf16*)(L + L_RT + t * LD + ch * 2) = (bf16)f2bf(Rt);
            if (tt & 1) { patt[tt >> 1] = pk2(hAt, At); pvt[tt >> 1] = pk2(vv[tt - 1], vv[tt]); pbh[tt >> 1] = pk2(hBh, Bh); pkh[tt >> 1] = pk2(hKh, Kh); }
            hAt = At; hBh = Bh; hKh = Kh;
        }
        *(LAS v4u*)(L + L_ATT + ch * LD + tb * 2) = (v4u){patt[0], patt[1], patt[2], patt[3]};
        *(LAS v4u*)(L + L_VT + ch * LD + tb * 2) = (v4u){pvt[0], pvt[1], pvt[2], pvt[3]};
        *(LAS v4u*)(L + L_BH + ch * LD + tb * 2) = (v4u){pbh[0], pbh[1], pbh[2], pbh[3]};
        *(LAS v4u*)(L + L_KH + ch * LD + tb * 2) = (v4u){pkh[0], pkh[1], pkh[2], pkh[3]};
        LBAR();
    }
    TSUB(2);
#pragma unroll
    for (int q = 0; q < 2; ++q) { const int tw = 2 * w + q, p0 = 16 * (tw >> 2), q0 = 16 * (tw & 3);
        f32x4 m = mm_tile(L + L_AT, LD, q0, L + L_BT, LD, p0, 2, Z4, fr, fq);
        f32x4 nak = mm_tile(L + L_KT, LD, q0, L + L_AT, LD, p0, 2, Z4, fr, fq);
        f32x4 nrk = mm_tile(L + L_KT, LD, q0, L + L_RT, LD, p0, 2, Z4, fr, fq);
        f32x4 nrb = mm_tile(L + L_BT, LD, q0, L + L_RT, LD, p0, 2, Z4, fr, fq);
        f32x4 tt;
        const int p = p0 + fr;
#pragma unroll
        for (int v = 0; v < 4; ++v) { const int qq = q0 + 4 * fq + v;
            if (!(p < qq)) m[v] = 0.f;
            if (!(qq < p)) nak[v] = 0.f;
            if (!(qq <= p)) { nrk[v] = 0.f; nrb[v] = 0.f; }
            tt[v] = (p == qq) ? 1.f : 0.f; }
        const int o = p * LD + (q0 + 4 * fq) * 2;
        st4_lds(L + L_M + o, m); st4t_lds(L + L_MT, p, q0 + 4 * fq, m); st4_lds(L + L_NAK + o, nak); st4_lds(L + L_NRK + o, nrk); st4_lds(L + L_NRB + o, nrb); st4_lds(L + L_TT + o, tt);
    }
    LBAR();
    TSUB(3);
    for (int it = 0; it < 6; ++it) {
        const int rM = (it & 1) ? L_AT : L_M, rMT = (it & 1) ? L_BT : L_MT, rTT = (it & 1) ? L_KT : L_TT;
        const int wM = (it & 1) ? L_M : L_AT, wMT = (it & 1) ? L_MT : L_BT, wTT = (it & 1) ? L_TT : L_KT;
#pragma unroll
        for (int q = 0; q < 2; ++q) { const int tw = 2 * w + q, p0 = 16 * (tw >> 2), q0 = 16 * (tw & 3); const int o = (p0 + fr) * LD + (q0 + 4 * fq) * 2;
            f32x4 tn = Z4, mn = Z4;
            if (q0 <= p0) { tn = mm_tile(L + rM, LD, q0, L + rTT, LD, p0, 2, ld4_lds(L + rTT + o), fr, fq);
                          }
            if (q0 >= p0 && it < 5) mn = mm_tile(L + rMT, LD, q0, L + rM, LD, p0, 2, Z4, fr, fq);
            st4_lds(L + wTT + o, tn); if (it < 5) { st4_lds(L + wM + o, mn); st4t_lds(L + wMT, p0 + fr, q0 + 4 * fq, mn); } }
        LBAR();
    }
    if (hh + 1 < RW_H) lora_dma(lora, hnext, lds0, w, lane);
    TSUB(4);
#pragma unroll
    for (int q = 0; q < 2; ++q) { const int tw = 2 * w + q, p0 = 16 * (tw >> 2), q0 = 16 * (tw & 3); const int o = (p0 + fr) * LD + (q0 + 4 * fq) * 2;
        const f32x4 ap = mm_tile(L + L_TT, LD, q0, L + L_ATT, LD, p0, 2, Z4, fr, fq);
        const f32x4 w1 = mm_tile(L + L_NAK, LD, q0, L + L_VT, LD, p0, 2, Z4, fr, fq);
        st4_lds(L + L_APT + o, ap); st4_lds(L + L_W1T + o, w1); }
    LBAR();
    {
        bf16* RPp = (bf16*)(F.ws + WS_RP) + (size_t)item * 4096; bf16* PTp = (bf16*)(F.ws + WS_PT) + (size_t)item * 4096;
#pragma unroll
        for (int q = 0; q < 2; ++q) { const int tw = 2 * w + q, p0 = 16 * (tw >> 2), q0 = 16 * (tw & 3); const int p = p0 + fr; const int o = p * LD + (q0 + 4 * fq) * 2;
            const f32x4 u0 = mm_tile(L + L_TT, LD, q0, L + L_W1T, LD, p0, 2, Z4, fr, fq);
            const f32x4 rp = mm_tile(L + L_APT, LD, q0, L + L_NRB, LD, p0, 2, ld4_lds(L + L_RT + o), fr, fq);
            f32x4 pt = mm_tile(L + L_APT, LD, q0, L + L_BH, LD, p0, 2, Z4, fr, fq);
            const float wc = *(const LAS float*)(L + L_WC + p * 4);
#pragma unroll
            for (int v = 0; v < 4; ++v) if (p == q0 + 4 * fq + v) pt[v] += wc;
            st4_lds(L + L_U0T + o, u0);
            st4_g(RPp + p * 64 + q0 + 4 * fq, rp); st4_g(PTp + ((p0 >> 4) * 2 + (q0 >> 5)) * 512 + fr * 32 + (q0 & 16) + 4 * fq, pt); }
    }
    LBAR();
    {
        bf16* Y0p = (bf16*)(F.ws + WS_Y0) + (size_t)item * 4096; bf16* QCp = (bf16*)(F.ws + WS_QC) + (size_t)item * 4096;
#pragma unroll
        for (int q = 0; q < 2; ++q) { const int tw = 2 * w + q, p0 = 16 * (tw >> 2), q0 = 16 * (tw & 3); const int p = p0 + fr;
            f32x4 y0 = mm_tile(L + L_VT, LD, q0, L + L_NRK, LD, p0, 2, Z4, fr, fq);
            y0 = mm_tile(L + L_U0T, LD, q0, L + L_NRB, LD, p0, 2, y0, fr, fq);
            f32x4 qc = mm_tile(L + L_KH, LD, q0, L + L_VT, LD, p0, 2, Z4, fr, fq);
            qc = mm_tile(L + L_BH, LD, q0, L + L_U0T, LD, p0, 2, qc, fr, fq);
            st4_g(Y0p + p * 64 + q0 + 4 * fq, y0); st4_g(QCp + p * 64 + q0 + 4 * fq, qc); }
    }
    LBAR();
    TSUB(5);
    }
#undef TSUB
}
struct ScanOps { bf16x8 pf[2][2]; v2u qi[2]; };
__device__ __forceinline__ void scan_load(const bf16* PT, const bf16* QC, int c, ScanOps& o, int w, int fr, int fq) {
#pragma unroll
    for (int q = 0; q < 2; ++q) { const int tw = 2 * w + q, p0 = 16 * (tw >> 2), q0 = 16 * (tw & 3);
        o.pf[q][0] = *(const GAS bf16x8*)(PT + (size_t)c * 4096 + ((q0 >> 4) * 2) * 512 + fr * 32 + fq * 8); o.pf[q][1] = *(const GAS bf16x8*)(PT + (size_t)c * 4096 + ((q0 >> 4) * 2 + 1) * 512 + fr * 32 + fq * 8);
        o.qi[q] = *(const GAS v2u*)(QC + (size_t)c * 4096 + (p0 + fr) * 64 + q0 + 4 * fq); }
}
__device__ __forceinline__ void scan_step(LAS unsigned char* L, bf16* S, int c, const ScanOps& o, f32x4 (&acc)[2], int w, int fr, int fq) {
#pragma unroll
    for (int q = 0; q < 2; ++q) { const int tw = 2 * w + q, p0 = 16 * (tw >> 2), q0 = 16 * (tw & 3);
        st4_g(S + (size_t)c * 4096 + (p0 + fr) * 64 + q0 + 4 * fq, acc[q]);
        st4_lds(L + (c & 1) * ARR + (p0 + fr) * LD + (q0 + 4 * fq) * 2, acc[q]); }
    LBAR();
#pragma unroll
    for (int q = 0; q < 2; ++q) { const int tw = 2 * w + q, p0 = 16 * (tw >> 2);
        const LAS unsigned char* sp = L + (c & 1) * ARR + (p0 + fr) * LD + fq * 16;
        const bf16x8 s0 = *(const LAS bf16x8*)sp, s1 = *(const LAS bf16x8*)(sp + 64);
        f32x4 a = (f32x4){bflo(o.qi[q].x), bfhi(o.qi[q].x), bflo(o.qi[q].y), bfhi(o.qi[q].y)};
        a = __builtin_amdgcn_mfma_f32_16x16x32_bf16(o.pf[q][0], s0, a, 0, 0, 0);
        a = __builtin_amdgcn_mfma_f32_16x16x32_bf16(o.pf[q][1], s1, a, 0, 0, 0);
        acc[q] = a; }
}
__device__ __forceinline__ void rwkv_state_scan(Frame& F, int bh) {
    LAS unsigned char* L = F.lds;
    const int lane = F.lane, w = F.wave, fr = lane & 15, fq = lane >> 4;
    const bf16* PT = (const bf16*)(F.ws + WS_PT) + (size_t)bh * NCH * 4096; const bf16* QC = (const bf16*)(F.ws + WS_QC) + (size_t)bh * NCH * 4096;
    bf16* S = (bf16*)(F.ws + WS_S) + (size_t)bh * NCH * 4096;
    f32x4 acc[2]; acc[0] = (f32x4){0.f, 0.f, 0.f, 0.f}; acc[1] = acc[0];
    ScanOps o0, o1, o2, o3;
    scan_load(PT, QC, 0, o0, w, fr, fq); scan_load(PT, QC, 1, o1, w, fr, fq); scan_load(PT, QC, 2, o2, w, fr, fq); scan_load(PT, QC, 3, o3, w, fr, fq);
#pragma unroll 1
    for (int c = 0; c < NCH; c += 4) {
        const int n0 = (c + 4 < NCH) ? c + 4 : c, n1 = (c + 5 < NCH) ? c + 5 : c, n2 = (c + 6 < NCH) ? c + 6 : c, n3 = (c + 7 < NCH) ? c + 7 : c;
        scan_step(L, S, c, o0, acc, w, fr, fq);     scan_load(PT, QC, n0, o0, w, fr, fq);
        scan_step(L, S, c + 1, o1, acc, w, fr, fq); scan_load(PT, QC, n1, o1, w, fr, fq);
        scan_step(L, S, c + 2, o2, acc, w, fr, fq); scan_load(PT, QC, n2, o2, w, fr, fq);
        scan_step(L, S, c + 3, o3, acc, w, fr, fq); scan_load(PT, QC, n3, o3, w, fr, fq);
    }
    LBAR();
}
struct ChunkOutOps { v2u y0[2]; bf16x8 sf[2][2], rf[2][2]; };
__device__ __forceinline__ void chunk_out_load(Frame& F, int item, ChunkOutOps& o, int w, int fr, int fq) {
    const bf16* S = (const bf16*)(F.ws + WS_S) + (size_t)item * 4096; const bf16* RP = (const bf16*)(F.ws + WS_RP) + (size_t)item * 4096; const bf16* Y0 = (const bf16*)(F.ws + WS_Y0) + (size_t)item * 4096;
#pragma unroll
    for (int q = 0; q < 2; ++q) { const int tw = 2 * w + q, p0 = 16 * (tw >> 2), q0 = 16 * (tw & 3);
        o.y0[q] = *(const GAS v2u*)(Y0 + (p0 + fr) * 64 + q0 + 4 * fq);
#pragma unroll
        for (int k = 0; k < 2; ++k) { o.sf[q][k] = *(const GAS bf16x8*)(S + (q0 + fr) * 64 + k * 32 + fq * 8); o.rf[q][k] = *(const GAS bf16x8*)(RP + (p0 + fr) * 64 + k * 32 + fq * 8); } }
}
__device__ __forceinline__ void rwkv_chunk_out_all(Frame& F) {
    const float* PRM = (const float*)(F.ws + WS_PRM);
    LAS unsigned char* L = F.lds;
    const int lane = F.lane, w = F.wave, fr = lane & 15, fq = lane >> 4;
    ChunkOutOps cur, nxt;
    int item = F.vcu;
    if (item < NITEM) chunk_out_load(F, item, cur, w, fr, fq);
    for (; item < NITEM; item += F.G) {
        const int bh = item / NCH, c = item % NCH, b = bh / RW_H, h = bh % RW_H; const int row0 = b * T + c * CH;
        const int ch = lane, gc = h * 64 + ch;
        const bf16* VB = (const bf16*)(F.ws + WS_VB) + (size_t)item * 4096; const bf16* G = (const bf16*)(F.ws + WS_G) + (size_t)item * 4096;
        const v4u vbq = *(const GAS v4u*)(VB + ch * 64 + 8 * w), ggq = *(const GAS v4u*)(G + ch * 64 + 8 * w);
        const int inext = item + F.G;
        if (inext < NITEM) chunk_out_load(F, inext, nxt, w, fr, fq);
#pragma unroll
        for (int q = 0; q < 2; ++q) { const int tw = 2 * w + q, p0 = 16 * (tw >> 2), q0 = 16 * (tw & 3);
            f32x4 a = (f32x4){bflo(cur.y0[q].x), bfhi(cur.y0[q].x), bflo(cur.y0[q].y), bfhi(cur.y0[q].y)};
#pragma unroll
            for (int k = 0; k < 2; ++k) a = __builtin_amdgcn_mfma_f32_16x16x32_bf16(cur.sf[q][k], cur.rf[q][k], a, 0, 0, 0);
#pragma unroll
            for (int v = 0; v < 4; ++v) *(LAS float*)(L + L_YL + ((p0 + fr) * 65 + q0 + 4 * fq + v) * 4) = a[v];
        }
        LBAR();
        {
            const float gw = (PRM + 4608)[gc], gb = (PRM + 5120)[gc];
            bf16* YM = (bf16*)(F.ws + WS_YMIX);
            float yv[8], sm[8], sv[8];
#pragma unroll
            for (int tt = 0; tt < 8; ++tt) { yv[tt] = *(const LAS float*)(L + L_YL + ((8 * w + tt) * 65 + ch) * 4); sm[tt] = yv[tt]; }
            wave_sum8(sm);
#pragma unroll
            for (int tt = 0; tt < 8; ++tt) { yv[tt] -= sm[tt] * (1.f / 64.f); sv[tt] = yv[tt] * yv[tt]; }
            wave_sum8(sv);
#pragma unroll
            for (int tt = 0; tt < 8; ++tt) { const int t = 8 * w + tt;
                const float yn = yv[tt] * __builtin_amdgcn_rsqf(sv[tt] * (1.f / 64.f) + GN_EPS) * gw + gb;
                const float o = (yn + ((tt & 1) ? bfhi(vbq[tt >> 1]) : bflo(vbq[tt >> 1]))) * ((tt & 1) ? bfhi(ggq[tt >> 1]) : bflo(ggq[tt >> 1]));
                YM[(size_t)(row0 + t) * D + gc] = (bf16)f2bf(o); }
        }
        LBAR();
        cur = nxt;
    }
}
__device__ __forceinline__ void diff_post_rows(Frame& F) {
    const float* PRM = (const float*)(F.ws + WS_PRM);
    const int lane = F.lane; const int gw = F.vcu * NWAVES + F.wave, NGW = F.G * NWAVES;
    const float l1 = wave_sum((PRM + 5632)[lane] * (PRM + 5696)[lane]), l2 = wave_sum((PRM + 5760)[lane] * (PRM + 5824)[lane]);
    const float lam = __expf(l1) - __expf(l2) + LAMBDA_INIT;
    const int e0 = 2 * lane, vh = e0 >> 6, d = e0 & 63;
    const float sw0 = (PRM + 5888)[e0] * (1.f - LAMBDA_INIT), sw1 = (PRM + 5888)[e0 + 1] * (1.f - LAMBDA_INIT);
    const bf16* O = (const bf16*)(F.ws + WS_O); bf16* YM = (bf16*)(F.ws + WS_YMIX);
    unsigned c1[2][4], c2[2][4], n1[2][4], n2[2][4];
    int m = gw;
#pragma unroll
    for (int r = 0; r < 2; ++r)
#pragma unroll
        for (int hd = 0; hd < 4; ++hd) { const int mr = m + r * NGW; c1[r][hd] = 0u; c2[r][hd] = 0u;
            if (mr < M) { c1[r][hd] = *(const GAS unsigned*)(O + (size_t)mr * 1024 + (hd * 4 + vh) * 64 + d); c2[r][hd] = *(const GAS unsigned*)(O + (size_t)mr * 1024 + (hd * 4 + 2 + vh) * 64 + d); } }
    for (; m < M; m += 2 * NGW) {
#pragma unroll
        for (int r = 0; r < 2; ++r)
#pragma unroll
            for (int hd = 0; hd < 4; ++hd) { const int mr = m + (2 + r) * NGW; n1[r][hd] = 0u; n2[r][hd] = 0u;
                if (mr < M) { n1[r][hd] = *(const GAS unsigned*)(O + (size_t)mr * 1024 + (hd * 4 + vh) * 64 + d); n2[r][hd] = *(const GAS unsigned*)(O + (size_t)mr * 1024 + (hd * 4 + 2 + vh) * 64 + d); } }
        float o0[8], o1[8], ss[8];
#pragma unroll
        for (int r = 0; r < 2; ++r)
#pragma unroll
            for (int hd = 0; hd < 4; ++hd) { const unsigned w1 = c1[r][hd], w2 = c2[r][hd]; const int k = r * 4 + hd;
                o0[k] = bflo(w1) - lam * bflo(w2); o1[k] = bfhi(w1) - lam * bfhi(w2); ss[k] = o0[k] * o0[k] + o1[k] * o1[k]; }
        wave_sum8(ss);
#pragma unroll
        for (int r = 0; r < 2; ++r) { const int mr = m + r * NGW;
            if (mr < M) {
#pragma unroll
                for (int hd = 0; hd < 4; ++hd) { const int k = r * 4 + hd; const float rs = __builtin_amdgcn_rsqf(ss[k] * (1.f / 128.f) + SUBLN_EPS);
                    *(GAS unsigned*)(YM + (size_t)mr * D + 512 + hd * 128 + e0) = pk2(o0[k] * rs * sw0, o1[k] * rs * sw1); } } }
#pragma unroll
        for (int r = 0; r < 2; ++r)
#pragma unroll
            for (int hd = 0; hd < 4; ++hd) { c1[r][hd] = n1[r][hd]; c2[r][hd] = n2[r][hd]; }
    }
}
__global__ void __launch_bounds__(NWAVES * 64, 2) hybrid_fwd(const Args A) {
    extern __shared__ __attribute__((aligned(16))) unsigned char lds[];
    Frame F;
    F.lds = (LAS unsigned char*)lds;
    F.wave = __builtin_amdgcn_readfirstlane((int)threadIdx.x >> 6); F.lane = lane_id_asm(); F.tid = F.wave * 64 + F.lane;
    F.G = gridDim.x; { const int bx = blockIdx.x; F.vcu = (F.G % 8 == 0) ? (bx % 8) * (F.G / 8) + bx / 8 : bx; }
    F.ws = A.ws; F.ctl = (unsigned*)(A.ws + WS_CTL); F.out = A.out;
    const int lo = A.ph_lo, hi = A.ph_hi;
    cg::grid_group grid = cg::this_grid();
    volatile LAS unsigned* MISC = (volatile LAS unsigned*)(F.lds + L_MISC);
    if (F.tid < 16) MISC[F.tid] = 0u;
    __syncthreads();
    XcdBarrier bar; bar.bar = F.ctl + CW_BAR; bar.x = 0; bar.st = nullptr;
    if (hi - lo > 1) {
        if (blockIdx.x == 0) { GAS v4u* z = (GAS v4u*)(F.ws + WS_CTL); for (int i = F.tid; i < (int)(CTL_ZERO_BYTES / 16); i += NWAVES * 64) if (i < (int)(WS_PRM / 16) || i >= (int)((CW_SEAM * 4) / 16)) z[i] = (v4u){0u, 0u, 0u, 0u}; }
        grid.sync();
        bar = xcd_barrier_post(F.ctl + CW_BAR, MISC + 8, F.wave);
    }
    const float* PRM = (const float*)(F.ws + WS_PRM);
#define IN(k) (lo <= (k) && (k) < hi)
    unsigned long long pt0 = 0;
#define PSTART(k) do { if ((k) == PROBE_PHASE) pt0 = __builtin_amdgcn_s_memrealtime(); } while (0)
#define PEND(k) do { if ((k) == PROBE_PHASE) { const unsigned long long pt1 = __builtin_amdgcn_s_memrealtime(); while (__builtin_amdgcn_s_memrealtime() - pt1 < pt1 - pt0) __builtin_amdgcn_s_sleep(8); xcd_barrier(bar, F.wave); } } while (0)
#define SEAM(k) do { if (hi - lo > 1) { xcd_barrier(bar, F.wave); F.lane = lane_id_asm(); F.tid = F.wave * 64 + F.lane; } } while (0)
    bf16* XN = (bf16*)(F.ws + WS_XN); bf16* ACT = (bf16*)(F.ws + WS_ACT); float* Y = (float*)(F.ws + WS_Y); float* YMo = (float*)(F.ws + WS_YM);

    PSTART(0); if (IN(0)) { for (int rep = 0; rep < REP0; ++rep) p0_prologue(F, A); } SEAM(0); PEND(0);
    PSTART(1); if (IN(1)) for (int rep = 0; rep < REP1; ++rep) { pg8::Gemm g{XN, (const bf16*)(F.ws + WS_WGU1), M, NGU, D}; pg8::StaticOrder S; S.init(M, NGU, F.G, (int)blockIdx.x);
        pg8::EpiSwiGLU E{ACT, FF}; pg8::gemm_phase<pg8::EpiSwiGLU, pg8::StaticOrder, true, true>(F.lds, g, S, E, F.wave);
        if (F.G == 256 && (int)blockIdx.x >= 128) p0_convert_range(F, A, P0_R0, P0_R1, ((int)blockIdx.x - 128) * NWAVES + F.wave, 128 * NWAVES);
        else if (F.G != 256) p0_convert_range(F, A, P0_R0, P0_R1, F.vcu * NWAVES + F.wave, F.G * NWAVES); } SEAM(1); PEND(1);
    PSTART(2); if (IN(2)) for (int rep = 0; rep < REP2; ++rep) { pg8::Gemm g{ACT, (const bf16*)(F.ws + WS_WD1), M, D, FF}; pg8::StaticOrder S; S.init(M, D, F.G, (int)blockIdx.x);
        pg8::PanelRms s1{(float*)(F.ws + WS_X), F.ctl + CW_SEAM, NORM_EPS}, s2{(float*)(F.ws + WS_X) + 65536, F.ctl + CW_SEAM + SEAM_BANK, NORM_EPS};
        pg8::EpiRmsResRms<false> E{A.in[0], (bf16*)F.out, XN, D, PRM + 6144, 0.5f, PRM + 7168, s1, s2};
        pg8::gemm_phase<pg8::EpiRmsResRms<false>, pg8::StaticOrder, false, true>(F.lds, g, S, E, F.wave); } SEAM(2); PEND(2);
    PSTART(4); if (IN(4)) for (int rep = 0; rep < REP4; ++rep) { pg8::Gemm g{XN, (const bf16*)(F.ws + WS_WIN), M, NPW, D}; pg8::StaticOrder S; S.init(M, NPW, F.G, (int)blockIdx.x);
        pg8::EpiP E{(bf16*)(F.ws + WS_PRW), PRW, (bf16*)(F.ws + WS_PDF), PDF}; pg8::gemm_phase<pg8::EpiP, pg8::StaticOrder, true, true>(F.lds, g, S, E, F.wave);
        if (F.G == 256 && (int)blockIdx.x >= 128) p0_convert_range(F, A, P0_R1, P0_R2, ((int)blockIdx.x - 128) * NWAVES + F.wave, 128 * NWAVES);
        else if (F.G != 256) p0_convert_range(F, A, P0_R1, P0_R2, F.vcu * NWAVES + F.wave, F.G * NWAVES); } SEAM(4); PEND(4); for (int rep = 0; rep < REPBAR; ++rep) xcd_barrier(bar, F.wave);
    PSTART(5); if (IN(5)) { for (int rep = 0; rep < REP5; ++rep) { unsigned long long tsub = 0; for (int bc = F.vcu; bc < BATCH * NCH; bc += F.G) rwkv_chunk_group(F, bc, tsub); if (PROBE_SUB >= 0) { const unsigned long long t1 = __builtin_amdgcn_s_memrealtime(); while (__builtin_amdgcn_s_memrealtime() - t1 < tsub) __builtin_amdgcn_s_sleep(8); } } } SEAM(5); PEND(5);
    PSTART(6); if (IN(6)) for (int rep = 0; rep < REP6; ++rep) {
        if ((F.vcu & 7) == 0) for (int rs = 0; rs < REPSCAN; ++rs) rwkv_state_scan(F, F.vcu >> 3);
        LAS unsigned* misc = (LAS unsigned*)(F.lds + L_MISC);
        const attn_body::bf16* Pd = (const attn_body::bf16*)(F.ws + WS_PDF);
        for (;;) {
            if (F.wave == 0 && lane_id_asm() == 0) misc[0] = atomicAdd(F.ctl + CW_QUEUE + 64 * rep, 1u);
            __syncthreads(); const unsigned idx = misc[0]; __syncthreads();
            if (idx >= 1024u) break;
            const int qb = 15 - (int)(idx >> 6), bhv = (int)(idx & 63u);
            attn_body::attn_unit<8>(bhv >> 4, bhv & 15, qb, Pd, Pd, Pd, (attn_body::bf16*)(F.ws + WS_O), (char*)lds, F.wave);
#if REPATT > 1
            attn_body::attn_unit<8>(bhv >> 4, bhv & 15, qb, Pd, Pd, Pd, (attn_body::bf16*)(F.ws + WS_O), (char*)lds, F.wave);
#endif
        }
    } SEAM(6); PEND(6);
    PSTART(7); if (IN(7)) { for (int rep = 0; rep < REP7; ++rep) { rwkv_chunk_out_all(F); diff_post_rows(F); } } SEAM(7); PEND(7);
    PSTART(8); if (IN(8)) { pg8::Gemm g{(const bf16*)(F.ws + WS_YMIX), (const bf16*)(F.ws + WS_WO), M, D, D}; pg8::StaticOrder S; S.init(M, D, F.G, (int)blockIdx.x);
        pg8::PanelRms s1{(float*)(F.ws + WS_X) + 2 * 65536, F.ctl + CW_SEAM + 2 * SEAM_BANK, NORM_EPS}, s2{(float*)(F.ws + WS_X) + 3 * 65536, F.ctl + CW_SEAM + 3 * SEAM_BANK, NORM_EPS};
        pg8::EpiRmsResRms<true> E{(const bf16*)F.out, (bf16*)(F.ws + WS_Y), XN, D, PRM + 8192, 1.0f, PRM + 9216, s1, s2};
        pg8::gemm_phase<pg8::EpiRmsResRms<true>, pg8::StaticOrder, false, true>(F.lds, g, S, E, F.wave); } SEAM(8); PEND(8);
    PSTART(10); if (IN(10)) { pg8::Gemm g{XN, (const bf16*)(F.ws + WS_WGU2), M, NGU, D}; pg8::StaticOrder S; S.init(M, NGU, F.G, (int)blockIdx.x);
        pg8::EpiSwiGLU E{ACT, FF}; pg8::gemm_phase<pg8::EpiSwiGLU, pg8::StaticOrder, true, true>(F.lds, g, S, E, F.wave);
        if (F.G == 256 && (int)blockIdx.x >= 128) p0_convert_range(F, A, P0_R2, P0_NITEMS, ((int)blockIdx.x - 128) * NWAVES + F.wave, 128 * NWAVES);
        else if (F.G != 256) p0_convert_range(F, A, P0_R2, P0_NITEMS, F.vcu * NWAVES + F.wave, F.G * NWAVES); } SEAM(10); PEND(10);
    if (IN(11)) { pg8::Gemm g{ACT, (const bf16*)(F.ws + WS_WD2), M, D, FF}; pg8::StaticOrder S; S.init(M, D, F.G, (int)blockIdx.x);
        pg8::PanelRms s1{(float*)(F.ws + WS_X) + 4 * 65536, F.ctl + CW_SEAM + 4 * SEAM_BANK, NORM_EPS};
        pg8::EpiRmsRes<true> E{(const bf16*)(F.ws + WS_Y), F.out, D, PRM + 10240, 0.5f, s1};
        pg8::gemm_phase<pg8::EpiRmsRes<true>, pg8::StaticOrder, false, true>(F.lds, g, S, E, F.wave); }
#undef IN
#undef SEAM
}

extern "C" void kernel_launch(void* const* d_in, const int* in_sizes, int n_in, void* d_out, int out_size, void* d_ws, size_t ws_size, hipStream_t stream) {
    static int grid = 0;
    if (grid == 0) {
        if (n_in != 31 || in_sizes[0] != M * D || out_size != M * D || ws_size < WS_END) { fprintf(stderr, "kernel_launch: unexpected shapes (n_in %d, in0 %d, out %d, ws %zu); nothing launched\n", n_in, n_in > 0 ? in_sizes[0] : -1, out_size, ws_size); grid = -1; return; }
        int dev = 0, cus = 0, per_cu = 0;
        if (hipGetDevice(&dev) != hipSuccess || hipDeviceGetAttribute(&cus, hipDeviceAttributeMultiprocessorCount, dev) != hipSuccess) { grid = -1; return; }
        if (hipFuncSetAttribute((const void*)hybrid_fwd, hipFuncAttributeMaxDynamicSharedMemorySize, LDS_BYTES) != hipSuccess) { fprintf(stderr, "kernel_launch: hipFuncSetAttribute failed\n"); grid = -1; return; }
        if (hipOccupancyMaxActiveBlocksPerMultiprocessor(&per_cu, (const void*)hybrid_fwd, NWAVES * 64, LDS_BYTES) != hipSuccess || per_cu < 1) { fprintf(stderr, "kernel_launch: occupancy query reports %d workgroups per CU\n", per_cu); per_cu = 1; }
        (void)hipGetLastError();
        grid = cus;
    }
    if (grid < 0) return;
#if MK_PER_PHASE
    (void)hipMemsetAsync((char*)d_ws + WS_CTL, 0, CTL_ZERO_BYTES, stream);
#endif
    Args a{};
    for (int i = 0; i < 31; ++i) a.in[i] = (const float*)d_in[i];
    a.out = (float*)d_out; a.ws = (unsigned char*)d_ws;
#if MK_PER_PHASE
    for (int p = 0; p < N_PHASES; ++p) { a.ph_lo = p; a.ph_hi = p + 1; hipLaunchKernelGGL(hybrid_fwd, dim3(grid), dim3(NWAVES * 64), LDS_BYTES, stream, a); }
#else
    a.ph_lo = 0; a.ph_hi = N_PHASES;
    void* kargs[] = {&a};
    const hipError_t e = hipLaunchCooperativeKernel((const void*)hybrid_fwd, dim3(grid), dim3(NWAVES * 64), kargs, LDS_BYTES, stream);
    if (e != hipSuccess) fprintf(stderr, "kernel_launch: cooperative launch failed: %s (grid %d)\n", hipGetErrorString(e), grid);
#endif
}
```
